# Optimizing an MI355X kernel written in HIP

```python
import math
import jax
import jax.numpy as jnp
from jax import lax
import numpy as np

D_MODEL = 1024
BATCH = 2
SEQ = 8192
DEPTH = 2

GRID_W = 64
CTX_LEN = 256
N_ADA = 6
N_BRANCH = 3
BRANCH_WIDTH = D_MODEL
POOL_WIDTH = BRANCH_WIDTH
POOL_GROUPS = 4
POOL_WINDOWS = (2, 4, 8, 16)
FOURIER_WIDTH = BRANCH_WIDTH
FOURIER_GROUPS = 4
SSM_INNER = BRANCH_WIDTH
SSM_HEAD_DIM = 64
SSM_HEADS = SSM_INNER // SSM_HEAD_DIM
SSM_GROUPS = 4
SSM_STATE = 128
SSM_CONV = 5
SSM_CHUNK = 128
CONV_DIM = SSM_INNER + 2 * SSM_GROUPS * SSM_STATE
OFF_FOURIER = POOL_WIDTH
OFF_Z = OFF_FOURIER + FOURIER_WIDTH
OFF_XBC = OFF_Z + SSM_INNER
OFF_DT = OFF_XBC + CONV_DIM
OFF_GATE = OFF_DT + 2 * SSM_HEADS
IN_COLS = OFF_GATE + N_BRANCH * D_MODEL
N_EXPERTS = 32
TOP_K = 4
D_FF = D_MODEL
SWIGLU_ALPHA = 1.702
SWIGLU_LIMIT = 7.0
MOE_BLOCK = 256
RMS_EPS = 1e-6

kernel_name = 'hybrid_pool_fourier_ssd_moe_dit'


def rms_norm(x, w):
    xf = x.astype(jnp.float32)
    y = xf * lax.rsqrt(jnp.mean(xf * xf, axis=-1, keepdims=True) + RMS_EPS)
    return y * w.astype(jnp.float32)


def modulate(h, shift, scale):
    return h * (1.0 + scale) + shift


def _window_bounds(n, w):
    t = jnp.arange(n)
    lo = jnp.clip(t - w // 2, 0, n)
    hi = jnp.clip(t + w - w // 2, 0, n)
    return lo, hi


def _pool1d(u, w):
    n = u.shape[1]
    s = jnp.pad(jnp.cumsum(u, axis=1), ((0, 0), (1, 0), (0, 0)))
    lo, hi = _window_bounds(n, w)
    return (s[:, hi] - s[:, lo]) / (hi - lo).astype(u.dtype)[None, :, None]


def _pool2d(u, w):
    rows, cols = u.shape[1], u.shape[2]
    s = jnp.pad(jnp.cumsum(jnp.cumsum(u, axis=1), axis=2), ((0, 0), (1, 0), (1, 0), (0, 0)))
    r0, r1 = _window_bounds(rows, w)
    c0, c1 = _window_bounds(cols, w)
    tot = (s[:, r1][:, :, c1] - s[:, r0][:, :, c1]
           - s[:, r1][:, :, c0] + s[:, r0][:, :, c0])
    cnt = ((r1 - r0)[:, None] * (c1 - c0)[None, :]).astype(u.dtype)
    return tot / cnt[None, :, :, None]


def pool_mixer(u, pool_w, pool_scale, grid):
    b, n, _ = u.shape
    gw = POOL_WIDTH // POOL_GROUPS
    ug = u.reshape(b, n, POOL_GROUPS, gw)
    outs = []
    for g, w in enumerate(POOL_WINDOWS):
        v = ug[:, :, g]
        if grid:
            rows = n // GRID_W
            p = _pool2d(v.reshape(b, rows, GRID_W, gw), w).reshape(b, n, gw)
        else:
            p = _pool1d(v, w)
        outs.append(p - v)
    d = jnp.stack(outs, axis=2)
    y = jnp.einsum('blgc,gcd->blgd', d, pool_w).reshape(b, n, POOL_WIDTH)
    return y * pool_scale


def fourier_mixer(u):
    b, n, _ = u.shape
    ug = u.astype(jnp.float32).reshape(b, n, FOURIER_GROUPS, FOURIER_WIDTH // FOURIER_GROUPS)
    f = jnp.fft.fft2(ug, axes=(1, 3), norm='ortho').real
    return f.reshape(b, n, FOURIER_WIDTH).astype(jnp.float32)


def depthwise_conv(u, w, bias):
    k = w.shape[0]
    out = lax.conv_general_dilated(
        u, w.astype(jnp.float32)[:, None, :], window_strides=(1,),
        padding=[(k // 2, k - 1 - k // 2)],
        dimension_numbers=('NWC', 'WIO', 'NWC'), feature_group_count=u.shape[-1])
    return out + bias.astype(jnp.float32)


def _segsum(a):
    t = a.shape[-1]
    cs = jnp.cumsum(a, axis=-1)
    diff = cs[..., :, None] - cs[..., None, :]
    return jnp.where(jnp.tril(jnp.ones((t, t), dtype=bool)), diff, -jnp.inf)


def ssd_scan(x, dt, a, bm, cm, init_state):
    b, n, h, p = x.shape
    q = SSM_CHUNK
    nc = n // q
    xd = (x * dt[..., None]).reshape(b, nc, q, h, p)
    ad = (dt * a).reshape(b, nc, q, h).transpose(0, 3, 1, 2)
    bc = bm.reshape(b, nc, q, h, -1)
    cc = cm.reshape(b, nc, q, h, -1)
    a_cum = jnp.cumsum(ad, axis=-1)
    lmat = jnp.exp(_segsum(ad))
    cb = jnp.einsum('bclhn,bcshn->bhcls', cc, bc)
    y_diag = jnp.einsum('bhcls,bcshp->bclhp', cb * lmat, xd)
    decay_states = jnp.exp(a_cum[..., -1:] - a_cum).transpose(0, 2, 3, 1)
    chunk_states = jnp.einsum('bclhn,bclhp->bchpn', bc, xd * decay_states[..., None])
    chunk_decay = jnp.exp(a_cum[..., -1])

    def step(s, inp):
        st, dec = inp
        return s * dec[..., None, None] + st, s

    final, starts = lax.scan(step, init_state,
                             (chunk_states.transpose(1, 0, 2, 3, 4), chunk_decay.transpose(2, 0, 1)))
    starts = starts.transpose(1, 0, 2, 3, 4)
    y_off = (jnp.einsum('bclhn,bchpn->bclhp', cc, starts)
             * jnp.exp(a_cum).transpose(0, 2, 3, 1)[..., None])
    return (y_diag + y_off).reshape(b, n, h, p), final


def _bidir_ssd(xs, bm, cm, dt, a, init_f, init_b):
    y_f, fin_f = ssd_scan(xs, dt[:, :, 0], a[0], bm, cm, init_f)
    rev = lambda t: jnp.flip(t, axis=1)
    y_b, fin_b = ssd_scan(rev(xs), rev(dt[:, :, 1]), a[1], rev(bm), rev(cm), init_b)
    return y_f + rev(y_b), fin_f, fin_b


def _ssm_inputs(xbc, dt_raw, conv_w, conv_b, dt_bias):
    b, n, _ = xbc.shape
    v = jax.nn.silu(depthwise_conv(xbc, conv_w, conv_b))
    gn = SSM_GROUPS * SSM_STATE
    rep = SSM_HEADS // SSM_GROUPS
    xs = v[..., :SSM_INNER].reshape(b, n, SSM_HEADS, SSM_HEAD_DIM)
    bm = jnp.repeat(v[..., SSM_INNER:SSM_INNER + gn].reshape(b, n, SSM_GROUPS, SSM_STATE), rep, axis=2)
    cm = jnp.repeat(v[..., SSM_INNER + gn:].reshape(b, n, SSM_GROUPS, SSM_STATE), rep, axis=2)
    dt = jax.nn.softplus(dt_raw.reshape(b, n, 2, SSM_HEADS) + dt_bias.astype(jnp.float32))
    return xs, bm, cm, dt


def _ssm_out(y, xs, z, d_skip, norm_w):
    b, n = y.shape[:2]
    y = (y + d_skip.astype(jnp.float32)[:, None] * xs).reshape(b, n, SSM_INNER)
    return rms_norm(y * jax.nn.silu(z), norm_w)


def merge_branches(ya, yb, yc, gate_raw, w_branch, w_out):
    b, n, _ = ya.shape
    ys = jnp.stack([ya, yb, yc], axis=2)
    proj = jnp.einsum('blkw,kwd->blkd', ys, w_branch)
    g = jax.nn.sigmoid(gate_raw.reshape(b, n, N_BRANCH, D_MODEL))
    return jnp.sum(g * proj, axis=2) @ w_out


def token_mixer(hl, hc, w_in, pool_w, pool_scale, conv_w, conv_b, dt_bias, a_log, d_skip,
                ssm_norm_w, w_branch, w_out, need_ctx):
    ul = (hl @ w_in).astype(jnp.float32)
    uc = (hc @ w_in).astype(jnp.float32)
    a = -jnp.exp(a_log.astype(jnp.float32))
    b = hl.shape[0]
    xs_c, bm_c, cm_c, dt_c = _ssm_inputs(uc[..., OFF_XBC:OFF_DT], uc[..., OFF_DT:OFF_GATE],
                                         conv_w, conv_b, dt_bias)
    xs_l, bm_l, cm_l, dt_l = _ssm_inputs(ul[..., OFF_XBC:OFF_DT], ul[..., OFF_DT:OFF_GATE],
                                         conv_w, conv_b, dt_bias)
    zero = jnp.zeros((b, SSM_HEADS, SSM_HEAD_DIM, SSM_STATE), jnp.float32)
    y_c, st_f, st_b = _bidir_ssd(xs_c, bm_c, cm_c, dt_c, a, zero, zero)
    y_l, _, _ = _bidir_ssd(xs_l, bm_l, cm_l, dt_l, a, st_f, st_b)

    def branches(u, y_ssm, xs, grid):
        ya = pool_mixer(u[..., :OFF_FOURIER], pool_w, pool_scale, grid)
        yb = fourier_mixer(u[..., OFF_FOURIER:OFF_Z])
        yc = _ssm_out(y_ssm, xs, u[..., OFF_Z:OFF_XBC], d_skip, ssm_norm_w)
        return merge_branches(ya, yb, yc, u[..., OFF_GATE:], w_branch, w_out)

    out_l = branches(ul, y_l, xs_l, True)
    out_c = branches(uc, y_c, xs_c, False) if need_ctx else None
    return out_l, out_c


def moe(h, router_w, router_b, w1, b1, w2, b2):
    t, d = h.shape
    logits = (h @ router_w + router_b).astype(jnp.float32)
    top_val, top_idx = lax.top_k(logits, TOP_K)
    wts = jax.nn.softmax(top_val, axis=-1)
    flat_e = top_idx.reshape(-1)
    flat_tok = jnp.repeat(jnp.arange(t, dtype=jnp.int32), TOP_K)
    flat_w = wts.reshape(-1)
    order = jnp.argsort(flat_e)
    se, stok, sw = flat_e[order], flat_tok[order], flat_w[order]
    counts = jnp.zeros((N_EXPERTS,), jnp.int32).at[flat_e].add(1)
    starts = jnp.cumsum(counts) - counts
    padded = (counts + MOE_BLOCK - 1) // MOE_BLOCK * MOE_BLOCK
    pends = jnp.cumsum(padded)
    pstarts = pends - padded
    dest = pstarts[se] + jnp.arange(t * TOP_K, dtype=jnp.int32) - starts[se]
    n_blocks = -(-(t * TOP_K) // MOE_BLOCK) + N_EXPERTS
    n_slots = n_blocks * MOE_BLOCK
    slot_tok = jnp.full((n_slots,), t, jnp.int32).at[dest].set(stok)
    slot_w = jnp.zeros((n_slots,), jnp.float32).at[dest].set(sw)
    block_e = jnp.clip(jnp.searchsorted(pends, jnp.arange(n_blocks) * MOE_BLOCK, side='right'),
                       0, N_EXPERTS - 1)
    hp = jnp.concatenate([h, jnp.zeros((1, d), h.dtype)], axis=0)
    xs = hp[slot_tok].reshape(n_blocks, MOE_BLOCK, d)

    def expert_block(args):
        xb, e = args
        gu = xb @ w1[e] + b1[e]
        gate = jnp.minimum(gu[:, :D_FF], SWIGLU_LIMIT)
        lin = jnp.clip(gu[:, D_FF:], -SWIGLU_LIMIT, SWIGLU_LIMIT)
        act = gate * jax.nn.sigmoid(SWIGLU_ALPHA * gate) * (lin + 1.0)
        return (act @ w2[e] + b2[e]).astype(jnp.float32)

    ys = lax.map(expert_block, (xs, block_e)).reshape(n_slots, d)
    out = jnp.zeros((t + 1, d), jnp.float32).at[slot_tok].add(ys * slot_w[:, None])
    return out[:t]


def setup_inputs(seed: int = 0) -> dict:
    key = jax.random.key(seed)
    ks = iter(jax.random.split(key, 32))
    nrm = lambda shape, scale: scale * jax.random.normal(next(ks), shape, jnp.float32)
    L, D = DEPTH, D_MODEL
    pg = POOL_WIDTH // POOL_GROUPS
    x = nrm((BATCH, SEQ, D), 1.0)
    c = nrm((BATCH, D), 1.0)
    ctx = nrm((BATCH, CTX_LEN, D), 1.0)
    c_ctx = nrm((D,), 1.0)
    w_ada = nrm((L, D, N_ADA * D), 0.5 * D ** -0.5)
    b_ada = nrm((L, N_ADA * D), 0.02)
    norm1_w = 1.0 + nrm((L, D), 0.02)
    norm2_w = 1.0 + nrm((L, D), 0.02)
    w_in = nrm((L, D, IN_COLS), D ** -0.5)
    pool_w = nrm((L, POOL_GROUPS, pg, pg), pg ** -0.5)
    pool_scale = 1.0 + nrm((L, POOL_WIDTH), 0.1)
    conv_w = nrm((L, SSM_CONV, CONV_DIM), SSM_CONV ** -0.5)
    conv_b = nrm((L, CONV_DIM), 0.02)
    dt0 = jnp.exp(jax.random.uniform(next(ks), (L, 2, SSM_HEADS), jnp.float32,
                                     minval=math.log(1e-3), maxval=math.log(1e-1)))
    dt_bias = dt0 + jnp.log(-jnp.expm1(-dt0))
    a_log = jnp.log(jax.random.uniform(next(ks), (L, 2, SSM_HEADS), jnp.float32, minval=1.0, maxval=16.0))
    d_skip = 1.0 + nrm((L, SSM_HEADS), 0.1)
    ssm_norm_w = 1.0 + nrm((L, SSM_INNER), 0.02)
    w_branch = nrm((L, N_BRANCH, BRANCH_WIDTH, D), BRANCH_WIDTH ** -0.5)
    w_out = nrm((L, D, D), D ** -0.5)
    router_w = nrm((L, D, N_EXPERTS), D ** -0.5)
    router_b = nrm((L, N_EXPERTS), 0.01)
    moe_w1 = nrm((L, N_EXPERTS, D, 2 * D_FF), D ** -0.5)
    moe_b1 = nrm((L, N_EXPERTS, 2 * D_FF), 0.02)
    moe_w2 = nrm((L, N_EXPERTS, D_FF, D), D_FF ** -0.5)
    moe_b2 = nrm((L, N_EXPERTS, D), 0.02)
    final_norm_w = 1.0 + nrm((D,), 0.02)
    return {'x': x, 'c': c, 'ctx': ctx, 'c_ctx': c_ctx, 'w_ada': w_ada, 'b_ada': b_ada,
            'norm1_w': norm1_w, 'norm2_w': norm2_w, 'w_in': w_in, 'pool_w': pool_w,
            'pool_scale': pool_scale, 'conv_w': conv_w, 'conv_b': conv_b, 'dt_bias': dt_bias,
            'a_log': a_log, 'd_skip': d_skip, 'ssm_norm_w': ssm_norm_w, 'w_branch': w_branch,
            'w_out': w_out, 'router_w': router_w, 'router_b': router_b, 'moe_w1': moe_w1,
            'moe_b1': moe_b1, 'moe_w2': moe_w2, 'moe_b2': moe_b2, 'final_norm_w': final_norm_w}


def reference(x, c, ctx, c_ctx, w_ada, b_ada, norm1_w, norm2_w, w_in, pool_w, pool_scale,
              conv_w, conv_b, dt_bias, a_log, d_skip, ssm_norm_w, w_branch, w_out,
              router_w, router_b, moe_w1, moe_b1, moe_w2, moe_b2, final_norm_w):
    b, n, d = x.shape
    lat, cx = x, ctx
    for i in range(DEPTH):
        last = i == DEPTH - 1
        mod_l = (jax.nn.silu(c.astype(jnp.float32)) @ w_ada[i] + b_ada[i]).reshape(b, N_ADA, 1, d)
        mod_c = (jax.nn.silu(c_ctx.astype(jnp.float32)) @ w_ada[i] + b_ada[i]).reshape(N_ADA, 1, 1, d)
        hl = modulate(rms_norm(lat, norm1_w[i]), mod_l[:, 0], mod_l[:, 1])
        hc = modulate(rms_norm(cx, norm1_w[i]), mod_c[0], mod_c[1])
        ol, oc = token_mixer(hl, hc, w_in[i], pool_w[i], pool_scale[i], conv_w[i], conv_b[i],
                             dt_bias[i], a_log[i], d_skip[i], ssm_norm_w[i], w_branch[i], w_out[i],
                             not last)
        lat = lat + (mod_l[:, 2] * ol).astype(lat.dtype)
        hl = modulate(rms_norm(lat, norm2_w[i]), mod_l[:, 3], mod_l[:, 4])
        if last:
            fl = moe(hl.reshape(-1, d), router_w[i], router_b[i], moe_w1[i], moe_b1[i],
                     moe_w2[i], moe_b2[i])
        else:
            cx = cx + (mod_c[2] * oc).astype(cx.dtype)
            hc = modulate(rms_norm(cx, norm2_w[i]), mod_c[3], mod_c[4])
            f = moe(jnp.concatenate([hl.reshape(-1, d), hc.reshape(-1, d)], axis=0), router_w[i],
                    router_b[i], moe_w1[i], moe_b1[i], moe_w2[i], moe_b2[i])
            fl = f[:b * n]
            cx = cx + (mod_c[5] * f[b * n:].reshape(b, -1, d)).astype(cx.dtype)
        lat = lat + (mod_l[:, 5] * fl.reshape(b, n, d)).astype(lat.dtype)
    return rms_norm(lat, final_norm_w).astype(x.dtype)
```

```cpp
#include <hip/hip_runtime.h>
#include <hip/hip_cooperative_groups.h>
#include <cstdio>
#include <cstdint>
#include <cstring>

typedef unsigned short bf16_t;
typedef short bf16x8 __attribute__((ext_vector_type(8)));
typedef float f32x4 __attribute__((ext_vector_type(4)));

constexpr int D = 1024, NB = 2, SEQ = 8192, TL = NB * SEQ, CTXL = 256, TC = NB * CTXL, T = TL + TC;
constexpr int DEPTH = 2, NE = 32, TOPK = 4, NH = 16, HD = 64, NS = 128;
constexpr int IN_COLS = 8224, UC = 8192;
constexpr int U_FOUR = 1024, U_Z = 2048, U_XBC = 3072, U_GATE = 5120;
constexpr int WIN_ROWS = 8320;
constexpr float RMS_EPS = 1e-6f;
constexpr int LDS_BYTES = 65536;

struct Params {
    const float *x, *c, *ctx, *c_ctx, *w_ada, *b_ada, *norm1_w, *norm2_w, *w_in, *pool_w, *pool_scale, *conv_w, *conv_b, *dt_bias, *a_log,
        *d_skip, *ssm_norm_w, *w_branch, *w_out, *router_w, *router_b, *moe_w1, *moe_b1, *moe_w2, *moe_b2, *final_norm_w;
    float* out;
    unsigned* bar; int* cnt;
    float *mod, *res, *dt, *ybuf, *ycraw, *topw;
    bf16_t *h, *w_in_t, *w_br_t, *w_out_t, *pool_w_t, *w1_t, *w2_t, *cs_t, *U, *V, *Dp, *ya, *Yb, *yb, *yc, *m, *act, *sout;
    int *topi, *list;
};

__device__ __forceinline__ float bf2f(bf16_t u) { return __uint_as_float(((unsigned)u) << 16); }
__device__ __forceinline__ bf16_t f2bf(float f) { unsigned u = __float_as_uint(f); u += 0x7fffu + ((u >> 16) & 1u); return (bf16_t)(u >> 16); }
__device__ __forceinline__ unsigned pack2(float a, float b) { return (unsigned)f2bf(a) | ((unsigned)f2bf(b) << 16); }
__device__ __forceinline__ float lo16(unsigned u) { return __uint_as_float(u << 16); }
__device__ __forceinline__ float hi16(unsigned u) { return __uint_as_float(u & 0xffff0000u); }
__device__ __forceinline__ float sigmoidf_(float x) { return 1.0f / (1.0f + __expf(-x)); }
__device__ __forceinline__ float siluf_(float x) { return x / (1.0f + __expf(-x)); }
__device__ __forceinline__ float softplusf_(float x) { return x > 20.f ? x : log1pf(__expf(x)); }
__device__ __forceinline__ int modrow(int row) { return row < TL ? (row / SEQ) : 2; }
__device__ __forceinline__ const float* modp(const Params& p, int layer, int mrow, int j) { return p.mod + ((size_t)((layer * 3 + mrow) * 6 + j)) * D; }
__device__ __forceinline__ float wave_sum(float v) {
#pragma unroll
    for (int o = 32; o >= 1; o >>= 1) v += __shfl_xor(v, o);
    return v;
}

__device__ __forceinline__ int colmap(int mode, int j) {
    if (mode == 0) return j;
    if (mode == 1) { if (j < 5120) return j; if (j < 8192) return j + 32; if (j < 8224) return 5120 + (j - 8192); return -1; }
    const int Tn = j >> 7, wc = (j >> 6) & 1, jj = j & 63;
    return (jj < 32) ? (Tn * 64 + wc * 32 + jj) : (1024 + Tn * 64 + wc * 32 + (jj - 32));
}
__device__ void convert_tile(const float* __restrict__ src, int ld, bf16_t* __restrict__ dst, int K, int n0, int k0, int mode, char* lds) {
    float* tile = (float*)lds;
    const int tx = threadIdx.x & 63, ty = threadIdx.x >> 6;
    const int sc = colmap(mode, n0 + tx);
    for (int kk = ty; kk < 64; kk += 4) tile[kk * 65 + tx] = sc >= 0 ? src[(size_t)(k0 + kk) * ld + sc] : 0.f;
    __syncthreads();
    for (int r = ty; r < 64; r += 4) dst[(size_t)(n0 + r) * K + k0 + tx] = f2bf(tile[tx * 65 + r]);
    __syncthreads();
}
constexpr int CV_WIN = (WIN_ROWS / 64) * 16, CV_BR = 3 * 256, CV_OUT = 256, CV_POOL = 4 * 16, CV_W1 = NE * 32 * 16, CV_W2 = NE * 256;
constexpr int CV_LAYER = CV_WIN + CV_BR + CV_OUT + CV_POOL + CV_W1 + CV_W2;
constexpr int N_CONVERT = DEPTH * CV_LAYER;
__device__ void stage_convert(const Params& p, int item, char* lds) {
    const int l = item / CV_LAYER; int w = item % CV_LAYER;
    if (w < CV_WIN) { convert_tile(p.w_in + (size_t)l * D * IN_COLS, IN_COLS, p.w_in_t + (size_t)l * WIN_ROWS * D, D, (w / 16) * 64, (w % 16) * 64, 1, lds); return; }
    w -= CV_WIN;
    if (w < CV_BR) { const int k = w / 256, t = w % 256; convert_tile(p.w_branch + (size_t)(l * 3 + k) * D * D, D, p.w_br_t + (size_t)(l * 3 + k) * D * D, D, (t / 16) * 64, (t % 16) * 64, 0, lds); return; }
    w -= CV_BR;
    if (w < CV_OUT) { convert_tile(p.w_out + (size_t)l * D * D, D, p.w_out_t + (size_t)l * D * D, D, (w / 16) * 64, (w % 16) * 64, 0, lds); return; }
    w -= CV_OUT;
    if (w < CV_POOL) { const int g = w / 16, t = w % 16; convert_tile(p.pool_w + (size_t)(l * 4 + g) * 65536, 256, p.pool_w_t + (size_t)(l * 4 + g) * 65536, 256, (t / 4) * 64, (t % 4) * 64, 0, lds); return; }
    w -= CV_POOL;
    if (w < CV_W1) { const int e = w / 512, t = w % 512; convert_tile(p.moe_w1 + (size_t)(l * NE + e) * D * 2048, 2048, p.w1_t + (size_t)(l * NE + e) * 2048 * D, D, (t / 16) * 64, (t % 16) * 64, 2, lds); return; }
    w -= CV_W1;
    { const int e = w / 256, t = w % 256; convert_tile(p.moe_w2 + (size_t)(l * NE + e) * D * D, D, p.w2_t + (size_t)(l * NE + e) * D * D, D, (t / 16) * 64, (t % 16) * 64, 0, lds); }
}
constexpr int N_TABLE = 256 * 512 / 256;
__device__ void stage_table(const Params& p, int item) {
    const int idx = item * 256 + threadIdx.x, m = idx >> 9, kk = idx & 511, ro = kk >> 8, c = kk & 255;
    const float ang = 6.283185307179586f * (float)((m * c) & 255) * (1.0f / 256.0f);
    p.cs_t[idx] = f2bf((ro ? sinf(ang) : cosf(ang)) * 0.0625f);
}
constexpr int N_ADA = DEPTH * 6144 / 256;
__device__ void stage_ada(const Params& p, int item, char* lds) {
    float* sc = (float*)lds;
    for (int i = threadIdx.x; i < 3 * D; i += 256) { const int r = i / D, k = i % D; const float v = r < 2 ? p.c[r * D + k] : p.c_ctx[k]; sc[i] = siluf_(v); }
    __syncthreads();
    const int l = item / 24, col = (item % 24) * 256 + threadIdx.x;
    const float* w = p.w_ada + (size_t)l * D * 6144 + col;
    float a0 = 0.f, a1 = 0.f, a2 = 0.f;
#pragma unroll 8
    for (int k = 0; k < D; ++k) { const float wv = w[(size_t)k * 6144]; a0 += sc[k] * wv; a1 += sc[D + k] * wv; a2 += sc[2 * D + k] * wv; }
    const float b = p.b_ada[l * 6144 + col];
    p.mod[(size_t)(l * 3 + 0) * 6144 + col] = a0 + b; p.mod[(size_t)(l * 3 + 1) * 6144 + col] = a1 + b; p.mod[(size_t)(l * 3 + 2) * 6144 + col] = a2 + b;
    __syncthreads();
}

constexpr int N_ROWNORM = T / 4;
template <int MODE>
__device__ void stage_rownorm(const Params& p, int layer, int item) {
    const int wave = threadIdx.x >> 6, lane = threadIdx.x & 63, row = item * 4 + wave, mrow = modrow(row);
    const float* src = MODE == 0 ? (row < TL ? p.x + (size_t)row * D : p.ctx + (size_t)(row - TL) * D) : p.res + (size_t)row * D;
    f32x4 v[4];
#pragma unroll
    for (int j = 0; j < 4; ++j) v[j] = *(const f32x4*)(src + 4 * lane + 256 * j);
    if (MODE >= 1) {
        const int pl = MODE == 1 ? layer - 1 : layer;
        const float* g2 = modp(p, pl, mrow, 5);
#pragma unroll
        for (int j = 0; j < 4; ++j) {
            const int k = 4 * lane + 256 * j; f32x4 s = {0.f, 0.f, 0.f, 0.f};
#pragma unroll
            for (int kk = 0; kk < 4; ++kk) { const uint2 q = *(const uint2*)(p.sout + ((size_t)row * 4 + kk) * D + k); s[0] += lo16(q.x); s[1] += hi16(q.x); s[2] += lo16(q.y); s[3] += hi16(q.y); }
            const f32x4 g = *(const f32x4*)(g2 + k); v[j] += g * s;
        }
    }
    if (MODE != 2) {
#pragma unroll
        for (int j = 0; j < 4; ++j) *(f32x4*)(p.res + (size_t)row * D + 4 * lane + 256 * j) = v[j];
    }
    float ss = 0.f;
#pragma unroll
    for (int j = 0; j < 4; ++j) ss += v[j][0] * v[j][0] + v[j][1] * v[j][1] + v[j][2] * v[j][2] + v[j][3] * v[j][3];
    ss = wave_sum(ss);
    const float rinv = rsqrtf(ss * (1.0f / D) + RMS_EPS);
    if (MODE == 2) {
        if (row < TL) {
#pragma unroll
            for (int j = 0; j < 4; ++j) { const int k = 4 * lane + 256 * j; const f32x4 w = *(const f32x4*)(p.final_norm_w + k); *(f32x4*)(p.out + (size_t)row * D + k) = v[j] * rinv * w; }
        }
    } else {
        const float* nw = p.norm1_w + layer * D; const float* sh = modp(p, layer, mrow, 0); const float* sc = modp(p, layer, mrow, 1);
#pragma unroll
        for (int j = 0; j < 4; ++j) {
            const int k = 4 * lane + 256 * j;
            const f32x4 w = *(const f32x4*)(nw + k), a = *(const f32x4*)(sc + k), b = *(const f32x4*)(sh + k);
            const f32x4 hv = v[j] * rinv * w * (a + 1.0f) + b;
            uint2 q; q.x = pack2(hv[0], hv[1]); q.y = pack2(hv[2], hv[3]);
            *(uint2*)(p.h + (size_t)row * D + k) = q;
        }
    }
}

__device__ __forceinline__ void gemm_kloop(f32x4 (&acc)[4][4], const bf16_t* pa0, const bf16_t* pa1, const bf16_t* pb0, const bf16_t* pb1, int K, char* lds) {
    const int tid = threadIdx.x, wid = tid >> 6, lane = tid & 63, wr = wid >> 1, wc = wid & 1, fr = lane & 15, fq = lane >> 4;
    char* SA = lds; char* SB = lds + 8192;
    for (int kt = 0; kt < K; kt += 32) {
        __builtin_amdgcn_global_load_lds((const unsigned*)(pa0 + kt), (unsigned*)(SA + tid * 16), 16, 0, 0);
        __builtin_amdgcn_global_load_lds((const unsigned*)(pa1 + kt), (unsigned*)(SA + 4096 + tid * 16), 16, 0, 0);
        __builtin_amdgcn_global_load_lds((const unsigned*)(pb0 + kt), (unsigned*)(SB + tid * 16), 16, 0, 0);
        __builtin_amdgcn_global_load_lds((const unsigned*)(pb1 + kt), (unsigned*)(SB + 4096 + tid * 16), 16, 0, 0);
        asm volatile("s_waitcnt vmcnt(0)" ::: "memory");
        __syncthreads();
        bf16x8 af[4], bfr[4];
#pragma unroll
        for (int m = 0; m < 4; ++m) af[m] = *(const bf16x8*)(SA + (wr * 64 + m * 16 + fr) * 64 + fq * 16);
#pragma unroll
        for (int n = 0; n < 4; ++n) bfr[n] = *(const bf16x8*)(SB + (wc * 64 + n * 16 + fr) * 64 + fq * 16);
#pragma unroll
        for (int m = 0; m < 4; ++m)
#pragma unroll
            for (int n = 0; n < 4; ++n) acc[m][n] = __builtin_amdgcn_mfma_f32_16x16x32_bf16(bfr[n], af[m], acc[m][n], 0, 0, 0);
        __syncthreads();
    }
}
__device__ __forceinline__ void zero_acc(f32x4 (&acc)[4][4]) {
#pragma unroll
    for (int m = 0; m < 4; ++m)
#pragma unroll
        for (int n = 0; n < 4; ++n) acc[m][n] = (f32x4){0.f, 0.f, 0.f, 0.f};
}
#define GEMM_LANE_VARS const int tid = threadIdx.x, wid = tid >> 6, lane = tid & 63, wr = wid >> 1, wc = wid & 1, fr = lane & 15, fq = lane >> 4; (void)wr; (void)wc; (void)fr; (void)fq; \
    const int ar0 = tid >> 2, ar1 = ar0 + 64, ac = (tid & 3) * 8;

constexpr int NM_T = T / 128, N_INPROJ = ((NM_T + 15) / 16) * 16 * 65;
__device__ void stage_inproj(const Params& p, int layer, int item, char* lds) {
    GEMM_LANE_VARS
    const int grp = item / (16 * 65), w = item % (16 * 65);
    int mt, nt;
    { const int gsz = (NM_T - grp * 16) < 16 ? (NM_T - grp * 16) : 16; mt = grp * 16 + (w % gsz); nt = w / gsz; }
    if (nt >= 65) return;
    const bf16_t* A = p.h + (size_t)(mt * 128) * D; const bf16_t* B = p.w_in_t + ((size_t)layer * WIN_ROWS + nt * 128) * D;
    f32x4 acc[4][4]; zero_acc(acc);
    gemm_kloop(acc, A + (size_t)ar0 * D + ac, A + (size_t)ar1 * D + ac, B + (size_t)ar0 * D + ac, B + (size_t)ar1 * D + ac, D, lds);
#pragma unroll
    for (int m = 0; m < 4; ++m) {
        const int row = mt * 128 + wr * 64 + m * 16 + fr;
#pragma unroll
        for (int n = 0; n < 4; ++n) {
            const int cl = wc * 64 + n * 16 + 4 * fq; f32x4 v = acc[m][n];
            if (nt < 64) {
                const int gc = nt * 128 + cl;
                if (gc >= U_GATE) { v[0] = sigmoidf_(v[0]); v[1] = sigmoidf_(v[1]); v[2] = sigmoidf_(v[2]); v[3] = sigmoidf_(v[3]); }
                uint2 q; q.x = pack2(v[0], v[1]); q.y = pack2(v[2], v[3]);
                *(uint2*)(p.U + (size_t)row * UC + gc) = q;
            } else if (cl < 32) {
                const f32x4 b = *(const f32x4*)(p.dt_bias + layer * 32 + cl);
                f32x4 o; o[0] = softplusf_(v[0] + b[0]); o[1] = softplusf_(v[1] + b[1]); o[2] = softplusf_(v[2] + b[2]); o[3] = softplusf_(v[3] + b[3]);
                *(f32x4*)(p.dt + (size_t)row * 32 + cl) = o;
            }
        }
    }
}
constexpr int N_G1024 = NM_T * 8;
template <int MODE>
__device__ void stage_gemm_small(const Params& p, int layer, int item, char* lds) {
    GEMM_LANE_VARS
    const int mt = item >> 3, nt = item & 7, g = nt >> 1;
    const bf16_t *A, *B; int lda, ldb, K;
    if (MODE == 0) { A = p.Dp + (size_t)(mt * 128) * D + g * 256; lda = D; K = 256; ldb = 256; B = p.pool_w_t + (size_t)(layer * 4 + g) * 65536 + (size_t)((nt & 1) * 128) * 256; }
    else           { A = p.Yb + (size_t)(mt * 128) * 2048 + g * 512; lda = 2048; K = 512; ldb = 512; B = p.cs_t + (size_t)((nt & 1) * 128) * 512; }
    f32x4 acc[4][4]; zero_acc(acc);
    gemm_kloop(acc, A + (size_t)ar0 * lda + ac, A + (size_t)ar1 * lda + ac, B + (size_t)ar0 * ldb + ac, B + (size_t)ar1 * ldb + ac, K, lds);
    bf16_t* O = MODE == 0 ? p.ya : p.yb;
#pragma unroll
    for (int m = 0; m < 4; ++m) {
        const int row = mt * 128 + wr * 64 + m * 16 + fr;
#pragma unroll
        for (int n = 0; n < 4; ++n) {
            const int col = nt * 128 + wc * 64 + n * 16 + 4 * fq; f32x4 v = acc[m][n];
            if (MODE == 0) { const f32x4 s = *(const f32x4*)(p.pool_scale + layer * D + col); v *= s; }
            uint2 q; q.x = pack2(v[0], v[1]); q.y = pack2(v[2], v[3]);
            *(uint2*)(O + (size_t)row * D + col) = q;
        }
    }
}
__device__ void stage_merge(const Params& p, int layer, int item, char* lds) {
    GEMM_LANE_VARS
    const int mt = item >> 3, nt = item & 7;
    f32x4 macc[4][4]; zero_acc(macc);
#pragma unroll 1
    for (int k = 0; k < 3; ++k) {
        const bf16_t* A = (k == 0 ? p.ya : (k == 1 ? p.yb : p.yc)) + (size_t)(mt * 128) * D;
        const bf16_t* B = p.w_br_t + ((size_t)(layer * 3 + k) * D + nt * 128) * D;
        f32x4 acc[4][4]; zero_acc(acc);
        gemm_kloop(acc, A + (size_t)ar0 * D + ac, A + (size_t)ar1 * D + ac, B + (size_t)ar0 * D + ac, B + (size_t)ar1 * D + ac, D, lds);
#pragma unroll
        for (int m = 0; m < 4; ++m) {
            const int row = mt * 128 + wr * 64 + m * 16 + fr;
#pragma unroll
            for (int n = 0; n < 4; ++n) {
                const int col = nt * 128 + wc * 64 + n * 16 + 4 * fq;
                const uint2 q = *(const uint2*)(p.U + (size_t)row * UC + U_GATE + k * D + col);
                macc[m][n][0] += lo16(q.x) * acc[m][n][0]; macc[m][n][1] += hi16(q.x) * acc[m][n][1];
                macc[m][n][2] += lo16(q.y) * acc[m][n][2]; macc[m][n][3] += hi16(q.y) * acc[m][n][3];
            }
        }
    }
#pragma unroll
    for (int m = 0; m < 4; ++m) {
        const int row = mt * 128 + wr * 64 + m * 16 + fr;
#pragma unroll
        for (int n = 0; n < 4; ++n) {
            const int col = nt * 128 + wc * 64 + n * 16 + 4 * fq;
            uint2 q; q.x = pack2(macc[m][n][0], macc[m][n][1]); q.y = pack2(macc[m][n][2], macc[m][n][3]);
            *(uint2*)(p.m + (size_t)row * D + col) = q;
        }
    }
}
__device__ void stage_outproj(const Params& p, int layer, int item, char* lds) {
    GEMM_LANE_VARS
    const int mt = item >> 3, nt = item & 7;
    const bf16_t* A = p.m + (size_t)(mt * 128) * D; const bf16_t* B = p.w_out_t + ((size_t)layer * D + nt * 128) * D;
    f32x4 acc[4][4]; zero_acc(acc);
    gemm_kloop(acc, A + (size_t)ar0 * D + ac, A + (size_t)ar1 * D + ac, B + (size_t)ar0 * D + ac, B + (size_t)ar1 * D + ac, D, lds);
#pragma unroll
    for (int m = 0; m < 4; ++m) {
        const int row = mt * 128 + wr * 64 + m * 16 + fr; const float* g1 = modp(p, layer, modrow(row), 2);
#pragma unroll
        for (int n = 0; n < 4; ++n) {
            const int col = nt * 128 + wc * 64 + n * 16 + 4 * fq;
            float* r = p.res + (size_t)row * D + col;
            const f32x4 g = *(const f32x4*)(g1 + col); *(f32x4*)r = *(const f32x4*)r + g * acc[m][n];
        }
    }
}
struct MoeTile { int e, mt, nt, cnt, off; };
template <int NT>
__device__ __forceinline__ bool moe_decode(const Params& p, int layer, int item, MoeTile& t) {
    const int mg = item / NT; t.nt = item % NT;
    int accm = 0, off = 0;
    for (int e = 0; e < NE; ++e) {
        const int c = p.cnt[layer * NE + e], mtn = (c + 127) >> 7;
        if (mg < accm + mtn) { t.e = e; t.mt = mg - accm; t.cnt = c; t.off = off; return true; }
        accm += mtn; off += c;
    }
    return false;
}
__device__ __forceinline__ int moe_total_mtiles(const Params& p, int layer) { int s = 0; for (int e = 0; e < NE; ++e) s += (p.cnt[layer * NE + e] + 127) >> 7; return s; }
__device__ void stage_moe1(const Params& p, int layer, int item, char* lds) {
    GEMM_LANE_VARS
    MoeTile t; if (!moe_decode<16>(p, layer, item, t)) return;
    const int* lst = p.list + (size_t)(layer * NE + t.e) * T;
    const int i0 = t.mt * 128 + ar0, i1 = t.mt * 128 + ar1;
    const int tok0 = lst[i0 < t.cnt ? i0 : t.cnt - 1] >> 2, tok1 = lst[i1 < t.cnt ? i1 : t.cnt - 1] >> 2;
    const bf16_t* B = p.w1_t + ((size_t)(layer * NE + t.e) * 2048 + t.nt * 128) * D;
    f32x4 acc[4][4]; zero_acc(acc);
    gemm_kloop(acc, p.h + (size_t)tok0 * D + ac, p.h + (size_t)tok1 * D + ac, B + (size_t)ar0 * D + ac, B + (size_t)ar1 * D + ac, D, lds);
    const float* b1 = p.moe_b1 + (size_t)(layer * NE + t.e) * 2048;
#pragma unroll
    for (int m = 0; m < 4; ++m) {
        const int i = t.mt * 128 + wr * 64 + m * 16 + fr;
        if (i < t.cnt) {
#pragma unroll
            for (int n = 0; n < 2; ++n) {
                const int gc = t.nt * 64 + wc * 32 + n * 16 + 4 * fq;
                const f32x4 bg = *(const f32x4*)(b1 + gc), bl = *(const f32x4*)(b1 + 1024 + gc);
                float o[4];
#pragma unroll
                for (int j = 0; j < 4; ++j) {
                    const float g = fminf(acc[m][n][j] + bg[j], 7.0f), l = fminf(fmaxf(acc[m][n + 2][j] + bl[j], -7.0f), 7.0f);
                    o[j] = g * sigmoidf_(1.702f * g) * (l + 1.0f);
                }
                uint2 q; q.x = pack2(o[0], o[1]); q.y = pack2(o[2], o[3]);
                *(uint2*)(p.act + (size_t)(t.off + i) * D + gc) = q;
            }
        }
    }
}
__device__ void stage_moe2(const Params& p, int layer, int item, char* lds) {
    GEMM_LANE_VARS
    MoeTile t; if (!moe_decode<8>(p, layer, item, t)) return;
    const int* lst = p.list + (size_t)(layer * NE + t.e) * T;
    const int i0 = t.mt * 128 + ar0, i1 = t.mt * 128 + ar1;
    const bf16_t* A0 = p.act + (size_t)(t.off + (i0 < t.cnt ? i0 : t.cnt - 1)) * D + ac; const bf16_t* A1 = p.act + (size_t)(t.off + (i1 < t.cnt ? i1 : t.cnt - 1)) * D + ac;
    const bf16_t* B = p.w2_t + ((size_t)(layer * NE + t.e) * D + t.nt * 128) * D;
    f32x4 acc[4][4]; zero_acc(acc);
    gemm_kloop(acc, A0, A1, B + (size_t)ar0 * D + ac, B + (size_t)ar1 * D + ac, D, lds);
    const float* b2 = p.moe_b2 + (size_t)(layer * NE + t.e) * D;
#pragma unroll
    for (int m = 0; m < 4; ++m) {
        const int i = t.mt * 128 + wr * 64 + m * 16 + fr;
        if (i < t.cnt) {
            const int pair = lst[i]; const float w = p.topw[pair];
#pragma unroll
            for (int n = 0; n < 4; ++n) {
                const int col = t.nt * 128 + wc * 64 + n * 16 + 4 * fq;
                const f32x4 b = *(const f32x4*)(b2 + col); const f32x4 v = (acc[m][n] + b) * w;
                uint2 q; q.x = pack2(v[0], v[1]); q.y = pack2(v[2], v[3]);
                *(uint2*)(p.sout + (size_t)pair * D + col) = q;
            }
        }
    }
}

constexpr int N_CONV = T / 32;
__device__ void stage_conv(const Params& p, int layer, int item) {
    const int c0 = threadIdx.x * 8, r0 = item * 32;
    const int seq0 = r0 < TL ? (r0 / SEQ) * SEQ : TL + ((r0 - TL) / CTXL) * CTXL, seq1 = seq0 + (r0 < TL ? SEQ : CTXL);
    float w[5][8], bias[8];
#pragma unroll
    for (int j = 0; j < 5; ++j) { const f32x4 a = *(const f32x4*)(p.conv_w + (size_t)(layer * 5 + j) * 2048 + c0), b = *(const f32x4*)(p.conv_w + (size_t)(layer * 5 + j) * 2048 + c0 + 4);
        w[j][0] = a[0]; w[j][1] = a[1]; w[j][2] = a[2]; w[j][3] = a[3]; w[j][4] = b[0]; w[j][5] = b[1]; w[j][6] = b[2]; w[j][7] = b[3]; }
    { const f32x4 a = *(const f32x4*)(p.conv_b + layer * 2048 + c0), b = *(const f32x4*)(p.conv_b + layer * 2048 + c0 + 4);
      bias[0] = a[0]; bias[1] = a[1]; bias[2] = a[2]; bias[3] = a[3]; bias[4] = b[0]; bias[5] = b[1]; bias[6] = b[2]; bias[7] = b[3]; }
    float win[5][8];
    auto ldrow = [&](int r, float (&o)[8]) {
        if (r >= seq0 && r < seq1) { const uint4 q = *(const uint4*)(p.U + (size_t)r * UC + U_XBC + c0);
            o[0] = lo16(q.x); o[1] = hi16(q.x); o[2] = lo16(q.y); o[3] = hi16(q.y); o[4] = lo16(q.z); o[5] = hi16(q.z); o[6] = lo16(q.w); o[7] = hi16(q.w); }
        else {
#pragma unroll
            for (int i = 0; i < 8; ++i) o[i] = 0.f; }
    };
    ldrow(r0 - 2, win[0]); ldrow(r0 - 1, win[1]); ldrow(r0, win[2]); ldrow(r0 + 1, win[3]);
#pragma unroll 4
    for (int r = r0; r < r0 + 32; ++r) {
        ldrow(r + 2, win[4]);
        float o[8];
#pragma unroll
        for (int i = 0; i < 8; ++i) { float s = bias[i];
#pragma unroll
            for (int j = 0; j < 5; ++j) s += w[j][i] * win[j][i];
            o[i] = siluf_(s); }
        uint4 q; q.x = pack2(o[0], o[1]); q.y = pack2(o[2], o[3]); q.z = pack2(o[4], o[5]); q.w = pack2(o[6], o[7]);
        *(uint4*)(p.V + (size_t)r * 2048 + c0) = q;
#pragma unroll
        for (int j = 0; j < 4; ++j)
#pragma unroll
            for (int i = 0; i < 8; ++i) win[j][i] = win[j + 1][i];
    }
}

constexpr int N_POOL = T / 2;
__device__ void stage_pool(const Params& p, int item) {
    const int row = item * 2 + (threadIdx.x >> 7), oc = threadIdx.x & 127, c0 = oc * 8, g = oc >> 5, w = 2 << g, lo = -(w >> 1), hi = w - (w >> 1) - 1;
    float s[8];
#pragma unroll
    for (int i = 0; i < 8; ++i) s[i] = 0.f;
    int cntw = 0;
    auto addrow = [&](int r) { const uint4 q = *(const uint4*)(p.U + (size_t)r * UC + c0);
        s[0] += lo16(q.x); s[1] += hi16(q.x); s[2] += lo16(q.y); s[3] += hi16(q.y); s[4] += lo16(q.z); s[5] += hi16(q.z); s[6] += lo16(q.w); s[7] += hi16(q.w); ++cntw; };
    if (row < TL) {
        const int b = row / SEQ, n = row % SEQ, gr = n >> 6, gc = n & 63;
        const int r0 = max(gr + lo, 0), r1 = min(gr + hi, 127), cc0 = max(gc + lo, 0), cc1 = min(gc + hi, 63);
        for (int rr = r0; rr <= r1; ++rr) for (int cc = cc0; cc <= cc1; ++cc) addrow(b * SEQ + rr * 64 + cc);
    } else {
        const int b = (row - TL) / CTXL, n = (row - TL) % CTXL;
        const int t0 = max(n + lo, 0), t1 = min(n + hi, CTXL - 1);
        for (int tt = t0; tt <= t1; ++tt) addrow(TL + b * CTXL + tt);
    }
    const float inv = 1.0f / (float)cntw;
    const uint4 q = *(const uint4*)(p.U + (size_t)row * UC + c0);
    float o[8] = {s[0] * inv - lo16(q.x), s[1] * inv - hi16(q.x), s[2] * inv - lo16(q.y), s[3] * inv - hi16(q.y), s[4] * inv - lo16(q.z), s[5] * inv - hi16(q.z), s[6] * inv - lo16(q.w), s[7] * inv - hi16(q.w)};
    uint4 r; r.x = pack2(o[0], o[1]); r.y = pack2(o[2], o[3]); r.z = pack2(o[4], o[5]); r.w = pack2(o[6], o[7]);
    *(uint4*)(p.Dp + (size_t)row * D + c0) = r;
}

constexpr int N_FOUR_LAT = NB * 256 * 16, N_FOUR = N_FOUR_LAT + NB * 8 * 16;
__device__ void four_table(char* lds) { float* tab = (float*)lds; for (int i = threadIdx.x; i < 8192; i += 256) tab[i] = cosf(6.283185307179586f * (float)i * (1.0f / 8192.0f)); __syncthreads(); }
__device__ void stage_fourier_naive(const Params& p, int item, char* lds) {
    const float* tab = (const float*)lds;
    int b, kt, cch, N, rowbase, mult; float scale;
    if (item < N_FOUR_LAT) { b = item / 4096; const int w = item % 4096; kt = w / 16; cch = w % 16; N = SEQ; rowbase = b * SEQ; mult = 1; scale = 0.011048543456039806f; }
    else { const int it = item - N_FOUR_LAT; b = it / 128; const int w = it % 128; kt = w / 16; cch = w % 16; N = CTXL; rowbase = TL + b * CTXL; mult = 32; scale = 0.0625f; }
    const int kk = threadIdx.x >> 3, oc = threadIdx.x & 7, k = kt * 32 + kk, c0 = cch * 64 + oc * 8;
    const int step = (k * mult) & 8191; int idx = 0;
    float ar[8], ai[8];
#pragma unroll
    for (int i = 0; i < 8; ++i) { ar[i] = 0.f; ai[i] = 0.f; }
    const bf16_t* src = p.U + (size_t)rowbase * UC + U_FOUR + c0;
#pragma unroll 4
    for (int n = 0; n < N; ++n) {
        const uint4 q = *(const uint4*)(src + (size_t)n * UC);
        const float cs = tab[idx], sn = tab[(idx - 2048) & 8191];
        const float xv[8] = {lo16(q.x), hi16(q.x), lo16(q.y), hi16(q.y), lo16(q.z), hi16(q.z), lo16(q.w), hi16(q.w)};
#pragma unroll
        for (int i = 0; i < 8; ++i) { ar[i] += xv[i] * cs; ai[i] -= xv[i] * sn; }
        idx = (idx + step) & 8191;
    }
    const int g = c0 >> 8, cg = c0 & 255;
    bf16_t* o = p.Yb + (size_t)(rowbase + k) * 2048 + g * 512 + cg;
    uint4 r; r.x = pack2(ar[0] * scale, ar[1] * scale); r.y = pack2(ar[2] * scale, ar[3] * scale); r.z = pack2(ar[4] * scale, ar[5] * scale); r.w = pack2(ar[6] * scale, ar[7] * scale);
    *(uint4*)o = r;
    r.x = pack2(ai[0] * scale, ai[1] * scale); r.y = pack2(ai[2] * scale, ai[3] * scale); r.z = pack2(ai[4] * scale, ai[5] * scale); r.w = pack2(ai[6] * scale, ai[7] * scale);
    *(uint4*)(o + 256) = r;
}

constexpr int N_SSD = NB * NH * 16;
__device__ void stage_ssd_naive(const Params& p, int layer, int item) {
    const int wave = threadIdx.x >> 6, lane = threadIdx.x & 63;
    const int b = item / 256, h = (item % 256) / 16, pp = (item % 16) * 4 + wave, g = h >> 2;
    const float dsk = p.d_skip[layer * NH + h];
#pragma unroll 1
    for (int d = 0; d < 2; ++d) {
        const float Ad = -__expf(p.a_log[(layer * 2 + d) * NH + h]);
        float s0 = 0.f, s1 = 0.f;
#pragma unroll 4
        for (int t = 0; t < CTXL + SEQ; ++t) {
            int row;
            if (d == 0) row = t < CTXL ? TL + b * CTXL + t : b * SEQ + (t - CTXL);
            else        row = t < CTXL ? TL + b * CTXL + (CTXL - 1 - t) : b * SEQ + (SEQ - 1 - (t - CTXL));
            const float dtv = p.dt[(size_t)row * 32 + d * 16 + h];
            const bf16_t* vr = p.V + (size_t)row * 2048;
            const float xv = bf2f(vr[h * HD + pp]);
            const unsigned Bq = *(const unsigned*)(vr + 1024 + g * NS + 2 * lane), Cq = *(const unsigned*)(vr + 1536 + g * NS + 2 * lane);
            const float dec = __expf(dtv * Ad), dx = dtv * xv;
            s0 = s0 * dec + dx * lo16(Bq); s1 = s1 * dec + dx * hi16(Bq);
            float y = wave_sum(s0 * lo16(Cq) + s1 * hi16(Cq));
            if (lane == 0) {
                const size_t o = (size_t)row * D + h * HD + pp;
                if (d == 0) p.ybuf[o] = y;
                else { const float tot = p.ybuf[o] + y + dsk * xv; const float z = bf2f(p.U[(size_t)row * UC + U_Z + h * HD + pp]); p.ycraw[o] = tot * siluf_(z); }
            }
        }
    }
}
__device__ void stage_ycnorm(const Params& p, int layer, int item) {
    const int wave = threadIdx.x >> 6, lane = threadIdx.x & 63, row = item * 4 + wave;
    f32x4 v[4]; float ss = 0.f;
#pragma unroll
    for (int j = 0; j < 4; ++j) { v[j] = *(const f32x4*)(p.ycraw + (size_t)row * D + 4 * lane + 256 * j); ss += v[j][0] * v[j][0] + v[j][1] * v[j][1] + v[j][2] * v[j][2] + v[j][3] * v[j][3]; }
    ss = wave_sum(ss); const float rinv = rsqrtf(ss * (1.0f / D) + RMS_EPS);
#pragma unroll
    for (int j = 0; j < 4; ++j) { const int k = 4 * lane + 256 * j; const f32x4 w = *(const f32x4*)(p.ssm_norm_w + layer * D + k); const f32x4 o = v[j] * rinv * w;
        uint2 q; q.x = pack2(o[0], o[1]); q.y = pack2(o[2], o[3]); *(uint2*)(p.yc + (size_t)row * D + k) = q; }
}

constexpr int N_ROUTER = T / 16;
__device__ void stage_router(const Params& p, int layer, int item, char* lds) {
    const int wave = threadIdx.x >> 6, lane = threadIdx.x & 63, row0 = item * 16 + wave * 4;
    float* hs = (float*)lds + wave * 4096;
    const float* nw = p.norm2_w + layer * D;
#pragma unroll 1
    for (int t = 0; t < 4; ++t) {
        const int row = row0 + t, mrow = modrow(row);
        const float* sh = modp(p, layer, mrow, 3); const float* sc = modp(p, layer, mrow, 4);
        f32x4 v[4]; float ss = 0.f;
#pragma unroll
        for (int j = 0; j < 4; ++j) { v[j] = *(const f32x4*)(p.res + (size_t)row * D + 4 * lane + 256 * j); ss += v[j][0] * v[j][0] + v[j][1] * v[j][1] + v[j][2] * v[j][2] + v[j][3] * v[j][3]; }
        ss = wave_sum(ss); const float rinv = rsqrtf(ss * (1.0f / D) + RMS_EPS);
#pragma unroll
        for (int j = 0; j < 4; ++j) {
            const int k = 4 * lane + 256 * j;
            const f32x4 w = *(const f32x4*)(nw + k), a = *(const f32x4*)(sc + k), bb = *(const f32x4*)(sh + k);
            const f32x4 hv = v[j] * rinv * w * (a + 1.0f) + bb;
            uint2 q; q.x = pack2(hv[0], hv[1]); q.y = pack2(hv[2], hv[3]);
            *(uint2*)(p.h + (size_t)row * D + k) = q;
            *(f32x4*)(hs + t * 1024 + k) = hv;
        }
    }
    __syncthreads();
    const int e = lane & 31, half = lane >> 5;
    const float* rw = p.router_w + (size_t)layer * D * NE + e;
    float acc[4] = {0.f, 0.f, 0.f, 0.f};
#pragma unroll 2
    for (int k4 = 0; k4 < 128; ++k4) {
        const int k = half * 512 + k4 * 4;
        const float w0 = rw[(size_t)(k + 0) * NE], w1 = rw[(size_t)(k + 1) * NE], w2 = rw[(size_t)(k + 2) * NE], w3 = rw[(size_t)(k + 3) * NE];
#pragma unroll
        for (int t = 0; t < 4; ++t) { const f32x4 hv = *(const f32x4*)(hs + t * 1024 + k); acc[t] += hv[0] * w0 + hv[1] * w1 + hv[2] * w2 + hv[3] * w3; }
    }
    const float rb = p.router_b[layer * NE + e];
#pragma unroll 1
    for (int t = 0; t < 4; ++t) {
        float logit = acc[t] + __shfl_xor(acc[t], 32) + rb;
        float tv[4]; int ti[4];
#pragma unroll
        for (int r = 0; r < 4; ++r) {
            float bv = logit; int bi = e;
#pragma unroll
            for (int o = 16; o >= 1; o >>= 1) { const float ov = __shfl_xor(bv, o); const int oi = __shfl_xor(bi, o); if (ov > bv || (ov == bv && oi < bi)) { bv = ov; bi = oi; } }
            tv[r] = bv; ti[r] = bi; if (e == bi) logit = -3.0e38f;
        }
        if (lane == 0) {
            const int row = row0 + t;
            const float e1 = __expf(tv[1] - tv[0]), e2 = __expf(tv[2] - tv[0]), e3 = __expf(tv[3] - tv[0]); const float inv = 1.0f / (1.0f + e1 + e2 + e3);
            const float wv[4] = {inv, e1 * inv, e2 * inv, e3 * inv};
#pragma unroll
            for (int r = 0; r < 4; ++r) {
                p.topi[row * 4 + r] = ti[r]; p.topw[row * 4 + r] = wv[r];
                const int pos = atomicAdd(&p.cnt[layer * NE + ti[r]], 1);
                p.list[(size_t)(layer * NE + ti[r]) * T + pos] = row * 4 + r;
            }
        }
    }
    __syncthreads();
}

enum { ST_CONVERT, ST_TABLE, ST_ADA, ST_NORM0, ST_NORM1, ST_FINAL, ST_INPROJ, ST_CONV, ST_POOL, ST_POOLG, ST_FOUR, ST_CHAN, ST_SSD, ST_YCN, ST_MERGE, ST_OUT, ST_ROUTER, ST_MOE1, ST_MOE2 };
template <int ST>
__global__ void __launch_bounds__(256) k_stage(Params p, int layer, int nitems) {
    __shared__ __attribute__((aligned(16))) char lds[LDS_BYTES];
    if (ST == ST_FOUR) four_table(lds);
    if (ST == ST_MOE1) nitems = moe_total_mtiles(p, layer) * 16;
    if (ST == ST_MOE2) nitems = moe_total_mtiles(p, layer) * 8;
    for (int item = blockIdx.x; item < nitems; item += gridDim.x) {
        if (ST == ST_CONVERT) stage_convert(p, item, lds);
        if (ST == ST_TABLE) stage_table(p, item);
        if (ST == ST_ADA) stage_ada(p, item, lds);
        if (ST == ST_NORM0) stage_rownorm<0>(p, layer, item);
        if (ST == ST_NORM1) stage_rownorm<1>(p, layer, item);
        if (ST == ST_FINAL) stage_rownorm<2>(p, layer, item);
        if (ST == ST_INPROJ) stage_inproj(p, layer, item, lds);
        if (ST == ST_CONV) stage_conv(p, layer, item);
        if (ST == ST_POOL) stage_pool(p, item);
        if (ST == ST_POOLG) stage_gemm_small<0>(p, layer, item, lds);
        if (ST == ST_FOUR) stage_fourier_naive(p, item, lds);
        if (ST == ST_CHAN) stage_gemm_small<1>(p, layer, item, lds);
        if (ST == ST_SSD) stage_ssd_naive(p, layer, item);
        if (ST == ST_YCN) stage_ycnorm(p, layer, item);
        if (ST == ST_MERGE) stage_merge(p, layer, item, lds);
        if (ST == ST_OUT) stage_outproj(p, layer, item, lds);
        if (ST == ST_ROUTER) stage_router(p, layer, item, lds);
        if (ST == ST_MOE1) stage_moe1(p, layer, item, lds);
        if (ST == ST_MOE2) stage_moe2(p, layer, item, lds);
    }
}
template <int ST> static void run(const Params& p, int layer, int nitems, hipStream_t s, int maxgrid = 2048) {
    int grid = nitems < maxgrid ? nitems : maxgrid; if (grid < 1) grid = 1;
    hipLaunchKernelGGL((k_stage<ST>), dim3(grid), dim3(256), 0, s, p, layer, nitems);
}

extern "C" void kernel_launch(void* const* d_in, const int* in_sizes, int n_in, void* d_out, int out_size, void* d_ws, size_t ws_size, hipStream_t stream) {
    Params p; memset(&p, 0, sizeof(p));
    const float** f = (const float**)&p;
    for (int i = 0; i < 26; ++i) f[i] = (const float*)d_in[i];
    p.out = (float*)d_out;
    char* w = (char*)d_ws; size_t off = 0;
    auto take = [&](size_t bytes) { char* r = w + off; off += (bytes + 255) & ~(size_t)255; return r; };
    p.bar = (unsigned*)take(16384); p.cnt = (int*)take(1024);
    p.mod = (float*)take((size_t)DEPTH * 3 * 6144 * 4);
    p.res = (float*)take((size_t)T * D * 4);
    p.dt = (float*)take((size_t)T * 32 * 4);
    p.ybuf = (float*)take((size_t)T * D * 4);
    p.ycraw = (float*)take((size_t)T * D * 4);
    p.topw = (float*)take((size_t)T * 4 * 4);
    p.topi = (int*)take((size_t)T * 4 * 4);
    p.list = (int*)take((size_t)DEPTH * NE * T * 4);
    p.h = (bf16_t*)take((size_t)T * D * 2);
    p.w_in_t = (bf16_t*)take((size_t)DEPTH * WIN_ROWS * D * 2);
    p.w_br_t = (bf16_t*)take((size_t)DEPTH * 3 * D * D * 2);
    p.w_out_t = (bf16_t*)take((size_t)DEPTH * D * D * 2);
    p.pool_w_t = (bf16_t*)take((size_t)DEPTH * 4 * 65536 * 2);
    p.w1_t = (bf16_t*)take((size_t)DEPTH * NE * 2048 * D * 2);
    p.w2_t = (bf16_t*)take((size_t)DEPTH * NE * D * D * 2);
    p.cs_t = (bf16_t*)take((size_t)256 * 512 * 2);
    p.U = (bf16_t*)take((size_t)T * UC * 2);
    p.V = (bf16_t*)take((size_t)T * 2048 * 2);
    p.Dp = (bf16_t*)take((size_t)T * D * 2);
    p.ya = (bf16_t*)take((size_t)T * D * 2);
    p.Yb = (bf16_t*)take((size_t)T * 2048 * 2);
    p.yb = (bf16_t*)take((size_t)T * D * 2);
    p.yc = (bf16_t*)take((size_t)T * D * 2);
    p.m = (bf16_t*)take((size_t)T * D * 2);
    p.act = (bf16_t*)take((size_t)(T * 4 + 128) * D * 2);
    p.sout = (bf16_t*)take((size_t)T * 4 * D * 2);
    if (off > ws_size) { fprintf(stderr, "workspace too small: need %zu have %zu\n", off, ws_size); return; }
    hipMemsetAsync(p.bar, 0, 16384 + 1024, stream);
    run<ST_CONVERT>(p, 0, N_CONVERT, stream, 8192);
    run<ST_TABLE>(p, 0, N_TABLE, stream);
    run<ST_ADA>(p, 0, N_ADA, stream);
    for (int l = 0; l < DEPTH; ++l) {
        if (l == 0) run<ST_NORM0>(p, l, N_ROWNORM, stream); else run<ST_NORM1>(p, l, N_ROWNORM, stream);
        run<ST_INPROJ>(p, l, N_INPROJ, stream);
        run<ST_CONV>(p, l, N_CONV, stream);
        run<ST_POOL>(p, l, N_POOL, stream);
        run<ST_POOLG>(p, l, N_G1024, stream);
        run<ST_FOUR>(p, l, N_FOUR, stream, 1024);
        run<ST_CHAN>(p, l, N_G1024, stream);
        run<ST_SSD>(p, l, N_SSD, stream);
        run<ST_YCN>(p, l, N_ROWNORM, stream);
        run<ST_MERGE>(p, l, N_G1024, stream);
        run<ST_OUT>(p, l, N_G1024, stream);
        run<ST_ROUTER>(p, l, N_ROUTER, stream);
        run<ST_MOE1>(p, l, 1 << 30, stream, 1024);
        run<ST_MOE2>(p, l, 1 << 30, stream, 1024);
    }
    run<ST_FINAL>(p, DEPTH - 1, N_ROWNORM, stream);
}
```

```cpp
#include <hip/hip_runtime.h>
#include <hip/hip_cooperative_groups.h>
#include <cstdio>
#include <cstdint>
#include <cstring>

typedef unsigned short bf16_t;
typedef short bf16x8 __attribute__((ext_vector_type(8)));
typedef float f32x4 __attribute__((ext_vector_type(4)));

constexpr int D = 1024, NB = 2, SEQ = 8192, TL = NB * SEQ, CTXL = 256, TC = NB * CTXL, T = TL + TC;
constexpr int DEPTH = 2, NE = 32, TOPK = 4, NH = 16, HD = 64, NS = 128;
constexpr int IN_COLS = 8224, UC = 8192;
constexpr int U_FOUR = 1024, U_Z = 2048, U_XBC = 3072, U_GATE = 5120;
constexpr int WIN_ROWS = 8320;
constexpr float RMS_EPS = 1e-6f;
constexpr int LDS_BYTES = 77824;

struct Params {
    const float *x, *c, *ctx, *c_ctx, *w_ada, *b_ada, *norm1_w, *norm2_w, *w_in, *pool_w, *pool_scale, *conv_w, *conv_b, *dt_bias, *a_log,
        *d_skip, *ssm_norm_w, *w_branch, *w_out, *router_w, *router_b, *moe_w1, *moe_b1, *moe_w2, *moe_b2, *final_norm_w;
    float* out;
    unsigned* bar; int* cnt;
    float *mod, *res, *dt, *ybuf, *ycraw, *topw, *ac, *ssq;
    bf16_t *h, *w_in_t, *w_br_t, *w_out_t, *pool_w_t, *w1_t, *w2_t, *cs_t, *U, *V, *Dp, *ya, *Yb, *yb, *yc, *m, *act, *sout, *tabA, *tabB, *tabC, *Ap, *Scs, *Sst;
    int *topi, *list;
};

typedef const __attribute__((address_space(4))) Params CParams;
typedef CParams& PRef;
__device__ __forceinline__ CParams* launder(CParams* kp) { asm volatile("" : "+s"(kp)); return kp; }
__device__ __forceinline__ int tidx() { int t = threadIdx.x; asm volatile("" : "+v"(t)); return t; }
__device__ __forceinline__ float bf2f(bf16_t u) { return __uint_as_float(((unsigned)u) << 16); }
__device__ __forceinline__ bf16_t f2bf(float f) { unsigned u = __float_as_uint(f); u += 0x7fffu + ((u >> 16) & 1u); return (bf16_t)(u >> 16); }
__device__ __forceinline__ unsigned pack2(float a, float b) { return (unsigned)f2bf(a) | ((unsigned)f2bf(b) << 16); }
__device__ __forceinline__ float lo16(unsigned u) { return __uint_as_float(u << 16); }
__device__ __forceinline__ float hi16(unsigned u) { return __uint_as_float(u & 0xffff0000u); }
__device__ __forceinline__ float sigmoidf_(float x) { return 1.0f / (1.0f + __expf(-x)); }
__device__ __forceinline__ float siluf_(float x) { return x / (1.0f + __expf(-x)); }
__device__ __forceinline__ float softplusf_(float x) { return x > 20.f ? x : log1pf(__expf(x)); }
__device__ __forceinline__ int modrow(int row) { return row < TL ? (row / SEQ) : 2; }
__device__ __forceinline__ const float* modp(PRef p, int layer, int mrow, int j) { return p.mod + ((size_t)((layer * 3 + mrow) * 6 + j)) * D; }
__device__ __forceinline__ float wave_sum(float v) {
#pragma unroll
    for (int o = 32; o >= 1; o >>= 1) v += __shfl_xor(v, o);
    return v;
}

__device__ __forceinline__ int colmap(int mode, int j) {
    if (mode == 0) return j;
    if (mode == 1) { if (j < 5120) return j; if (j < 8192) return j + 32; if (j < 8224) return 5120 + (j - 8192); return -1; }
    const int Tn = j >> 7, wc = (j >> 6) & 1, jj = j & 63, fq = jj >> 4, n = (jj >> 2) & 3;
    return (n < 2 ? 0 : 1024) + Tn * 64 + wc * 32 + 8 * fq + 4 * (n & 1) + (jj & 3);
}
__device__ __forceinline__ void convert_tile(const float* __restrict__ src, int ld, bf16_t* __restrict__ dst, int K, int n0, int k0, int mode, char* lds, const float* kscale = nullptr) {
    float* tile = (float*)lds;
    const int tid = tidx();
    __syncthreads();
    { const int n4 = (tid & 15) * 4, kr = tid >> 4; const int sc = colmap(mode, n0 + n4);
      f32x4 v[8];
#pragma unroll
      for (int i = 0; i < 8; ++i) { const int kk = kr + 16 * i; v[i] = (f32x4){0.f, 0.f, 0.f, 0.f}; if (sc >= 0) v[i] = *(const f32x4*)(src + (size_t)(k0 + kk) * ld + sc); }
#pragma unroll
      for (int i = 0; i < 8; ++i) { const int kk = kr + 16 * i; if (kscale) v[i] *= kscale[k0 + kk];
          tile[kk * 65 + n4] = v[i][0]; tile[kk * 65 + n4 + 1] = v[i][1]; tile[kk * 65 + n4 + 2] = v[i][2]; tile[kk * 65 + n4 + 3] = v[i][3]; } }
    __syncthreads();
    { const int ko = (tid & 15) * 8, nr = tid >> 4;
#pragma unroll
      for (int i = 0; i < 4; ++i) { const int n = nr + 16 * i; float v[8];
#pragma unroll
          for (int j = 0; j < 8; ++j) v[j] = tile[(ko + j) * 65 + n];
          uint4 q; q.x = pack2(v[0], v[1]); q.y = pack2(v[2], v[3]); q.z = pack2(v[4], v[5]); q.w = pack2(v[6], v[7]);
          *(uint4*)(dst + (size_t)(n0 + n) * K + k0 + ko) = q; } }
}
constexpr int CV_WIN = (WIN_ROWS / 64) * 8, CV_BR = 3 * 128, CV_OUT = 128, CV_POOL = 4 * 8, CV_W1 = NE * 32 * 8, CV_W2 = NE * 128;
constexpr int CV_LAYER = CV_WIN + CV_BR + CV_OUT + CV_POOL + CV_W1 + CV_W2;
constexpr int N_CONVERT = DEPTH * CV_LAYER;
__device__ __forceinline__ void stage_convert(PRef p, int item, char* lds) {
    const int l = item / CV_LAYER; int w = item % CV_LAYER;
    if (w < CV_WIN) { convert_tile(p.w_in + (size_t)l * D * IN_COLS, IN_COLS, p.w_in_t + (size_t)l * WIN_ROWS * D, D, (w / 8) * 64, (w % 8) * 128, 1, lds); return; }
    w -= CV_WIN;
    if (w < CV_BR) { const int k = w / 128, t = w % 128; if (k == 0) return; convert_tile(p.w_branch + (size_t)(l * 3 + k) * D * D, D, p.w_br_t + (size_t)(l * 3 + k) * D * D, D, (t / 8) * 64, (t % 8) * 128, 0, lds, (k == 2) ? p.ssm_norm_w + l * D : nullptr); return; }
    w -= CV_BR;
    if (w < CV_OUT) { convert_tile(p.w_out + (size_t)l * D * D, D, p.w_out_t + (size_t)l * D * D, D, (w / 8) * 64, (w % 8) * 128, 0, lds); return; }
    w -= CV_OUT;
    if (w < CV_POOL) { return; const int g = w / 8, t = w % 8; convert_tile(p.pool_w + (size_t)(l * 4 + g) * 65536, 256, p.pool_w_t + (size_t)(l * 4 + g) * 65536, 256, (t / 2) * 64, (t % 2) * 128, 0, lds); return; }
    w -= CV_POOL;
    if (w < CV_W1) { const int e = w / 256, t = w % 256; convert_tile(p.moe_w1 + (size_t)(l * NE + e) * D * 2048, 2048, p.w1_t + (size_t)(l * NE + e) * 2048 * D, D, (t / 8) * 64, (t % 8) * 128, 2, lds); return; }
    w -= CV_W1;
    { const int e = w / 128, t = w % 128; convert_tile(p.moe_w2 + (size_t)(l * NE + e) * D * D, D, p.w2_t + (size_t)(l * NE + e) * D * D, D, (t / 8) * 64, (t % 8) * 128, 0, lds); }
}
constexpr int N_FOLD = DEPTH * 4 * 16 * 4;
__device__ __forceinline__ void stage_fold(PRef p, int item, char* lds) {
    float* P = (float*)lds;
    float* W = P + 64 * 64;
    const int tid = tidx(), l = item >> 8, g = (item >> 6) & 3, n0 = ((item >> 2) & 15) * 64, kl0 = (item & 3) * 64;
    const int n = tid & 63, kq = tid >> 6;
    float acc[16];
#pragma unroll
    for (int i = 0; i < 16; ++i) acc[i] = 0.f;
    const float* pw = p.pool_w + (size_t)(l * 4 + g) * 65536; const float* ps = p.pool_scale + l * D + g * 256; const float* wb = p.w_branch + (size_t)(l * 3) * D * D + (size_t)(g * 256) * D;
#pragma unroll 1
    for (int c0 = 0; c0 < 256; c0 += 64) {
        __syncthreads();
#pragma unroll
        for (int i = 0; i < 16; ++i) { const int id = tid + 256 * i, kl = id >> 6, c = id & 63; P[c * 64 + kl] = pw[(size_t)(kl0 + kl) * 256 + c0 + c] * ps[c0 + c]; }
#pragma unroll
        for (int i = 0; i < 16; ++i) { const int id = tid + 256 * i, c = id >> 6, nn = id & 63; W[c * 64 + nn] = wb[(size_t)(c0 + c) * D + n0 + nn]; }
        __syncthreads();
#pragma unroll 4
        for (int c = 0; c < 64; ++c) {
            const float w = W[c * 64 + n];
#pragma unroll
            for (int q = 0; q < 4; ++q) { const f32x4 pv = *(const f32x4*)(P + c * 64 + kq * 16 + q * 4); acc[q * 4] += pv[0] * w; acc[q * 4 + 1] += pv[1] * w; acc[q * 4 + 2] += pv[2] * w; acc[q * 4 + 3] += pv[3] * w; }
        }
    }
    bf16_t* o = p.w_br_t + (size_t)(l * 3) * D * D + (size_t)(n0 + n) * D + g * 256 + kl0 + kq * 16;
    uint4 q0, q1;
    q0.x = pack2(acc[0], acc[1]); q0.y = pack2(acc[2], acc[3]); q0.z = pack2(acc[4], acc[5]); q0.w = pack2(acc[6], acc[7]);
    q1.x = pack2(acc[8], acc[9]); q1.y = pack2(acc[10], acc[11]); q1.z = pack2(acc[12], acc[13]); q1.w = pack2(acc[14], acc[15]);
    ((uint4*)o)[0] = q0; ((uint4*)o)[1] = q1;
}
constexpr int N_TAB_CS = 512, N_TAB_A = 4096, N_TAB_B = 256, N_TAB_C = 512, N_TABLE = N_TAB_CS + N_TAB_A + N_TAB_B + N_TAB_C;
__device__ __forceinline__ void stage_table(PRef p, int item) {
    const float TWO_PI = 6.283185307179586f;
    if (item < N_TAB_CS) {
        const int idx = item * 256 + tidx(), m = idx >> 9, kk = idx & 511, ro = kk >> 8, c = kk & 255;
        const float ang = TWO_PI * (float)((m * c) & 255) * (1.0f / 256.0f);
        p.cs_t[idx] = f2bf((ro ? sinf(ang) : cosf(ang)) * 0.0625f); return;
    }
    item -= N_TAB_CS;
    if (item < N_TAB_A) {
        const int idx = item * 256 + tidx(), n2 = idx >> 13, rA = (idx >> 6) & 127, n1 = idx & 63, k1 = rA >> 1, ri = rA & 1;
        const float ang = TWO_PI * (float)((k1 * (128 * n1 + n2)) & 8191) * (1.0f / 8192.0f);
        p.tabA[idx] = f2bf((ri ? -sinf(ang) : cosf(ang)) * 0.011048543456039806f); return;
    }
    item -= N_TAB_A;
    if (item < N_TAB_B) {
        const int idx = item * 256 + tidx(), rB = idx >> 8, j = idx & 255, k2 = rB >> 1, ro = rB & 1, n2 = j >> 1, ri = j & 1;
        const float ang = TWO_PI * (float)((k2 * n2) & 127) * (1.0f / 128.0f);
        const float cs = cosf(ang), sn = sinf(ang);
        p.tabB[idx] = f2bf(ro == 0 ? (ri == 0 ? cs : sn) : (ri == 0 ? -sn : cs)); return;
    }
    item -= N_TAB_B;
    {
        const int idx = item * 256 + tidx(), half = idx >> 16, rC = (idx >> 8) & 255, n = idx & 255, k = half * 128 + (rC >> 1), ro = rC & 1;
        const float ang = TWO_PI * (float)((k * n) & 255) * (1.0f / 256.0f);
        p.tabC[idx] = f2bf((ro ? -sinf(ang) : cosf(ang)) * 0.0625f);
    }
}
constexpr int N_ADA = DEPTH * 6144 / 32;
__device__ __forceinline__ void stage_ada(PRef p, int item, char* lds) {
    float* sc = (float*)lds;
    float* part = sc + 3 * D;
    const int tid = tidx();
    __syncthreads();
    for (int i = tid; i < 3 * D; i += 256) { const int r = i / D, k = i % D; const float v = r < 2 ? p.c[r * D + k] : p.c_ctx[k]; sc[i] = siluf_(v); }
    __syncthreads();
    const int l = item / 192, cl = tid & 31, kg = tid >> 5, col = (item % 192) * 32 + cl;
    const float* w = p.w_ada + (size_t)l * D * 6144 + (size_t)(kg * 128) * 6144 + col;
    float a0 = 0.f, a1 = 0.f, a2 = 0.f;
#pragma unroll 16
    for (int k = 0; k < 128; ++k) { const float wv = w[(size_t)k * 6144]; a0 += sc[kg * 128 + k] * wv; a1 += sc[D + kg * 128 + k] * wv; a2 += sc[2 * D + kg * 128 + k] * wv; }
    part[(kg * 3 + 0) * 32 + cl] = a0; part[(kg * 3 + 1) * 32 + cl] = a1; part[(kg * 3 + 2) * 32 + cl] = a2;
    __syncthreads();
    if (tid < 96) { const int r = tid >> 5, c2 = tid & 31; float s = p.b_ada[l * 6144 + (item % 192) * 32 + c2];
#pragma unroll
        for (int g = 0; g < 8; ++g) s += part[(g * 3 + r) * 32 + c2];
        p.mod[(size_t)(l * 3 + r) * 6144 + (item % 192) * 32 + c2] = s; }
}

constexpr int N_ROWNORM = T / 4;
template <int MODE>
__device__ __forceinline__ void stage_rownorm(PRef p, int layer, int item) {
    const int wave = tidx() >> 6, lane = tidx() & 63, row = item * 4 + wave, mrow = modrow(row);
    const float* src = MODE == 0 ? (row < TL ? p.x + (size_t)row * D : p.ctx + (size_t)(row - TL) * D) : p.res + (size_t)row * D;
    f32x4 v[4];
#pragma unroll
    for (int j = 0; j < 4; ++j) v[j] = *(const f32x4*)(src + 4 * lane + 256 * j);
    if (MODE >= 1) {
        const int pl = MODE == 1 ? layer - 1 : layer;
        const float* g2 = modp(p, pl, mrow, 5);
#pragma unroll
        for (int j = 0; j < 4; ++j) {
            const int k = 4 * lane + 256 * j; f32x4 s = {0.f, 0.f, 0.f, 0.f};
#pragma unroll
            for (int kk = 0; kk < 4; ++kk) { const uint2 q = *(const uint2*)(p.sout + ((size_t)row * 4 + kk) * D + k); s[0] += lo16(q.x); s[1] += hi16(q.x); s[2] += lo16(q.y); s[3] += hi16(q.y); }
            const f32x4 g = *(const f32x4*)(g2 + k); v[j] += g * s;
        }
    }
    if (MODE != 2) {
#pragma unroll
        for (int j = 0; j < 4; ++j) *(f32x4*)(p.res + (size_t)row * D + 4 * lane + 256 * j) = v[j];
    }
    float ss = 0.f;
#pragma unroll
    for (int j = 0; j < 4; ++j) ss += v[j][0] * v[j][0] + v[j][1] * v[j][1] + v[j][2] * v[j][2] + v[j][3] * v[j][3];
    ss = wave_sum(ss);
    const float rinv = rsqrtf(ss * (1.0f / D) + RMS_EPS);
    if (MODE == 2) {
        if (row < TL) {
#pragma unroll
            for (int j = 0; j < 4; ++j) { const int k = 4 * lane + 256 * j; const f32x4 w = *(const f32x4*)(p.final_norm_w + k); *(f32x4*)(p.out + (size_t)row * D + k) = v[j] * rinv * w; }
        }
    } else {
        const float* nw = p.norm1_w + layer * D; const float* sh = modp(p, layer, mrow, 0); const float* sc = modp(p, layer, mrow, 1);
#pragma unroll
        for (int j = 0; j < 4; ++j) {
            const int k = 4 * lane + 256 * j;
            const f32x4 w = *(const f32x4*)(nw + k), a = *(const f32x4*)(sc + k), b = *(const f32x4*)(sh + k);
            const f32x4 hv = v[j] * rinv * w * (a + 1.0f) + b;
            uint2 q; q.x = pack2(hv[0], hv[1]); q.y = pack2(hv[2], hv[3]);
            *(uint2*)(p.h + (size_t)row * D + k) = q;
        }
    }
}

struct GemmSrc { const bf16_t* a[4]; const bf16_t* b[4]; };
__device__ __forceinline__ void gemm_stage(const GemmSrc& s, int kt, char* buf, int tid) {
#pragma unroll
    for (int i = 0; i < 4; ++i) {
        __builtin_amdgcn_global_load_lds((const unsigned*)(s.a[i] + kt), (unsigned*)(buf + i * 4096 + tid * 16), 16, 0, 0);
        __builtin_amdgcn_global_load_lds((const unsigned*)(s.b[i] + kt), (unsigned*)(buf + 16384 + i * 4096 + tid * 16), 16, 0, 0);
    }
}
__device__ __forceinline__ void gemm_kloop(f32x4 (&acc)[4][4], const GemmSrc& s, int K, char* lds) {
    const int tid = tidx(), wid = tid >> 6, lane = tid & 63, wr = wid >> 1, wc = wid & 1, fr = lane & 15, fq = lane >> 4;
    const int rsw = fr & 7;
    const int offA = (wr * 64 + fr) * 128, offB = 16384 + (wc * 64 + fr) * 128;
    const int c0 = ((0 + fq) ^ rsw) * 16, c1 = ((4 + fq) ^ rsw) * 16;
    asm volatile("s_waitcnt lgkmcnt(0)" ::: "memory");
    __builtin_amdgcn_s_barrier();
    asm volatile("" ::: "memory");
    gemm_stage(s, 0, lds, tid);
    asm volatile("s_waitcnt vmcnt(0)" ::: "memory");
    __syncthreads();
    int cur = 0;
    for (int kt = 0; kt < K; kt += 64) {
        char* buf = lds + cur * 32768;
        if (kt + 64 < K) gemm_stage(s, kt + 64, lds + (cur ^ 1) * 32768, tid);
#pragma unroll
        for (int ks = 0; ks < 2; ++ks) {
            const int cc = ks ? c1 : c0;
            bf16x8 af[4], bfr[4];
#pragma unroll
            for (int m = 0; m < 4; ++m) af[m] = *(const bf16x8*)(buf + offA + m * 2048 + cc);
#pragma unroll
            for (int n = 0; n < 4; ++n) bfr[n] = *(const bf16x8*)(buf + offB + n * 2048 + cc);
#pragma unroll
            for (int m = 0; m < 4; ++m)
#pragma unroll
                for (int n = 0; n < 4; ++n) acc[m][n] = __builtin_amdgcn_mfma_f32_16x16x32_bf16(bfr[n], af[m], acc[m][n], 0, 0, 0);
        }
        asm volatile("s_waitcnt vmcnt(0)" ::: "memory");
        __syncthreads();
        cur ^= 1;
    }
}
template <int MR> struct GemmSrcT { const bf16_t* a[MR / 2]; const bf16_t* b[2]; };
template <int MR>
__device__ __forceinline__ void gemm_stage_t(const GemmSrcT<MR>& s, int kt, char* buf, int tid) {
#pragma unroll
    for (int i = 0; i < MR / 2; ++i) __builtin_amdgcn_global_load_lds((const unsigned*)(s.a[i] + kt), (unsigned*)(buf + i * 4096 + tid * 16), 16, 0, 0);
#pragma unroll
    for (int i = 0; i < 2; ++i) __builtin_amdgcn_global_load_lds((const unsigned*)(s.b[i] + kt), (unsigned*)(buf + MR * 2048 + i * 4096 + tid * 16), 16, 0, 0);
}
template <int N> __device__ __forceinline__ void wait_vmcnt() { asm volatile("s_waitcnt vmcnt(%0)" :: "n"(N) : "memory"); }
template <int MR>
__device__ __forceinline__ void gemm_kloop_t(f32x4 (&acc)[MR][4], const GemmSrcT<MR>& s, int K, char* lds) {
    constexpr int NBUF = (MR == 8) ? 3 : 4, P = NBUF - 1, L = MR / 2 + 2, BUFB = MR * 2048 + 8192;
    const int tid = tidx(), wid = tid >> 6, lane = tid & 63, wr = wid >> 1, wc = wid & 1, fr = lane & 15, fq = lane >> 4;
    const int cc = (fq ^ ((-(fr >> 2)) & 3)) * 16;
    const int offA = (wr * (MR * 16) + fr) * 64 + cc, offB = MR * 2048 + (wc * 64 + fr) * 64 + cc;
    const int nk = K >> 5;
    asm volatile("s_waitcnt lgkmcnt(0)" ::: "memory");
    __builtin_amdgcn_s_barrier();
    asm volatile("" ::: "memory");
#pragma unroll
    for (int i = 0; i < P; ++i) if (i < nk) gemm_stage_t<MR>(s, i * 32, lds + i * BUFB, tid);
    int cur = 0, nxt = P;
#pragma unroll 1
    for (int k = 0; k < nk; ++k) {
        const int rem = nk - 1 - k;
        if (P >= 3 && rem >= 2) wait_vmcnt<2 * L>(); else if (rem >= 1) wait_vmcnt<L>(); else wait_vmcnt<0>();
        __builtin_amdgcn_s_barrier();
        asm volatile("" ::: "memory");
        const char* buf = lds + cur * BUFB;
        bf16x8 af[MR], bfr[4];
#pragma unroll
        for (int n = 0; n < 4; ++n) bfr[n] = *(const bf16x8*)(buf + offB + n * 1024);
#pragma unroll
        for (int m = 0; m < MR; ++m) af[m] = *(const bf16x8*)(buf + offA + m * 1024);
        __builtin_amdgcn_sched_barrier(0);
        if (k + P < nk) gemm_stage_t<MR>(s, (k + P) * 32, lds + nxt * BUFB, tid);
        __builtin_amdgcn_sched_barrier(0);
#pragma unroll
        for (int m = 0; m < MR; ++m)
#pragma unroll
            for (int n = 0; n < 4; ++n) acc[m][n] = __builtin_amdgcn_mfma_f32_16x16x32_bf16(bfr[n], af[m], acc[m][n], 0, 0, 0);
        cur = (cur + 1 == NBUF) ? 0 : cur + 1; nxt = (nxt + 1 == NBUF) ? 0 : nxt + 1;
    }
}
__device__ __forceinline__ void gemm_kloop2(f32x4 (&acc)[8][4], const GemmSrcT<8>& s, int K, char* lds) { gemm_kloop_t<8>(acc, s, K, lds); }
typedef GemmSrcT<8> GemmSrc2;
__device__ __forceinline__ void zero_acc2(f32x4 (&acc)[8][4]) {
#pragma unroll
    for (int m = 0; m < 8; ++m)
#pragma unroll
        for (int n = 0; n < 4; ++n) acc[m][n] = (f32x4){0.f, 0.f, 0.f, 0.f};
}
#define GEMM2_LANE_VARS const int tid = tidx(), wid = tid >> 6, lane = tid & 63, wr = wid >> 1, wc = wid & 1, fr = lane & 15, fq = lane >> 4; (void)wr; (void)wc; (void)fr; (void)fq; \
    const int br0 = tid >> 2, bc = ((tid & 3) ^ ((-(tid >> 4)) & 3)) * 8;
__device__ __forceinline__ int brow(int r) { return (r & ~63) | (((r >> 2) & 3) << 4) | (((r >> 4) & 3) << 2) | (r & 3); }
__device__ __forceinline__ void pack16(const f32x4 (&v)[4], uint4& q0, uint4& q1) {
    q0.x = pack2(v[0][0], v[0][1]); q0.y = pack2(v[0][2], v[0][3]); q0.z = pack2(v[1][0], v[1][1]); q0.w = pack2(v[1][2], v[1][3]);
    q1.x = pack2(v[2][0], v[2][1]); q1.y = pack2(v[2][2], v[2][3]); q1.z = pack2(v[3][0], v[3][1]); q1.w = pack2(v[3][2], v[3][3]); }
__device__ __forceinline__ void zero_acc(f32x4 (&acc)[4][4]) {
#pragma unroll
    for (int m = 0; m < 4; ++m)
#pragma unroll
        for (int n = 0; n < 4; ++n) acc[m][n] = (f32x4){0.f, 0.f, 0.f, 0.f};
}
#define GEMM_LANE_VARS const int tid = tidx(), wid = tid >> 6, lane = tid & 63, wr = wid >> 1, wc = wid & 1, fr = lane & 15, fq = lane >> 4; (void)wr; (void)wc; (void)fr; (void)fq; \
    const int ar0 = tid >> 3, ac = ((tid & 7) ^ (ar0 & 7)) * 8;

constexpr int NM_T = T / 128, NM2 = T / 256, N_INPROJ = ((NM2 + 7) / 8) * 8 * 65;
__device__ __forceinline__ void stage_inproj(PRef p, int layer, int item, char* lds) {
    GEMM2_LANE_VARS
    const int grp = item / (8 * 65), w = item % (8 * 65);
    int mt, nt;
    { const int gsz = (NM2 - grp * 8) < 8 ? (NM2 - grp * 8) : 8; mt = grp * 8 + (w % gsz); nt = w / gsz; }
    if (nt >= 65) return;
    const bf16_t* A = p.h + (size_t)(mt * 256) * D; const bf16_t* B = p.w_in_t + ((size_t)layer * WIN_ROWS + nt * 128) * D;
    f32x4 acc[8][4]; zero_acc2(acc);
    { GemmSrc2 s;
#pragma unroll
      for (int i = 0; i < 4; ++i) s.a[i] = A + (size_t)(br0 + 64 * i) * D + bc;
#pragma unroll
      for (int i = 0; i < 2; ++i) s.b[i] = B + (size_t)brow(br0 + 64 * i) * D + bc;
      gemm_kloop2(acc, s, D, lds); }
#pragma unroll
    for (int m = 0; m < 8; ++m) {
        const int row = mt * 256 + wr * 128 + m * 16 + fr;
        if (nt < 64) {
            const int gc = nt * 128 + wc * 64 + 16 * fq;
            f32x4 v[4];
#pragma unroll
            for (int n = 0; n < 4; ++n) { v[n] = acc[m][n]; if (gc >= U_GATE) { v[n][0] = sigmoidf_(v[n][0]); v[n][1] = sigmoidf_(v[n][1]); v[n][2] = sigmoidf_(v[n][2]); v[n][3] = sigmoidf_(v[n][3]); } }
            uint4 q0, q1; pack16(v, q0, q1);
            uint4* o = (uint4*)(p.U + (size_t)row * UC + gc); o[0] = q0; o[1] = q1;
        } else if (wc == 0 && fq < 2) {
#pragma unroll
            for (int n = 0; n < 4; ++n) {
                const int cl = 16 * fq + 4 * n; const f32x4 b = *(const f32x4*)(p.dt_bias + layer * 32 + cl); const f32x4 v = acc[m][n];
                f32x4 o; o[0] = softplusf_(v[0] + b[0]); o[1] = softplusf_(v[1] + b[1]); o[2] = softplusf_(v[2] + b[2]); o[3] = softplusf_(v[3] + b[3]);
                *(f32x4*)(p.dt + (size_t)row * 32 + cl) = o;
            }
        }
    }
}
constexpr int N_G1024 = NM_T * 8;
template <int MODE>
__device__ __forceinline__ void stage_gemm_small(PRef p, int layer, int item, char* lds) {
    GEMM_LANE_VARS
    const int mt = item >> 3, nt = item & 7, g = nt >> 1;
    const bf16_t *A, *B; int lda, ldb, K;
    if (MODE == 0) { A = p.Dp + (size_t)(mt * 128) * D + g * 256; lda = D; K = 256; ldb = 256; B = p.pool_w_t + (size_t)(layer * 4 + g) * 65536 + (size_t)((nt & 1) * 128) * 256; }
    else           { A = p.Yb + (size_t)(mt * 128) * 2048 + g * 512; lda = 2048; K = 512; ldb = 512; B = p.cs_t + (size_t)((nt & 1) * 128) * 512; }
    f32x4 acc[4][4]; zero_acc(acc);
    { GemmSrc s;
#pragma unroll
      for (int i = 0; i < 4; ++i) { s.a[i] = A + (size_t)(ar0 + 32 * i) * lda + ac; s.b[i] = B + (size_t)brow(ar0 + 32 * i) * ldb + ac; }
      gemm_kloop(acc, s, K, lds); }
    bf16_t* O = MODE == 0 ? p.ya : p.yb;
#pragma unroll
    for (int m = 0; m < 4; ++m) {
        const int row = mt * 128 + wr * 64 + m * 16 + fr, col = nt * 128 + wc * 64 + 16 * fq;
        f32x4 v[4];
#pragma unroll
        for (int n = 0; n < 4; ++n) { v[n] = acc[m][n]; if (MODE == 0) v[n] *= *(const f32x4*)(p.pool_scale + layer * D + col + 4 * n); }
        uint4 q0, q1; pack16(v, q0, q1);
        uint4* o = (uint4*)(O + (size_t)row * D + col); o[0] = q0; o[1] = q1;
    }
}
__device__ __forceinline__ void stage_merge(PRef p, int layer, int item, char* lds) {
    GEMM_LANE_VARS
    const int mt = item >> 3, nt = item & 7;
    f32x4 macc[4][4]; zero_acc(macc);
#pragma unroll 1
    for (int k = 0; k < 3; ++k) {
        const bf16_t* A = (k == 0 ? p.Dp : (k == 1 ? p.yb : p.yc)) + (size_t)(mt * 128) * D;
        const bf16_t* B = p.w_br_t + ((size_t)(layer * 3 + k) * D + nt * 128) * D;
        f32x4 acc[4][4]; zero_acc(acc);
        { GemmSrc s;
#pragma unroll
          for (int i = 0; i < 4; ++i) { s.a[i] = A + (size_t)(ar0 + 32 * i) * D + ac; s.b[i] = B + (size_t)brow(ar0 + 32 * i) * D + ac; }
          gemm_kloop(acc, s, D, lds); }
#pragma unroll
        for (int m = 0; m < 4; ++m) {
            const int row = mt * 128 + wr * 64 + m * 16 + fr, col = nt * 128 + wc * 64 + 16 * fq;
            float rs = 1.0f;
            if (k == 2) { const f32x4* sq = (const f32x4*)(p.ssq + (size_t)row * 16); const f32x4 t = sq[0] + sq[1] + sq[2] + sq[3]; rs = rsqrtf((t[0] + t[1] + t[2] + t[3]) * (1.0f / D) + RMS_EPS); }
            const uint4* gp = (const uint4*)(p.U + (size_t)row * UC + U_GATE + k * D + col);
            const uint4 g0 = gp[0], g1 = gp[1];
            const unsigned gw[8] = {g0.x, g0.y, g0.z, g0.w, g1.x, g1.y, g1.z, g1.w};
#pragma unroll
            for (int n = 0; n < 4; ++n) {
                macc[m][n][0] += lo16(gw[2 * n]) * rs * acc[m][n][0]; macc[m][n][1] += hi16(gw[2 * n]) * rs * acc[m][n][1];
                macc[m][n][2] += lo16(gw[2 * n + 1]) * rs * acc[m][n][2]; macc[m][n][3] += hi16(gw[2 * n + 1]) * rs * acc[m][n][3];
            }
        }
    }
#pragma unroll
    for (int m = 0; m < 4; ++m) {
        const int row = mt * 128 + wr * 64 + m * 16 + fr, col = nt * 128 + wc * 64 + 16 * fq;
        uint4 q0, q1; pack16(macc[m], q0, q1);
        uint4* o = (uint4*)(p.m + (size_t)row * D + col); o[0] = q0; o[1] = q1;
    }
}
__device__ __forceinline__ void stage_outproj(PRef p, int layer, int item, char* lds) {
    GEMM_LANE_VARS
    const int mt = item >> 3, nt = item & 7;
    const bf16_t* A = p.m + (size_t)(mt * 128) * D; const bf16_t* B = p.w_out_t + ((size_t)layer * D + nt * 128) * D;
    f32x4 acc[4][4]; zero_acc(acc);
    { GemmSrc s;
#pragma unroll
      for (int i = 0; i < 4; ++i) { s.a[i] = A + (size_t)(ar0 + 32 * i) * D + ac; s.b[i] = B + (size_t)brow(ar0 + 32 * i) * D + ac; }
      gemm_kloop(acc, s, D, lds); }
#pragma unroll
    for (int m = 0; m < 4; ++m) {
        const int row = mt * 128 + wr * 64 + m * 16 + fr, col = nt * 128 + wc * 64 + 16 * fq; const float* g1 = modp(p, layer, modrow(row), 2) + col;
        float* r = p.res + (size_t)row * D + col;
#pragma unroll
        for (int n = 0; n < 4; ++n) { const f32x4 g = *(const f32x4*)(g1 + 4 * n); *(f32x4*)(r + 4 * n) = *(const f32x4*)(r + 4 * n) + g * acc[m][n]; }
    }
}
__device__ __forceinline__ int ld_cnt(PRef p, int i) { return __hip_atomic_load(p.cnt + i, __ATOMIC_RELAXED, __HIP_MEMORY_SCOPE_AGENT); }
struct MoeTile { int e, mt, nt, cnt, off; };
template <int NT>
__device__ __forceinline__ bool moe_decode(PRef p, int layer, int item, MoeTile& t) {
    const int mg = item / NT; t.nt = item % NT;
    int accm = 0, off = 0;
    for (int e = 0; e < NE; ++e) {
        const int c = ld_cnt(p, layer * NE + e), mtn = (c + 255) >> 8;
        if (mg < accm + mtn) { t.e = e; t.mt = mg - accm; t.cnt = c; t.off = off; return true; }
        accm += mtn; off += c;
    }
    return false;
}
__device__ __forceinline__ int moe_total_mtiles(PRef p, int layer) { int s = 0; for (int e = 0; e < NE; ++e) s += (ld_cnt(p, layer * NE + e) + 255) >> 8; return s; }
__device__ __forceinline__ void stage_moe1(PRef p, int layer, int item, char* lds) {
    GEMM2_LANE_VARS
    MoeTile t; if (!moe_decode<16>(p, layer, item, t)) return;
    const int* lst = p.list + (size_t)(layer * NE + t.e) * T;
    const bf16_t* B = p.w1_t + ((size_t)(layer * NE + t.e) * 2048 + t.nt * 128) * D;
    f32x4 acc[8][4]; zero_acc2(acc);
    { GemmSrc2 s;
#pragma unroll
      for (int i = 0; i < 4; ++i) { const int ii = t.mt * 256 + br0 + 64 * i; const int tok = lst[ii < t.cnt ? ii : t.cnt - 1] >> 2; s.a[i] = p.h + (size_t)tok * D + bc; }
#pragma unroll
      for (int i = 0; i < 2; ++i) s.b[i] = B + (size_t)brow(br0 + 64 * i) * D + bc;
      gemm_kloop2(acc, s, D, lds); }
    const float* b1 = p.moe_b1 + (size_t)(layer * NE + t.e) * 2048;
#pragma unroll
    for (int m = 0; m < 8; ++m) {
        const int i = t.mt * 256 + wr * 128 + m * 16 + fr;
        if (i < t.cnt) {
            const int gc = t.nt * 64 + wc * 32 + 8 * fq;
            float o[8];
#pragma unroll
            for (int n = 0; n < 2; ++n) {
                const f32x4 bg = *(const f32x4*)(b1 + gc + 4 * n), bl = *(const f32x4*)(b1 + 1024 + gc + 4 * n);
#pragma unroll
                for (int j = 0; j < 4; ++j) {
                    const float g = fminf(acc[m][n][j] + bg[j], 7.0f), l = fminf(fmaxf(acc[m][n + 2][j] + bl[j], -7.0f), 7.0f);
                    o[4 * n + j] = g * sigmoidf_(1.702f * g) * (l + 1.0f);
                }
            }
            uint4 q; q.x = pack2(o[0], o[1]); q.y = pack2(o[2], o[3]); q.z = pack2(o[4], o[5]); q.w = pack2(o[6], o[7]);
            *(uint4*)(p.act + (size_t)(t.off + i) * D + gc) = q;
        }
    }
}
__device__ __forceinline__ void stage_moe2(PRef p, int layer, int item, char* lds) {
    GEMM2_LANE_VARS
    MoeTile t; if (!moe_decode<8>(p, layer, item, t)) return;
    const int* lst = p.list + (size_t)(layer * NE + t.e) * T;
    const bf16_t* B = p.w2_t + ((size_t)(layer * NE + t.e) * D + t.nt * 128) * D;
    f32x4 acc[8][4]; zero_acc2(acc);
    { GemmSrc2 s;
#pragma unroll
      for (int i = 0; i < 4; ++i) { const int ii = t.mt * 256 + br0 + 64 * i; s.a[i] = p.act + (size_t)(t.off + (ii < t.cnt ? ii : t.cnt - 1)) * D + bc; }
#pragma unroll
      for (int i = 0; i < 2; ++i) s.b[i] = B + (size_t)brow(br0 + 64 * i) * D + bc;
      gemm_kloop2(acc, s, D, lds); }
    const float* b2 = p.moe_b2 + (size_t)(layer * NE + t.e) * D;
#pragma unroll
    for (int m = 0; m < 8; ++m) {
        const int i = t.mt * 256 + wr * 128 + m * 16 + fr;
        if (i < t.cnt) {
            const int pair = lst[i]; const float w = p.topw[pair]; const int col = t.nt * 128 + wc * 64 + 16 * fq;
            f32x4 v[4];
#pragma unroll
            for (int n = 0; n < 4; ++n) v[n] = (acc[m][n] + *(const f32x4*)(b2 + col + 4 * n)) * w;
            uint4 q0, q1; pack16(v, q0, q1);
            uint4* o = (uint4*)(p.sout + (size_t)pair * D + col); o[0] = q0; o[1] = q1;
        }
    }
}

constexpr int N_CONV = T / 32;
__device__ __forceinline__ void stage_conv(PRef p, int layer, int item) {
    const int c0 = tidx() * 8, r0 = item * 32;
    const int seq0 = r0 < TL ? (r0 / SEQ) * SEQ : TL + ((r0 - TL) / CTXL) * CTXL, seq1 = seq0 + (r0 < TL ? SEQ : CTXL);
    float w[5][8], bias[8];
#pragma unroll
    for (int j = 0; j < 5; ++j) { const f32x4 a = *(const f32x4*)(p.conv_w + (size_t)(layer * 5 + j) * 2048 + c0), b = *(const f32x4*)(p.conv_w + (size_t)(layer * 5 + j) * 2048 + c0 + 4);
        w[j][0] = a[0]; w[j][1] = a[1]; w[j][2] = a[2]; w[j][3] = a[3]; w[j][4] = b[0]; w[j][5] = b[1]; w[j][6] = b[2]; w[j][7] = b[3]; }
    { const f32x4 a = *(const f32x4*)(p.conv_b + layer * 2048 + c0), b = *(const f32x4*)(p.conv_b + layer * 2048 + c0 + 4);
      bias[0] = a[0]; bias[1] = a[1]; bias[2] = a[2]; bias[3] = a[3]; bias[4] = b[0]; bias[5] = b[1]; bias[6] = b[2]; bias[7] = b[3]; }
    float win[5][8];
    auto ldrow = [&](int r, float (&o)[8]) {
        if (r >= seq0 && r < seq1) { const uint4 q = *(const uint4*)(p.U + (size_t)r * UC + U_XBC + c0);
            o[0] = lo16(q.x); o[1] = hi16(q.x); o[2] = lo16(q.y); o[3] = hi16(q.y); o[4] = lo16(q.z); o[5] = hi16(q.z); o[6] = lo16(q.w); o[7] = hi16(q.w); }
        else {
#pragma unroll
            for (int i = 0; i < 8; ++i) o[i] = 0.f; }
    };
    ldrow(r0 - 2, win[0]); ldrow(r0 - 1, win[1]); ldrow(r0, win[2]); ldrow(r0 + 1, win[3]);
#pragma unroll 8
    for (int r = r0; r < r0 + 32; ++r) {
        ldrow(r + 2, win[4]);
        float o[8];
#pragma unroll
        for (int i = 0; i < 8; ++i) { float s = bias[i];
#pragma unroll
            for (int j = 0; j < 5; ++j) s += w[j][i] * win[j][i];
            o[i] = siluf_(s); }
        uint4 q; q.x = pack2(o[0], o[1]); q.y = pack2(o[2], o[3]); q.z = pack2(o[4], o[5]); q.w = pack2(o[6], o[7]);
        *(uint4*)(p.V + (size_t)r * 2048 + c0) = q;
#pragma unroll
        for (int j = 0; j < 4; ++j)
#pragma unroll
            for (int i = 0; i < 8; ++i) win[j][i] = win[j + 1][i];
    }
}

constexpr int N_POOL_LAT = NB * 4 * 4 * 16, N_POOL = N_POOL_LAT + NB * 4 * 64;
__device__ __forceinline__ void pool_acc(const uint2 q, float w, float (&v)[4]) { v[0] += w * lo16(q.x); v[1] += w * hi16(q.x); v[2] += w * lo16(q.y); v[3] += w * hi16(q.y); }
template <int W>
__device__ __forceinline__ void pool_lat(PRef p, int g, int b, int band, int c, int lane) {
    constexpr int lo = -(W >> 1), hi = W - (W >> 1) - 1;
    const int r0 = band * 32, cc0 = max(c + lo, 0), cc1 = min(c + hi, 63), ncol = cc1 - cc0 + 1;
    const bf16_t* base = p.U + (size_t)(b * SEQ) * UC + g * 256 + lane * 4;
    float vs[4] = {0.f, 0.f, 0.f, 0.f};
    auto addH = [&](int rr, float sg) {
        const bool rv = rr >= 0 && rr <= 127; const int rc = min(max(rr, 0), 127);
        uint2 q[W];
#pragma unroll
        for (int i = 0; i < W; ++i) { const int cc = min(cc0 + i, 63); q[i] = *(const uint2*)(base + (size_t)(rc * 64 + cc) * UC); }
#pragma unroll
        for (int i = 0; i < W; ++i) pool_acc(q[i], (rv && i < ncol) ? sg : 0.f, vs);
    };
#pragma unroll 1
    for (int rr = r0 + lo; rr <= r0 + hi; ++rr) addH(rr, 1.0f);
#pragma unroll 1
    for (int r = r0; r < r0 + 32; ++r) {
        const int rlo = max(r + lo, 0), rhi = min(r + hi, 127);
        const float inv = 1.0f / (float)((rhi - rlo + 1) * ncol);
        const uint2 sq = *(const uint2*)(base + (size_t)(r * 64 + c) * UC);
        uint2 q; q.x = pack2(vs[0] * inv - lo16(sq.x), vs[1] * inv - hi16(sq.x)); q.y = pack2(vs[2] * inv - lo16(sq.y), vs[3] * inv - hi16(sq.y));
        *(uint2*)(p.Dp + (size_t)(b * SEQ + r * 64 + c) * D + g * 256 + lane * 4) = q;
        {
            const int ra = r + lo, rb = r + 1 + hi;
            const bool va = ra >= 0, vb = rb <= 127; const int rac = max(ra, 0), rbc = min(rb, 127);
            uint2 qa[W], qb[W];
#pragma unroll
            for (int i = 0; i < W; ++i) { const int cc = min(cc0 + i, 63); qa[i] = *(const uint2*)(base + (size_t)(rac * 64 + cc) * UC); qb[i] = *(const uint2*)(base + (size_t)(rbc * 64 + cc) * UC); }
#pragma unroll
            for (int i = 0; i < W; ++i) { pool_acc(qa[i], (va && i < ncol) ? -1.0f : 0.f, vs); pool_acc(qb[i], (vb && i < ncol) ? 1.0f : 0.f, vs); }
        }
    }
}
__device__ __forceinline__ void stage_pool(PRef p, int item) {
    const int tid = tidx(), wave = tid >> 6, lane = tid & 63;
    if (item < N_POOL_LAT) {
        const int g = 3 - (item >> 7), b = (item >> 6) & 1, band = (item >> 4) & 3, c = (item & 15) * 4 + wave;
        if (g == 3) pool_lat<16>(p, g, b, band, c, lane);
        else if (g == 2) pool_lat<8>(p, g, b, band, c, lane);
        else if (g == 1) pool_lat<4>(p, g, b, band, c, lane);
        else pool_lat<2>(p, g, b, band, c, lane);
    } else {
        const int it = item - N_POOL_LAT, g = 3 - (it >> 7), b = (it >> 6) & 1, n = (it & 63) * 4 + wave;
        const int w = 2 << g, lo = -(w >> 1), hi = w - (w >> 1) - 1, t0 = max(n + lo, 0), t1 = min(n + hi, CTXL - 1);
        const bf16_t* base = p.U + (size_t)(TL + b * CTXL) * UC + g * 256 + lane * 4;
        float s[4] = {0.f, 0.f, 0.f, 0.f};
        uint2 q[16];
#pragma unroll
        for (int i = 0; i < 16; ++i) q[i] = *(const uint2*)(base + (size_t)min(t0 + i, CTXL - 1) * UC);
#pragma unroll
        for (int i = 0; i < 16; ++i) pool_acc(q[i], (t0 + i <= t1) ? 1.0f : 0.f, s);
        const float inv = 1.0f / (float)(t1 - t0 + 1);
        const uint2 sq = *(const uint2*)(base + (size_t)n * UC);
        uint2 o; o.x = pack2(s[0] * inv - lo16(sq.x), s[1] * inv - hi16(sq.x)); o.y = pack2(s[2] * inv - lo16(sq.y), s[3] * inv - hi16(sq.y));
        *(uint2*)(p.Dp + (size_t)(TL + b * CTXL + n) * D + g * 256 + lane * 4) = o;
    }
}

typedef unsigned u32x2 __attribute__((ext_vector_type(2)));
union Frag8 { bf16x8 v; u32x2 h[2]; };
template <int OFF>
__device__ __forceinline__ void tr_frag4(bf16x8 (&f)[4], unsigned a0, unsigned a1, unsigned a2, unsigned a3) {
    Frag8 r0, r1, r2, r3;
    asm volatile("ds_read_b64_tr_b16 %0, %8\n\tds_read_b64_tr_b16 %1, %8 offset:%c12\n\t"
                 "ds_read_b64_tr_b16 %2, %9\n\tds_read_b64_tr_b16 %3, %9 offset:%c12\n\t"
                 "ds_read_b64_tr_b16 %4, %10\n\tds_read_b64_tr_b16 %5, %10 offset:%c12\n\t"
                 "ds_read_b64_tr_b16 %6, %11\n\tds_read_b64_tr_b16 %7, %11 offset:%c12\n\t"
                 "s_waitcnt lgkmcnt(0)"
                 : "=&v"(r0.h[0]), "=&v"(r0.h[1]), "=&v"(r1.h[0]), "=&v"(r1.h[1]), "=&v"(r2.h[0]), "=&v"(r2.h[1]), "=&v"(r3.h[0]), "=&v"(r3.h[1])
                 : "v"(a0), "v"(a1), "v"(a2), "v"(a3), "i"(OFF) : "memory");
    f[0] = r0.v; f[1] = r1.v; f[2] = r2.v; f[3] = r3.v;
}
__device__ __forceinline__ unsigned lds_addr(const void* p) { return (unsigned)(size_t)p; }
constexpr int PBA = 544, N_FOURA = NB * 128 * 4;
__device__ __forceinline__ void stage_fourA(PRef p, int item, char* lds) {
    const int tid = tidx(), wid = tid >> 6, lane = tid & 63, fr = lane & 15, fq = lane >> 4;
    const int b = item >> 9, n2 = (item >> 2) & 127, c0 = (item & 3) * 256;
    const bf16_t* tA = p.tabA + ((size_t)n2 * 128 + fr) * 64 + fq * 8;
    bf16x8 tf[2][8];
#pragma unroll
    for (int rt = 0; rt < 8; ++rt) tf[0][rt] = *(const bf16x8*)(tA + rt * 16 * 64);
    __syncthreads();
#pragma unroll
    for (int i = 0; i < 8; ++i) {
        const int id = tid + 256 * i, r = id >> 5, o = id & 31;
        const uint4 q = *(const uint4*)(p.U + (size_t)(b * SEQ + 128 * r + n2) * UC + U_FOUR + c0 + o * 8);
        *(uint4*)(lds + r * PBA + o * 16) = q;
    }
    __syncthreads();
    f32x4 acc[4][8];
#pragma unroll
    for (int a = 0; a < 4; ++a)
#pragma unroll
        for (int r = 0; r < 8; ++r) acc[a][r] = (f32x4){0.f, 0.f, 0.f, 0.f};
    const unsigned base = lds_addr(lds) + (unsigned)((8 * fq + (fr >> 2)) * PBA + (wid * 64 + 4 * (fr & 3)) * 2);
#pragma unroll
    for (int ks = 0; ks < 2; ++ks) {
        bf16x8 xf[4];
        if (ks == 0) {
#pragma unroll
            for (int rt = 0; rt < 8; ++rt) tf[1][rt] = *(const bf16x8*)(tA + rt * 16 * 64 + 32);
        }
        const unsigned a = base + ks * 32 * PBA;
        tr_frag4<4 * PBA>(xf, a, a + 32, a + 64, a + 96);
#pragma unroll
        for (int ct = 0; ct < 4; ++ct)
#pragma unroll
            for (int rt = 0; rt < 8; ++rt) acc[ct][rt] = __builtin_amdgcn_mfma_f32_16x16x32_bf16(xf[ct], tf[ks][rt], acc[ct][rt], 0, 0, 0);
    }
#pragma unroll
    for (int rt = 0; rt < 8; ++rt) {
        const int rA = rt * 16 + fr, k1 = rA >> 1, ri = rA & 1;
        bf16_t* o = p.Ap + ((size_t)(b * 64 + k1) * 256 + n2 * 2 + ri) * D + c0 + wid * 64 + 4 * fq;
#pragma unroll
        for (int ct = 0; ct < 4; ++ct) { uint2 q; q.x = pack2(acc[ct][rt][0], acc[ct][rt][1]); q.y = pack2(acc[ct][rt][2], acc[ct][rt][3]); *(uint2*)(o + ct * 16) = q; }
    }
}
constexpr int PBB = 288, N_FOURB_LAT = NB * 64 * 8, N_FOURB = N_FOURB_LAT + NB * 2 * 8;
__device__ __forceinline__ void stage_fourB(PRef p, int item, char* lds) {
    const int tid = tidx(), wid = tid >> 6, lane = tid & 63, fr = lane & 15, fq = lane >> 4;
    const bf16_t* xsrc; size_t xpitch; const bf16_t* tab; int orow0, orstep, c0;
    if (item < N_FOURB_LAT) { const int b = item >> 9, k1 = (item >> 3) & 63; c0 = (item & 7) * 128;
        xsrc = p.Ap + (size_t)(b * 64 + k1) * 256 * D + c0; xpitch = D; tab = p.tabB; orow0 = b * SEQ + k1; orstep = 64; }
    else { const int it = item - N_FOURB_LAT, b = it >> 4, half = (it >> 3) & 1; c0 = (it & 7) * 128;
        xsrc = p.U + (size_t)(TL + b * CTXL) * UC + U_FOUR + c0; xpitch = UC; tab = p.tabC + half * 65536; orow0 = TL + b * CTXL + half * 128; orstep = 1; }
    f32x4 acc[8][4];
#pragma unroll
    for (int a = 0; a < 8; ++a)
#pragma unroll
        for (int r = 0; r < 4; ++r) acc[a][r] = (f32x4){0.f, 0.f, 0.f, 0.f};
    const unsigned base = lds_addr(lds) + (unsigned)((8 * fq + (fr >> 2)) * PBB + (4 * (fr & 3)) * 2);
    const bf16_t* tB = tab + (size_t)(wid * 64 + fr) * 256 + fq * 8;
#pragma unroll 1
    for (int kh = 0; kh < 2; ++kh) {
        bf16x8 tf0[4];
#pragma unroll
        for (int rt = 0; rt < 4; ++rt) tf0[rt] = *(const bf16x8*)(tB + rt * 16 * 256 + kh * 128);
        __syncthreads();
#pragma unroll
        for (int i = 0; i < 8; ++i) {
            const int id = tid + 256 * i, r = id >> 4, o = id & 15;
            const uint4 q = *(const uint4*)(xsrc + (size_t)(kh * 128 + r) * xpitch + o * 8);
            *(uint4*)(lds + r * PBB + o * 16) = q;
        }
        __syncthreads();
#pragma unroll
        for (int ks = 0; ks < 4; ++ks) {
            bf16x8 xf[8], tf[4];
#pragma unroll
            for (int rt = 0; rt < 4; ++rt) tf[rt] = tf0[rt];
            if (ks < 3) {
#pragma unroll
                for (int rt = 0; rt < 4; ++rt) tf0[rt] = *(const bf16x8*)(tB + rt * 16 * 256 + kh * 128 + (ks + 1) * 32);
            }
            const unsigned a = base + ks * 32 * PBB;
            { bf16x8 t4[4]; tr_frag4<4 * PBB>(t4, a, a + 32, a + 64, a + 96); xf[0] = t4[0]; xf[1] = t4[1]; xf[2] = t4[2]; xf[3] = t4[3]; }
            { bf16x8 t4[4]; tr_frag4<4 * PBB>(t4, a + 128, a + 160, a + 192, a + 224); xf[4] = t4[0]; xf[5] = t4[1]; xf[6] = t4[2]; xf[7] = t4[3]; }
#pragma unroll
            for (int ct = 0; ct < 8; ++ct)
#pragma unroll
                for (int rt = 0; rt < 4; ++rt) acc[ct][rt] = __builtin_amdgcn_mfma_f32_16x16x32_bf16(xf[ct], tf[rt], acc[ct][rt], 0, 0, 0);
        }
    }
    const int g = c0 >> 8, cg = c0 & 255;
#pragma unroll
    for (int rt = 0; rt < 4; ++rt) {
        const int rB = wid * 64 + rt * 16 + fr, kk = rB >> 1, ro = rB & 1;
        bf16_t* o = p.Yb + (size_t)(orow0 + kk * orstep) * 2048 + g * 512 + ro * 256 + cg + 4 * fq;
#pragma unroll
        for (int ct = 0; ct < 8; ++ct) { uint2 q; q.x = pack2(acc[ct][rt][0], acc[ct][rt][1]); q.y = pack2(acc[ct][rt][2], acc[ct][rt][3]); *(uint2*)(o + ct * 16) = q; }
    }
}

constexpr int NCH = T / 128, N_ACSUM = NCH;
__device__ __forceinline__ void stage_acsum(PRef p, int layer, int item, char* lds) {
    const int tid = tidx(), col = tid & 31, seg = tid >> 5, d = col >> 4, h = col & 15;
    float* part = (float*)lds;
    const float A = -__expf(p.a_log[(layer * 2 + d) * NH + h]);
    float v[16];
#pragma unroll
    for (int i = 0; i < 16; ++i) { const int pos = seg * 16 + i, r = item * 128 + (d == 0 ? pos : 127 - pos); v[i] = p.dt[(size_t)r * 32 + col] * A; }
    float s = 0.f;
#pragma unroll
    for (int i = 0; i < 16; ++i) { s += v[i]; v[i] = s; }
    __syncthreads();
    part[seg * 32 + col] = s;
    __syncthreads();
    float base = 0.f;
#pragma unroll
    for (int j = 0; j < 8; ++j) base += (j < seg) ? part[j * 32 + col] : 0.f;
#pragma unroll
    for (int i = 0; i < 16; ++i) { const int pos = seg * 16 + i, r = item * 128 + (d == 0 ? pos : 127 - pos); p.ac[(size_t)r * 32 + col] = base + v[i]; }
}
template <int OFF>
__device__ __forceinline__ void tr_frag4b(bf16x8 (&f)[4], unsigned a, int step) { tr_frag4<OFF>(f, a, a + step, a + 2 * step, a + 3 * step); }
constexpr int PBS = 288, PXS = 160, N_CSTATE = NCH * NH;
__device__ __forceinline__ void stage_cstate(PRef p, int item, char* lds) {
    const int tid = tidx(), wid = tid >> 6, lane = tid & 63, fr = lane & 15, fq = lane >> 4;
    const int cid = item >> 4, hh = item & 15, g = hh >> 2, row0 = cid * 128;
    char* LB = lds; char* LX = lds + 128 * PBS; float* wgt = (float*)(lds + 128 * PBS + 128 * PXS);
    __syncthreads();
#pragma unroll
    for (int i = 0; i < 8; ++i) { const int id = tid + 256 * i, r = id >> 4, o = id & 15;
        *(uint4*)(LB + r * PBS + o * 16) = *(const uint4*)(p.V + (size_t)(row0 + r) * 2048 + 1024 + g * NS + o * 8); }
#pragma unroll
    for (int i = 0; i < 4; ++i) { const int id = tid + 256 * i, r = id >> 3, o = id & 7;
        *(uint4*)(LX + r * PXS + o * 16) = *(const uint4*)(p.V + (size_t)(row0 + r) * 2048 + hh * HD + o * 8); }
    { const int d = tid >> 7, l = tid & 127; const int col = d * 16 + hh;
      const float tot = p.ac[(size_t)(row0 + (d == 0 ? 127 : 0)) * 32 + col];
      wgt[tid] = p.dt[(size_t)(row0 + l) * 32 + col] * __expf(tot - p.ac[(size_t)(row0 + l) * 32 + col]); }
    __syncthreads();
    const int d = wid >> 1, nh = wid & 1;
    f32x4 acc[4][4];
#pragma unroll
    for (int a = 0; a < 4; ++a)
#pragma unroll
        for (int b = 0; b < 4; ++b) acc[a][b] = (f32x4){0.f, 0.f, 0.f, 0.f};
    const unsigned rowoff = 8 * fq + (fr >> 2), coloff = 4 * (fr & 3);
    const unsigned baseB = lds_addr(LB) + rowoff * PBS + (nh * 64 + coloff) * 2, baseX = lds_addr(LX) + rowoff * PXS + coloff * 2;
#pragma unroll
    for (int ks = 0; ks < 4; ++ks) {
        bf16x8 bt[4], xr[4], xs[4];
        tr_frag4b<4 * PBS>(bt, baseB + ks * 32 * PBS, 32);
        tr_frag4b<4 * PXS>(xr, baseX + ks * 32 * PXS, 32);
        const f32x4 w0 = *(const f32x4*)(wgt + d * 128 + ks * 32 + 8 * fq), w1 = *(const f32x4*)(wgt + d * 128 + ks * 32 + 8 * fq + 4);
#pragma unroll
        for (int pt = 0; pt < 4; ++pt)
#pragma unroll
            for (int e = 0; e < 8; ++e) xs[pt][e] = (short)f2bf(bf2f((bf16_t)xr[pt][e]) * (e < 4 ? w0[e & 3] : w1[e & 3]));
#pragma unroll
        for (int nt = 0; nt < 4; ++nt)
#pragma unroll
            for (int pt = 0; pt < 4; ++pt) acc[nt][pt] = __builtin_amdgcn_mfma_f32_16x16x32_bf16(bt[nt], xs[pt], acc[nt][pt], 0, 0, 0);
    }
    bf16_t* o = p.Scs + ((size_t)((cid * 2 + d) * 16 + hh) * 64) * NS + nh * 64 + 4 * fq;
#pragma unroll
    for (int pt = 0; pt < 4; ++pt)
#pragma unroll
        for (int nt = 0; nt < 4; ++nt) { uint2 q; q.x = pack2(acc[nt][pt][0], acc[nt][pt][1]); q.y = pack2(acc[nt][pt][2], acc[nt][pt][3]);
            *(uint2*)(o + (size_t)(pt * 16 + fr) * NS + nt * 16) = q; }
}
constexpr int N_SCAN = NB * 2 * NH * HD * 16 / 256;
__device__ __forceinline__ void stage_scan(PRef p, int item) {
    const int idx = item * 256 + tidx(), n8 = idx & 15, pp = (idx >> 4) & 63, hh = (idx >> 10) & 15, d = (idx >> 14) & 1, b = idx >> 15;
    float s[8];
#pragma unroll
    for (int i = 0; i < 8; ++i) s[i] = 0.f;
#pragma unroll 4
    for (int t = 0; t < 66; ++t) {
        const int cid = t < 2 ? 128 + b * 2 + (d == 0 ? t : 1 - t) : b * 64 + (d == 0 ? t - 2 : 65 - t);
        const size_t o = ((size_t)((cid * 2 + d) * 16 + hh) * 64 + pp) * NS + n8 * 8;
        uint4 q; q.x = pack2(s[0], s[1]); q.y = pack2(s[2], s[3]); q.z = pack2(s[4], s[5]); q.w = pack2(s[6], s[7]);
        *(uint4*)(p.Sst + o) = q;
        const uint4 c = *(const uint4*)(p.Scs + o);
        const float dec = __expf(p.ac[(size_t)(cid * 128 + (d == 0 ? 127 : 0)) * 32 + d * 16 + hh]);
        s[0] = s[0] * dec + lo16(c.x); s[1] = s[1] * dec + hi16(c.x); s[2] = s[2] * dec + lo16(c.y); s[3] = s[3] * dec + hi16(c.y);
        s[4] = s[4] * dec + lo16(c.z); s[5] = s[5] * dec + hi16(c.z); s[6] = s[6] * dec + lo16(c.w); s[7] = s[7] * dec + hi16(c.w);
    }
}
constexpr int N_SSDOUT = 128 * 4 + 4 * 4 * 4;
__device__ __forceinline__ void stage_ssdout(PRef p, int layer, int item, char* lds) {
    const int tid = tidx(), wid = tid >> 6, lane = tid & 63, fr = lane & 15, fq = lane >> 4;
    int cid, g, h0, nh;
    if (item < 512) { cid = item >> 2; g = item & 3; h0 = 0; nh = 4; } else { const int it = item - 512; cid = 128 + (it >> 4); g = (it >> 2) & 3; h0 = it & 3; nh = 1; }
    const int row0 = cid * 128;
    char* LX = lds; float* acd = (float*)(lds + 128 * PXS); float* dtd = acd + 256;
    char* SB = lds + 128 * PXS + 2048;
    const int srow = tid >> 4, sslot = tid & 15, schunk = (sslot ^ (srow & 15)) * 8;
    __syncthreads();
#pragma unroll
    for (int i = 0; i < 8; ++i) __builtin_amdgcn_global_load_lds((const unsigned*)(p.V + (size_t)(row0 + srow + 16 * i) * 2048 + 1024 + g * NS + schunk), (unsigned*)(SB + i * 4096 + tid * 16), 16, 0, 0);
    bf16x8 cf[2][4];
#pragma unroll
    for (int lt = 0; lt < 2; ++lt)
#pragma unroll
        for (int ks = 0; ks < 4; ++ks) cf[lt][ks] = *(const bf16x8*)(p.V + (size_t)(row0 + wid * 32 + lt * 16 + fr) * 2048 + 1536 + g * NS + ks * 32 + fq * 8);
    asm volatile("s_waitcnt vmcnt(0)" ::: "memory");
    __syncthreads();
    f32x4 cbt[8][2];
#pragma unroll
    for (int st = 0; st < 8; ++st) {
        bf16x8 bfA[4];
#pragma unroll
        for (int ks = 0; ks < 4; ++ks) bfA[ks] = *(const bf16x8*)(SB + (st * 16 + fr) * 256 + (((ks * 4 + fq) ^ fr) * 16));
#pragma unroll
        for (int lt = 0; lt < 2; ++lt) { f32x4 a = {0.f, 0.f, 0.f, 0.f};
#pragma unroll
            for (int ks = 0; ks < 4; ++ks) a = __builtin_amdgcn_mfma_f32_16x16x32_bf16(bfA[ks], cf[lt][ks], a, 0, 0, 0);
            cbt[st][lt] = a; }
    }
    const unsigned baseX = lds_addr(LX) + (4 * fq + (fr >> 2)) * PXS + 4 * (fr & 3) * 2;
#pragma unroll 1
    for (int hi = h0; hi < h0 + nh; ++hi) {
        const int hh = g * 4 + hi;
        float ssq[2] = {0.f, 0.f};
        __syncthreads();
        { const int t2 = tidx(), srow2 = t2 >> 4, schunk2 = ((t2 & 15) ^ (srow2 & 15)) * 8;
#pragma unroll
        for (int d = 0; d < 2; ++d) { const bf16_t* S = p.Sst + ((size_t)((cid * 2 + d) * 16 + hh) * 64) * NS;
#pragma unroll
            for (int i = 0; i < 4; ++i) __builtin_amdgcn_global_load_lds((const unsigned*)(S + (size_t)(srow2 + 16 * i) * NS + schunk2), (unsigned*)(SB + d * 16384 + i * 4096 + t2 * 16), 16, 0, 0); } }
#pragma unroll
        for (int i = 0; i < 4; ++i) { const int id = tid + 256 * i, r = id >> 3, o = id & 7;
            *(uint4*)(LX + r * PXS + o * 16) = *(const uint4*)(p.V + (size_t)(row0 + r) * 2048 + hh * HD + o * 8); }
        { const int d = tid >> 7, l = tid & 127; acd[tid] = p.ac[(size_t)(row0 + l) * 32 + d * 16 + hh]; dtd[tid] = p.dt[(size_t)(row0 + l) * 32 + d * 16 + hh]; }
        asm volatile("s_waitcnt vmcnt(0)" ::: "memory");
        __syncthreads();
        f32x4 yacc[4][2];
#pragma unroll
        for (int pt = 0; pt < 4; ++pt) { yacc[pt][0] = (f32x4){0.f, 0.f, 0.f, 0.f}; yacc[pt][1] = (f32x4){0.f, 0.f, 0.f, 0.f}; }
#pragma unroll
        for (int d = 0; d < 2; ++d) {
            const float el0 = acd[d * 128 + wid * 32 + fr], el1 = acd[d * 128 + wid * 32 + 16 + fr];
#pragma unroll
            for (int ks = 0; ks < 4; ++ks) {
                if (d == 0 ? ks > wid : ks < wid) continue;
                const int s0 = 32 * ks + 4 * fq;
                const f32x4 as0 = *(const f32x4*)(acd + d * 128 + s0), as1 = *(const f32x4*)(acd + d * 128 + s0 + 16);
                const f32x4 ds0 = *(const f32x4*)(dtd + d * 128 + s0), ds1 = *(const f32x4*)(dtd + d * 128 + s0 + 16);
                bf16x8 gf[2];
#pragma unroll
                for (int lt = 0; lt < 2; ++lt) {
                    const int l = wid * 32 + lt * 16 + fr; const float el = lt ? el1 : el0;
#pragma unroll
                    for (int e = 0; e < 4; ++e) {
                        const int sa = s0 + e, sb = s0 + 16 + e;
                        const bool ma = d == 0 ? (sa <= l) : (sa >= l), mb = d == 0 ? (sb <= l) : (sb >= l);
                        const float va = ma ? cbt[2 * ks][lt][e] * __expf(fminf(el - as0[e], 0.f)) * ds0[e] : 0.f;
                        const float vb = mb ? cbt[2 * ks + 1][lt][e] * __expf(fminf(el - as1[e], 0.f)) * ds1[e] : 0.f;
                        gf[lt][e] = (short)f2bf(va); gf[lt][4 + e] = (short)f2bf(vb);
                    }
                }
                bf16x8 xf[4];
                tr_frag4b<16 * PXS>(xf, baseX + ks * 32 * PXS, 32);
#pragma unroll
                for (int pt = 0; pt < 4; ++pt) { yacc[pt][0] = __builtin_amdgcn_mfma_f32_16x16x32_bf16(xf[pt], gf[0], yacc[pt][0], 0, 0, 0);
                                                 yacc[pt][1] = __builtin_amdgcn_mfma_f32_16x16x32_bf16(xf[pt], gf[1], yacc[pt][1], 0, 0, 0); }
            }
            const float ex0 = __expf(el0), ex1 = __expf(el1);
            const char* S = SB + d * 16384;
#pragma unroll
            for (int pt = 0; pt < 4; ++pt) {
                f32x4 o0 = {0.f, 0.f, 0.f, 0.f}, o1 = {0.f, 0.f, 0.f, 0.f};
#pragma unroll
                for (int ks = 0; ks < 4; ++ks) { const bf16x8 sf = *(const bf16x8*)(S + (pt * 16 + fr) * 256 + (((ks * 4 + fq) ^ fr) * 16));
                    o0 = __builtin_amdgcn_mfma_f32_16x16x32_bf16(sf, cf[0][ks], o0, 0, 0, 0); o1 = __builtin_amdgcn_mfma_f32_16x16x32_bf16(sf, cf[1][ks], o1, 0, 0, 0); }
                yacc[pt][0] += o0 * ex0; yacc[pt][1] += o1 * ex1;
            }
        }
        const float dsk = p.d_skip[layer * NH + hh];
#pragma unroll
        for (int lt = 0; lt < 2; ++lt) {
            const int l = wid * 32 + lt * 16 + fr; const size_t row = (size_t)(row0 + l);
#pragma unroll
            for (int pt = 0; pt < 4; ++pt) {
                const int pc = pt * 16 + 4 * fq;
                const uint2 xq = *(const uint2*)(LX + l * PXS + pc * 2);
                const uint2 zq = *(const uint2*)(p.U + row * UC + U_Z + hh * HD + pc);
                const float xv[4] = {lo16(xq.x), hi16(xq.x), lo16(xq.y), hi16(xq.y)}, zv[4] = {lo16(zq.x), hi16(zq.x), lo16(zq.y), hi16(zq.y)};
                float o[4];
#pragma unroll
                for (int j = 0; j < 4; ++j) { o[j] = (yacc[pt][lt][j] + dsk * xv[j]) * siluf_(zv[j]); ssq[lt] += o[j] * o[j]; }
                uint2 q; q.x = pack2(o[0], o[1]); q.y = pack2(o[2], o[3]);
                *(uint2*)(p.yc + row * D + hh * HD + pc) = q;
            }
        }
#pragma unroll
        for (int lt = 0; lt < 2; ++lt) { float s = ssq[lt]; s += __shfl_xor(s, 16); s += __shfl_xor(s, 32);
            if (fq == 0) p.ssq[(size_t)(row0 + wid * 32 + lt * 16 + fr) * 16 + hh] = s; }
    }
}

constexpr int N_ROUTER = T / 32, HSP = 1028;
__device__ __forceinline__ void stage_router(PRef p, int layer, int item, char* lds) {
    const int tid = tidx(), wave = tid >> 6, lane = tid & 63;
    float* hs = (float*)lds;
    float* part = hs + 16 * HSP;
    int* pe = (int*)(part + 4 * 16 * 32);
    int* hist = pe + 256;
    int* rank = hist + 32;
    const float* nw = p.norm2_w + layer * D;
    __syncthreads();
    if (tid < 32) hist[tid] = 0;
#pragma unroll 1
    for (int rnd = 0; rnd < 2; ++rnd) {
        const int rowb = item * 32 + rnd * 16;
#pragma unroll 1
        for (int t = 0; t < 4; ++t) {
            const int tl = wave * 4 + t, row = rowb + tl, mrow = modrow(row);
            const float* sh = modp(p, layer, mrow, 3); const float* sc = modp(p, layer, mrow, 4);
            f32x4 v[4]; float ss = 0.f;
#pragma unroll
            for (int j = 0; j < 4; ++j) { v[j] = *(const f32x4*)(p.res + (size_t)row * D + 4 * lane + 256 * j); ss += v[j][0] * v[j][0] + v[j][1] * v[j][1] + v[j][2] * v[j][2] + v[j][3] * v[j][3]; }
            ss = wave_sum(ss); const float rinv = rsqrtf(ss * (1.0f / D) + RMS_EPS);
#pragma unroll
            for (int j = 0; j < 4; ++j) {
                const int k = 4 * lane + 256 * j;
                const f32x4 w = *(const f32x4*)(nw + k), a = *(const f32x4*)(sc + k), bb = *(const f32x4*)(sh + k);
                const f32x4 hv = v[j] * rinv * w * (a + 1.0f) + bb;
                uint2 q; q.x = pack2(hv[0], hv[1]); q.y = pack2(hv[2], hv[3]);
                *(uint2*)(p.h + (size_t)row * D + k) = q;
                *(f32x4*)(hs + tl * HSP + k) = hv;
            }
        }
        __syncthreads();
        {
            const int i = lane & 15, kq = lane >> 4;
            const float* rw = p.router_w + (size_t)layer * D * NE + (lane & 15);
            f32x4 a0 = {0.f, 0.f, 0.f, 0.f}, a1 = {0.f, 0.f, 0.f, 0.f};
#pragma unroll 4
            for (int q = 0; q < 16; ++q) {
                const int kb = wave * 256 + q * 16 + kq * 4;
                const f32x4 av = *(const f32x4*)(hs + i * HSP + kb);
#pragma unroll
                for (int j = 0; j < 4; ++j) {
                    const float b0 = rw[(size_t)(kb + j) * NE], b1 = rw[(size_t)(kb + j) * NE + 16];
                    a0 = __builtin_amdgcn_mfma_f32_16x16x4f32(av[j], b0, a0, 0, 0, 0);
                    a1 = __builtin_amdgcn_mfma_f32_16x16x4f32(av[j], b1, a1, 0, 0, 0);
                }
            }
#pragma unroll
            for (int r = 0; r < 4; ++r) { part[(wave * 16 + 4 * kq + r) * 32 + i] = a0[r]; part[(wave * 16 + 4 * kq + r) * 32 + 16 + i] = a1[r]; }
        }
        __syncthreads();
        if (tid < 16) {
            float lg[32];
#pragma unroll
            for (int e = 0; e < 32; ++e) lg[e] = part[(0 * 16 + tid) * 32 + e] + part[(1 * 16 + tid) * 32 + e] + part[(2 * 16 + tid) * 32 + e] + part[(3 * 16 + tid) * 32 + e] + p.router_b[layer * NE + e];
            float tv[4]; int ti[4];
#pragma unroll
            for (int r = 0; r < 4; ++r) {
                float bv = -3.0e38f; int bi = 0;
#pragma unroll
                for (int e = 0; e < 32; ++e) { const bool tk = (r > 0 && ti[0] == e) || (r > 1 && ti[1] == e) || (r > 2 && ti[2] == e); if (!tk && lg[e] > bv) { bv = lg[e]; bi = e; } }
                tv[r] = bv; ti[r] = bi;
            }
            const int row = rowb + tid;
            const float e1 = __expf(tv[1] - tv[0]), e2 = __expf(tv[2] - tv[0]), e3 = __expf(tv[3] - tv[0]); const float inv = 1.0f / (1.0f + e1 + e2 + e3);
            *(f32x4*)(p.topw + (size_t)row * 4) = (f32x4){inv, e1 * inv, e2 * inv, e3 * inv};
#pragma unroll
            for (int r = 0; r < 4; ++r) { p.topi[row * 4 + r] = ti[r]; pe[(rnd * 16 + tid) * 4 + r] = ti[r]; }
        }
        __syncthreads();
    }
    if (tid < 128) rank[tid] = atomicAdd(&hist[pe[tid]], 1);
    __syncthreads();
    if (tid < 32) { const int c = hist[tid]; hist[tid] = c ? atomicAdd(&p.cnt[layer * NE + tid], c) : 0; }
    __syncthreads();
    if (tid < 128) { const int e = pe[tid]; p.list[(size_t)(layer * NE + e) * T + hist[e] + rank[tid]] = (item * 32 + (tid >> 2)) * 4 + (tid & 3); }
}

#define XB_TMO      128
#define XB_XCNT(j)  (256  + 64 * (j))
#define XB_XSUB(j)  (1280 + 64 * (j))
#define XB_XGEN(j)  (2304 + 64 * (j))
#define XB_TOP      3328
#define XB_TOPGEN   3392
#define XB_XSH(j, s) (3456 + 64 * (4 * (j) + (s)))
#define XCD_BAR_WORDS (3456 + 64 * 64)
#define XB_SPIN_CAP (1u << 22)
#define LAS __attribute__((address_space(3)))
__device__ __forceinline__ unsigned xb_ld(unsigned* p)              { return __hip_atomic_load(p, __ATOMIC_RELAXED, __HIP_MEMORY_SCOPE_AGENT); }
__device__ __forceinline__ unsigned xb_add(unsigned* p, unsigned v) { return __hip_atomic_fetch_add(p, v, __ATOMIC_RELAXED, __HIP_MEMORY_SCOPE_AGENT); }
__device__ __forceinline__ unsigned xb_xcc_id() { return (unsigned)__builtin_amdgcn_s_getreg((3 << 11) | 20) & 0xFu; }
#define XB_SPIN(cond, bar) do { unsigned _sp = 0; while (cond) { __builtin_amdgcn_s_sleep(1); \
    if ((++_sp & 255u) == 0u) { if (xb_ld(&(bar)[XB_TMO])) break; if (_sp > XB_SPIN_CAP) { atomicAdd(&(bar)[XB_TMO], 1u); break; } } } } while (0)
struct XcdBarrier { unsigned* bar; unsigned x; volatile LAS unsigned* st; };
__device__ __forceinline__ XcdBarrier xcd_barrier_post(unsigned* bar, volatile LAS unsigned* st) {
    XcdBarrier b; b.bar = bar; b.x = xb_xcc_id(); b.st = st;
    if (threadIdx.x == 0) st[2] = xb_add(&bar[XB_XCNT(b.x)], 1u);
    return b;
}
__device__ __forceinline__ void xcd_barrier_complete(unsigned* bar, unsigned x, unsigned& nloc, unsigned& nx, unsigned& rank) {
    const unsigned G = gridDim.x * gridDim.y * gridDim.z;
    unsigned sum, cnt, mine, sp = 0u;
    for (;;) {
        sum = 0u; cnt = 0u; mine = 0u;
#pragma unroll
        for (unsigned j = 0; j < 16; ++j) { const unsigned c = xb_ld(&bar[XB_XCNT(j)]); sum += c; cnt += (c > 0u) ? 1u : 0u; }
        mine = xb_ld(&bar[XB_XCNT(x)]);
        rank = 0u;
#pragma unroll
        for (unsigned j = 0; j < 16; ++j) rank += (j < x && xb_ld(&bar[XB_XCNT(j)]) > 0u) ? 1u : 0u;
        if (sum == G) break;
        __builtin_amdgcn_s_sleep(1);
        if ((++sp & 255u) == 0u) { if (xb_ld(&bar[XB_TMO])) break; if (sp > XB_SPIN_CAP) { atomicAdd(&bar[XB_TMO], 1u); break; } }
    }
    nloc = mine > 0u ? mine : 1u; nx = cnt > 0u ? cnt : 1u;
}
__device__ __forceinline__ void xcd_barrier(const XcdBarrier& b) {
    asm volatile("s_waitcnt vmcnt(0)" ::: "memory");
    __syncthreads();
    if (threadIdx.x == 0) {
        unsigned* bar = b.bar;
        __builtin_amdgcn_s_waitcnt(0);
        unsigned nloc = b.st[0], nx = b.st[1];
        if (nloc == 0u) { unsigned rk = 0u; xcd_barrier_complete(bar, b.x, nloc, nx, rk); b.st[0] = nloc; b.st[1] = nx; b.st[3] = rk; }
        const unsigned sh = b.st[2] & 3u, nshards = nloc < 4u ? nloc : 4u, ns = (nloc + 3u - sh) >> 2;
        const unsigned o1 = xb_add(&bar[XB_XSH(b.x, sh)], 1u);
        const unsigned gen = o1 / ns;
        bool leader = false;
        if (o1 + 1u == (gen + 1u) * ns) { const unsigned o2 = xb_add(&bar[XB_XSUB(b.x)], 1u); leader = (o2 + 1u == (o2 / nshards + 1u) * nshards); }
        if (leader) {
            __builtin_amdgcn_fence(__ATOMIC_RELEASE, "agent");
            asm volatile("s_waitcnt vmcnt(0)" ::: "memory");
            const unsigned og = xb_add(&bar[XB_TOP], 1u);
            const unsigned tg = og / nx;
            if (og + 1u == (tg + 1u) * nx) xb_add(&bar[XB_TOPGEN], 1u);
            else XB_SPIN(xb_ld(&bar[XB_TOPGEN]) == tg, bar);
            __builtin_amdgcn_fence(__ATOMIC_ACQUIRE, "agent");
            xb_add(&bar[XB_XGEN(b.x)], 1u);
            asm volatile("s_waitcnt vmcnt(0)" ::: "memory");
        } else {
            XB_SPIN(xb_ld(&bar[XB_XGEN(b.x)]) == gen, bar);
            __builtin_amdgcn_fence(__ATOMIC_ACQUIRE, "agent");
            asm volatile("s_waitcnt vmcnt(0)" ::: "memory");
        }
    }
    __syncthreads();
}

namespace cg = cooperative_groups;
#define PHASE_LOOP(n) for (int item = bid; item < (n); item += G)
#define XPHASE_LOOP(n, base) for (int item = (base) + (int)(((long)(n) * xrank) / xnum) + xslot, item_end = (base) + (int)(((long)(n) * (xrank + 1)) / xnum); item < item_end; item += xper)
__global__ void __launch_bounds__(256, 2) hybrid_megakernel(Params p_by_value) {
    CParams* kp = (CParams*)__builtin_amdgcn_kernarg_segment_ptr();
#define p (*launder(kp))
    __shared__ __attribute__((aligned(16))) char lds[LDS_BYTES + 16];
#define xb_words (*(uint4*)(lds + LDS_BYTES))
    if (threadIdx.x == 0) xb_words = make_uint4(0u, 0u, 0u, 0u);
    __syncthreads();
    XcdBarrier bar = xcd_barrier_post(p.bar, (volatile LAS unsigned*)&xb_words);
    const int G = gridDim.x, bid = blockIdx.x;
    int xper = G >> 3, xnum = 8, xslot = bid >> 3, xrank = bid & 7;
    constexpr int PH_PER_LAYER = 11, N_PHASES = 1 + DEPTH * PH_PER_LAYER + 1;
#pragma unroll 1
    for (int ph = 0; ph < N_PHASES; ++ph) {
        const int l = ph == 0 ? 0 : (ph - 1) / PH_PER_LAYER, sub = ph == 0 ? -1 : (ph == N_PHASES - 1 ? 99 : (ph - 1) % PH_PER_LAYER);
        switch (sub) {
        case -1:
            PHASE_LOOP(N_TABLE + 33 * (N_FOLD + N_ADA)) {
                if (item < N_TABLE) { stage_table(p, item); continue; }
                const int i = item - N_TABLE, q = i / 33, r = i % 33;
                if (r == 0) { if (q < N_FOLD) stage_fold(p, q, lds); else stage_ada(p, q - N_FOLD, lds); }
                else { const int cv = q * 32 + (r - 1); if (cv < N_CONVERT) stage_convert(p, cv, lds); }
            }
            break;
        case 0:
            if (l == 0) { PHASE_LOOP(N_ROWNORM) stage_rownorm<0>(p, l, item); } else { PHASE_LOOP(N_ROWNORM) stage_rownorm<1>(p, l, item); }
            break;
        case 1: XPHASE_LOOP(N_INPROJ, 0) stage_inproj(p, l, item, lds); break;
        case 2:
            PHASE_LOOP(N_FOURA + N_CONV + N_POOL + N_ACSUM) {
                if (item < N_FOURA) stage_fourA(p, item, lds);
                else if (item < N_FOURA + N_CONV) stage_conv(p, l, item - N_FOURA);
                else if (item < N_FOURA + N_CONV + N_POOL) stage_pool(p, item - N_FOURA - N_CONV);
                else stage_acsum(p, l, item - N_FOURA - N_CONV - N_POOL, lds);
            }
            break;
        case 3:
            PHASE_LOOP(N_CSTATE + N_FOURB) {
                if (item < N_CSTATE) stage_cstate(p, item, lds);
                else stage_fourB(p, item - N_CSTATE, lds);
            }
            break;
        case 4:
            PHASE_LOOP(N_SCAN) stage_scan(p, item);
            XPHASE_LOOP(N_G1024, 0) stage_gemm_small<1>(p, l, item, lds);
            break;
        case 5: PHASE_LOOP(l == DEPTH - 1 ? 512 : N_SSDOUT) stage_ssdout(p, l, item, lds); break;
        case 6: XPHASE_LOOP(l == DEPTH - 1 ? (TL / 128) * 8 : N_G1024, 0) stage_merge(p, l, item, lds); break;
        case 7: XPHASE_LOOP(l == DEPTH - 1 ? (TL / 128) * 8 : N_G1024, 0) stage_outproj(p, l, item, lds); break;
        case 8: PHASE_LOOP(l == DEPTH - 1 ? TL / 32 : N_ROUTER) stage_router(p, l, item, lds); break;
        case 9: { const int n1 = moe_total_mtiles(p, l) * 16; XPHASE_LOOP(n1, 0) stage_moe1(p, l, item, lds); } break;
        case 10: { const int n2 = moe_total_mtiles(p, l) * 8; XPHASE_LOOP(n2, 0) stage_moe2(p, l, item, lds); } break;
        default: PHASE_LOOP(TL / 4) stage_rownorm<2>(p, DEPTH - 1, item); break;
        }
        if (ph == 0) { cg::this_grid().sync(); xcd_barrier(bar); xper = (int)xb_words.x; xnum = (int)xb_words.y; xslot = (int)xb_words.z; xrank = (int)xb_words.w; }
        else if (ph != N_PHASES - 1) xcd_barrier(bar);
    }
#undef p
}

extern "C" void kernel_launch(void* const* d_in, const int* in_sizes, int n_in, void* d_out, int out_size, void* d_ws, size_t ws_size, hipStream_t stream) {
    Params p; memset(&p, 0, sizeof(p));
    const float** f = (const float**)&p;
    for (int i = 0; i < 26; ++i) f[i] = (const float*)d_in[i];
    p.out = (float*)d_out;
    char* w = (char*)d_ws; size_t off = 0;
    auto take = [&](size_t bytes) { char* r = w + off; off += (bytes + 255) & ~(size_t)255; return r; };
    p.bar = (unsigned*)take(32768); p.cnt = (int*)take(1024);
    p.mod = (float*)take((size_t)DEPTH * 3 * 6144 * 4);
    p.res = (float*)take((size_t)T * D * 4);
    p.dt = (float*)take((size_t)T * 32 * 4);
    p.ybuf = (float*)take((size_t)T * D * 4);
    p.ycraw = (float*)take((size_t)T * D * 4);
    p.topw = (float*)take((size_t)T * 4 * 4);
    p.topi = (int*)take((size_t)T * 4 * 4);
    p.list = (int*)take((size_t)DEPTH * NE * T * 4);
    p.h = (bf16_t*)take((size_t)T * D * 2);
    p.w_in_t = (bf16_t*)take((size_t)DEPTH * WIN_ROWS * D * 2);
    p.w_br_t = (bf16_t*)take((size_t)DEPTH * 3 * D * D * 2);
    p.w_out_t = (bf16_t*)take((size_t)DEPTH * D * D * 2);
    p.pool_w_t = (bf16_t*)take((size_t)DEPTH * 4 * 65536 * 2);
    p.w1_t = (bf16_t*)take((size_t)DEPTH * NE * 2048 * D * 2);
    p.w2_t = (bf16_t*)take((size_t)DEPTH * NE * D * D * 2);
    p.cs_t = (bf16_t*)take((size_t)256 * 512 * 2);
    p.tabA = (bf16_t*)take((size_t)128 * 128 * 64 * 2);
    p.tabB = (bf16_t*)take((size_t)256 * 256 * 2);
    p.tabC = (bf16_t*)take((size_t)2 * 256 * 256 * 2);
    p.Ap = (bf16_t*)take((size_t)NB * 64 * 256 * D * 2);
    p.Scs = (bf16_t*)take((size_t)NCH * 2 * NH * HD * NS * 2);
    p.Sst = (bf16_t*)take((size_t)NCH * 2 * NH * HD * NS * 2);
    p.ac = (float*)take((size_t)T * 32 * 4);
    p.ssq = (float*)take((size_t)T * 16 * 4);
    p.U = (bf16_t*)take((size_t)T * UC * 2);
    p.V = (bf16_t*)take((size_t)T * 2048 * 2);
    p.Dp = (bf16_t*)take((size_t)T * D * 2);
    p.ya = (bf16_t*)take((size_t)T * D * 2);
    p.Yb = (bf16_t*)take((size_t)T * 2048 * 2);
    p.yb = (bf16_t*)take((size_t)T * D * 2);
    p.yc = (bf16_t*)take((size_t)T * D * 2);
    p.m = (bf16_t*)take((size_t)T * D * 2);
    p.act = (bf16_t*)take((size_t)(T * 4 + 256) * D * 2);
    p.sout = (bf16_t*)take((size_t)T * 4 * D * 2);
    if (off > ws_size) { fprintf(stderr, "workspace too small: need %zu have %zu\n", off, ws_size); return; }
    static int grid_blocks = 0;
    if (!grid_blocks) {
        int dev = 0, cus = 0, per_cu = 0;
        (void)hipGetDevice(&dev);
        (void)hipDeviceGetAttribute(&cus, hipDeviceAttributeMultiprocessorCount, dev);
        (void)hipOccupancyMaxActiveBlocksPerMultiprocessor(&per_cu, hybrid_megakernel, 256, 0);
        if (per_cu > 2) per_cu = 2;
        if (per_cu < 1) per_cu = 1;
        grid_blocks = cus * per_cu;
    }
    (void)hipMemsetAsync(p.bar, 0, 32768 + 1024, stream);
    void* args[] = {&p};
    hipError_t e = hipLaunchCooperativeKernel((void*)hybrid_megakernel, dim3(grid_blocks), dim3(256), args, 0, stream);
    if (e != hipSuccess) fprintf(stderr, "cooperative launch failed: %s (grid %d)\n", hipGetErrorString(e), grid_blocks);
}
```

```cpp
#include <hip/hip_runtime.h>
#include <hip/hip_cooperative_groups.h>
#include <cstdio>
#include <cstdint>
#include <cstring>

typedef unsigned short bf16_t;
typedef short bf16x8 __attribute__((ext_vector_type(8)));
typedef float f32x4 __attribute__((ext_vector_type(4)));

constexpr int D = 1024, NB = 2, SEQ = 8192, TL = NB * SEQ, CTXL = 256, TC = NB * CTXL, T = TL + TC;
constexpr int DEPTH = 2, NE = 32, TOPK = 4, NH = 16, HD = 64, NS = 128;
constexpr int IN_COLS = 8224, UC = 8192;
constexpr int U_FOUR = 1024, U_Z = 2048, U_XBC = 3072, U_GATE = 5120;
constexpr int WIN_ROWS = 8320;
constexpr float RMS_EPS = 1e-6f;
constexpr int LDS_BYTES = 77824;

struct Params {
    const float *x, *c, *ctx, *c_ctx, *w_ada, *b_ada, *norm1_w, *norm2_w, *w_in, *pool_w, *pool_scale, *conv_w, *conv_b, *dt_bias, *a_log,
        *d_skip, *ssm_norm_w, *w_branch, *w_out, *router_w, *router_b, *moe_w1, *moe_b1, *moe_w2, *moe_b2, *final_norm_w;
    float* out;
    unsigned* bar; int* cnt;
    float *mod, *res, *dt, *ybuf, *ycraw, *topw, *ac, *ssq;
    bf16_t *h, *w_in_t, *w_br_t, *w_out_t, *pool_w_t, *w1_t, *w2_t, *cs_t, *U, *V, *Dp, *ya, *Yb, *yb, *yc, *m, *act, *sout, *tabA, *tabB, *tabC, *Ap, *Scs, *Sst;
    int *topi, *list;
};

typedef const __attribute__((address_space(4))) Params CParams;
typedef CParams& PRef;
__device__ __forceinline__ CParams* launder(CParams* kp) { asm volatile("" : "+s"(kp)); return kp; }
__device__ __forceinline__ int tidx() { int t = threadIdx.x; asm volatile("" : "+v"(t)); return t; }
__device__ __forceinline__ float bf2f(bf16_t u) { return __uint_as_float(((unsigned)u) << 16); }
typedef __bf16 bf16n2 __attribute__((ext_vector_type(2)));
typedef float f32x2n __attribute__((ext_vector_type(2)));
__device__ __forceinline__ bf16_t f2bf(float f) { return __builtin_bit_cast(bf16_t, (__bf16)f); }
__device__ __forceinline__ unsigned pack2(float a, float b) { return __builtin_bit_cast(unsigned, __builtin_convertvector((f32x2n){a, b}, bf16n2)); }
__device__ __forceinline__ float lo16(unsigned u) { return __uint_as_float(u << 16); }
__device__ __forceinline__ float hi16(unsigned u) { return __uint_as_float(u & 0xffff0000u); }
__device__ __forceinline__ float sigmoidf_(float x) { return __builtin_amdgcn_rcpf(1.0f + __expf(-x)); }
__device__ __forceinline__ float siluf_(float x) { return x * __builtin_amdgcn_rcpf(1.0f + __expf(-x)); }
__device__ __forceinline__ float softplusf_(float x) { return x > 20.f ? x : log1pf(__expf(x)); }
__device__ __forceinline__ int modrow(int row) { return row < TL ? (row / SEQ) : 2; }
__device__ __forceinline__ const float* modp(PRef p, int layer, int mrow, int j) { return p.mod + ((size_t)((layer * 3 + mrow) * 6 + j)) * D; }
__device__ __forceinline__ float wave_sum(float v) {
#pragma unroll
    for (int o = 32; o >= 1; o >>= 1) v += __shfl_xor(v, o);
    return v;
}

__device__ __forceinline__ int colmap(int mode, int j) {
    if (mode == 0) return j;
    if (mode == 1) { if (j < 5120) return j; if (j < 8192) return j + 32; if (j < 8224) return 5120 + (j - 8192); return -1; }
    const int Tn = j >> 7, wc = (j >> 6) & 1, jj = j & 63, fq = jj >> 4, n = (jj >> 2) & 3;
    return (n < 2 ? 0 : 1024) + Tn * 64 + wc * 32 + 8 * fq + 4 * (n & 1) + (jj & 3);
}
__device__ __forceinline__ void convert_tile(const float* __restrict__ src, int ld, bf16_t* __restrict__ dst, int K, int n0, int k0, int mode, char* lds, const float* kscale = nullptr) {
    float* tile = (float*)lds;
    const int tid = tidx();
    __syncthreads();
    { const int n4 = (tid & 15) * 4, kr = tid >> 4; const int sc = colmap(mode, n0 + n4);
      f32x4 v[8];
#pragma unroll
      for (int i = 0; i < 8; ++i) { const int kk = kr + 16 * i; v[i] = (f32x4){0.f, 0.f, 0.f, 0.f}; if (sc >= 0) v[i] = *(const f32x4*)(src + (size_t)(k0 + kk) * ld + sc); }
#pragma unroll
      for (int i = 0; i < 8; ++i) { const int kk = kr + 16 * i; if (kscale) v[i] *= kscale[k0 + kk];
          tile[kk * 65 + n4] = v[i][0]; tile[kk * 65 + n4 + 1] = v[i][1]; tile[kk * 65 + n4 + 2] = v[i][2]; tile[kk * 65 + n4 + 3] = v[i][3]; } }
    __syncthreads();
    { const int ko = (tid & 15) * 8, nr = tid >> 4;
#pragma unroll
      for (int i = 0; i < 4; ++i) { const int n = nr + 16 * i; float v[8];
#pragma unroll
          for (int j = 0; j < 8; ++j) v[j] = tile[(ko + j) * 65 + n];
          uint4 q; q.x = pack2(v[0], v[1]); q.y = pack2(v[2], v[3]); q.z = pack2(v[4], v[5]); q.w = pack2(v[6], v[7]);
          *(uint4*)(dst + (size_t)(n0 + n) * K + k0 + ko) = q; } }
}
constexpr int CV_WIN = (WIN_ROWS / 64) * 8, CV_BR = 3 * 128, CV_OUT = 128, CV_POOL = 4 * 8, CV_W1 = NE * 32 * 8, CV_W2 = NE * 128;
constexpr int CV_LAYER = CV_WIN + CV_BR + CV_OUT + CV_POOL + CV_W1 + CV_W2;
constexpr int N_CONVERT = DEPTH * CV_LAYER;
__device__ __forceinline__ void stage_convert(PRef p, int item, char* lds) {
    const int l = item / CV_LAYER; int w = item % CV_LAYER;
    if (w < CV_WIN) { convert_tile(p.w_in + (size_t)l * D * IN_COLS, IN_COLS, p.w_in_t + (size_t)l * WIN_ROWS * D, D, (w / 8) * 64, (w % 8) * 128, 1, lds); return; }
    w -= CV_WIN;
    if (w < CV_BR) { const int k = w / 128, t = w % 128; if (k == 0) return; convert_tile(p.w_branch + (size_t)(l * 3 + k) * D * D, D, p.w_br_t + (size_t)(l * 3 + k) * D * D, D, (t / 8) * 64, (t % 8) * 128, 0, lds, (k == 2) ? p.ssm_norm_w + l * D : nullptr); return; }
    w -= CV_BR;
    if (w < CV_OUT) { convert_tile(p.w_out + (size_t)l * D * D, D, p.w_out_t + (size_t)l * D * D, D, (w / 8) * 64, (w % 8) * 128, 0, lds); return; }
    w -= CV_OUT;
    if (w < CV_POOL) { return; const int g = w / 8, t = w % 8; convert_tile(p.pool_w + (size_t)(l * 4 + g) * 65536, 256, p.pool_w_t + (size_t)(l * 4 + g) * 65536, 256, (t / 2) * 64, (t % 2) * 128, 0, lds); return; }
    w -= CV_POOL;
    if (w < CV_W1) { const int e = w / 256, t = w % 256; convert_tile(p.moe_w1 + (size_t)(l * NE + e) * D * 2048, 2048, p.w1_t + (size_t)(l * NE + e) * 2048 * D, D, (t / 8) * 64, (t % 8) * 128, 2, lds); return; }
    w -= CV_W1;
    { const int e = w / 128, t = w % 128; convert_tile(p.moe_w2 + (size_t)(l * NE + e) * D * D, D, p.w2_t + (size_t)(l * NE + e) * D * D, D, (t / 8) * 64, (t % 8) * 128, 0, lds); }
}
constexpr int N_FOLD = DEPTH * 4 * 16 * 4;
__device__ __forceinline__ void stage_fold(PRef p, int item, char* lds) {
    float* P = (float*)lds;
    float* W = P + 64 * 64;
    const int tid = tidx(), l = item >> 8, g = (item >> 6) & 3, n0 = ((item >> 2) & 15) * 64, kl0 = (item & 3) * 64;
    const int n = tid & 63, kq = tid >> 6;
    float acc[16];
#pragma unroll
    for (int i = 0; i < 16; ++i) acc[i] = 0.f;
    const float* pw = p.pool_w + (size_t)(l * 4 + g) * 65536; const float* ps = p.pool_scale + l * D + g * 256; const float* wb = p.w_branch + (size_t)(l * 3) * D * D + (size_t)(g * 256) * D;
#pragma unroll 1
    for (int c0 = 0; c0 < 256; c0 += 64) {
        __syncthreads();
#pragma unroll
        for (int i = 0; i < 16; ++i) { const int id = tid + 256 * i, kl = id >> 6, c = id & 63; P[c * 64 + kl] = pw[(size_t)(kl0 + kl) * 256 + c0 + c] * ps[c0 + c]; }
#pragma unroll
        for (int i = 0; i < 16; ++i) { const int id = tid + 256 * i, c = id >> 6, nn = id & 63; W[c * 64 + nn] = wb[(size_t)(c0 + c) * D + n0 + nn]; }
        __syncthreads();
#pragma unroll 4
        for (int c = 0; c < 64; ++c) {
            const float w = W[c * 64 + n];
#pragma unroll
            for (int q = 0; q < 4; ++q) { const f32x4 pv = *(const f32x4*)(P + c * 64 + kq * 16 + q * 4); acc[q * 4] += pv[0] * w; acc[q * 4 + 1] += pv[1] * w; acc[q * 4 + 2] += pv[2] * w; acc[q * 4 + 3] += pv[3] * w; }
        }
    }
    bf16_t* o = p.w_br_t + (size_t)(l * 3) * D * D + (size_t)(n0 + n) * D + g * 256 + kl0 + kq * 16;
    uint4 q0, q1;
    q0.x = pack2(acc[0], acc[1]); q0.y = pack2(acc[2], acc[3]); q0.z = pack2(acc[4], acc[5]); q0.w = pack2(acc[6], acc[7]);
    q1.x = pack2(acc[8], acc[9]); q1.y = pack2(acc[10], acc[11]); q1.z = pack2(acc[12], acc[13]); q1.w = pack2(acc[14], acc[15]);
    ((uint4*)o)[0] = q0; ((uint4*)o)[1] = q1;
}
constexpr int N_TAB_CS = 512, N_TAB_A = 4096, N_TAB_B = 256, N_TAB_C = 512, N_TABLE = N_TAB_CS + N_TAB_A + N_TAB_B + N_TAB_C;
__device__ __forceinline__ void stage_table(PRef p, int item) {
    const float TWO_PI = 6.283185307179586f;
    if (item < N_TAB_CS) {
        const int idx = item * 256 + tidx(), m = idx >> 9, kk = idx & 511, ro = kk >> 8, c = kk & 255;
        const float ang = TWO_PI * (float)((m * c) & 255) * (1.0f / 256.0f);
        p.cs_t[idx] = f2bf((ro ? sinf(ang) : cosf(ang)) * 0.0625f); return;
    }
    item -= N_TAB_CS;
    if (item < N_TAB_A) {
        const int idx = item * 256 + tidx(), n2 = idx >> 13, rA = (idx >> 6) & 127, n1 = idx & 63, k1 = rA >> 1, ri = rA & 1;
        const float ang = TWO_PI * (float)((k1 * (128 * n1 + n2)) & 8191) * (1.0f / 8192.0f);
        p.tabA[idx] = f2bf((ri ? -sinf(ang) : cosf(ang)) * 0.011048543456039806f); return;
    }
    item -= N_TAB_A;
    if (item < N_TAB_B) {
        const int idx = item * 256 + tidx(), rB = idx >> 8, j = idx & 255, k2 = rB >> 1, ro = rB & 1, n2 = j >> 1, ri = j & 1;
        const float ang = TWO_PI * (float)((k2 * n2) & 127) * (1.0f / 128.0f);
        const float cs = cosf(ang), sn = sinf(ang);
        p.tabB[idx] = f2bf(ro == 0 ? (ri == 0 ? cs : sn) : (ri == 0 ? -sn : cs)); return;
    }
    item -= N_TAB_B;
    {
        const int idx = item * 256 + tidx(), half = idx >> 16, rC = (idx >> 8) & 255, n = idx & 255, k = half * 128 + (rC >> 1), ro = rC & 1;
        const float ang = TWO_PI * (float)((k * n) & 255) * (1.0f / 256.0f);
        p.tabC[idx] = f2bf((ro ? -sinf(ang) : cosf(ang)) * 0.0625f);
    }
}
constexpr int N_ADA = DEPTH * 6144 / 32;
__device__ __forceinline__ void stage_ada(PRef p, int item, char* lds) {
    float* sc = (float*)lds;
    float* part = sc + 3 * D;
    const int tid = tidx();
    __syncthreads();
    for (int i = tid; i < 3 * D; i += 256) { const int r = i / D, k = i % D; const float v = r < 2 ? p.c[r * D + k] : p.c_ctx[k]; sc[i] = siluf_(v); }
    __syncthreads();
    const int l = item / 192, cl = tid & 31, kg = tid >> 5, col = (item % 192) * 32 + cl;
    const float* w = p.w_ada + (size_t)l * D * 6144 + (size_t)(kg * 128) * 6144 + col;
    float a0 = 0.f, a1 = 0.f, a2 = 0.f;
#pragma unroll 16
    for (int k = 0; k < 128; ++k) { const float wv = w[(size_t)k * 6144]; a0 += sc[kg * 128 + k] * wv; a1 += sc[D + kg * 128 + k] * wv; a2 += sc[2 * D + kg * 128 + k] * wv; }
    part[(kg * 3 + 0) * 32 + cl] = a0; part[(kg * 3 + 1) * 32 + cl] = a1; part[(kg * 3 + 2) * 32 + cl] = a2;
    __syncthreads();
    if (tid < 96) { const int r = tid >> 5, c2 = tid & 31; float s = p.b_ada[l * 6144 + (item % 192) * 32 + c2];
#pragma unroll
        for (int g = 0; g < 8; ++g) s += part[(g * 3 + r) * 32 + c2];
        p.mod[(size_t)(l * 3 + r) * 6144 + (item % 192) * 32 + c2] = s; }
}

constexpr int N_ROWNORM = T / 4;
template <int MODE>
__device__ __forceinline__ void stage_rownorm(PRef p, int layer, int item) {
    const int wave = tidx() >> 6, lane = tidx() & 63, row = item * 4 + wave, mrow = modrow(row);
    const float* src = MODE == 0 ? (row < TL ? p.x + (size_t)row * D : p.ctx + (size_t)(row - TL) * D) : p.res + (size_t)row * D;
    f32x4 v[4];
#pragma unroll
    for (int j = 0; j < 4; ++j) v[j] = *(const f32x4*)(src + 4 * lane + 256 * j);
    if (MODE >= 1) {
        const int pl = MODE == 1 ? layer - 1 : layer;
        const float* g2 = modp(p, pl, mrow, 5);
#pragma unroll
        for (int j = 0; j < 4; ++j) {
            const int k = 4 * lane + 256 * j; f32x4 s = {0.f, 0.f, 0.f, 0.f};
#pragma unroll
            for (int kk = 0; kk < 4; ++kk) { const uint2 q = *(const uint2*)(p.sout + ((size_t)row * 4 + kk) * D + k); s[0] += lo16(q.x); s[1] += hi16(q.x); s[2] += lo16(q.y); s[3] += hi16(q.y); }
            const f32x4 g = *(const f32x4*)(g2 + k); v[j] += g * s;
        }
    }
    if (MODE != 2) {
#pragma unroll
        for (int j = 0; j < 4; ++j) *(f32x4*)(p.res + (size_t)row * D + 4 * lane + 256 * j) = v[j];
    }
    float ss = 0.f;
#pragma unroll
    for (int j = 0; j < 4; ++j) ss += v[j][0] * v[j][0] + v[j][1] * v[j][1] + v[j][2] * v[j][2] + v[j][3] * v[j][3];
    ss = wave_sum(ss);
    const float rinv = rsqrtf(ss * (1.0f / D) + RMS_EPS);
    if (MODE == 2) {
        if (row < TL) {
#pragma unroll
            for (int j = 0; j < 4; ++j) { const int k = 4 * lane + 256 * j; const f32x4 w = *(const f32x4*)(p.final_norm_w + k); *(f32x4*)(p.out + (size_t)row * D + k) = v[j] * rinv * w; }
        }
    } else {
        const float* nw = p.norm1_w + layer * D; const float* sh = modp(p, layer, mrow, 0); const float* sc = modp(p, layer, mrow, 1);
#pragma unroll
        for (int j = 0; j < 4; ++j) {
            const int k = 4 * lane + 256 * j;
            const f32x4 w = *(const f32x4*)(nw + k), a = *(const f32x4*)(sc + k), b = *(const f32x4*)(sh + k);
            const f32x4 hv = v[j] * rinv * w * (a + 1.0f) + b;
            uint2 q; q.x = pack2(hv[0], hv[1]); q.y = pack2(hv[2], hv[3]);
            *(uint2*)(p.h + (size_t)row * D + k) = q;
        }
    }
}

struct GemmSrc { const bf16_t* a[4]; const bf16_t* b[4]; };
__device__ __forceinline__ void gemm_stage(const GemmSrc& s, int kt, char* buf, int tid) {
#pragma unroll
    for (int i = 0; i < 4; ++i) {
        __builtin_amdgcn_global_load_lds((const unsigned*)(s.a[i] + kt), (unsigned*)(buf + i * 4096 + tid * 16), 16, 0, 0);
        __builtin_amdgcn_global_load_lds((const unsigned*)(s.b[i] + kt), (unsigned*)(buf + 16384 + i * 4096 + tid * 16), 16, 0, 0);
    }
}
__device__ __forceinline__ void gemm_kloop(f32x4 (&acc)[4][4], const GemmSrc& s, int K, char* lds) {
    const int tid = tidx(), wid = tid >> 6, lane = tid & 63, wr = wid >> 1, wc = wid & 1, fr = lane & 15, fq = lane >> 4;
    const int rsw = fr & 7;
    const int offA = (wr * 64 + fr) * 128, offB = 16384 + (wc * 64 + fr) * 128;
    const int c0 = ((0 + fq) ^ rsw) * 16, c1 = ((4 + fq) ^ rsw) * 16;
    asm volatile("s_waitcnt lgkmcnt(0)" ::: "memory");
    __builtin_amdgcn_s_barrier();
    asm volatile("" ::: "memory");
    gemm_stage(s, 0, lds, tid);
    asm volatile("s_waitcnt vmcnt(0)" ::: "memory");
    __syncthreads();
    int cur = 0;
    for (int kt = 0; kt < K; kt += 64) {
        char* buf = lds + cur * 32768;
        if (kt + 64 < K) gemm_stage(s, kt + 64, lds + (cur ^ 1) * 32768, tid);
#pragma unroll
        for (int ks = 0; ks < 2; ++ks) {
            const int cc = ks ? c1 : c0;
            bf16x8 af[4], bfr[4];
#pragma unroll
            for (int m = 0; m < 4; ++m) af[m] = *(const bf16x8*)(buf + offA + m * 2048 + cc);
#pragma unroll
            for (int n = 0; n < 4; ++n) bfr[n] = *(const bf16x8*)(buf + offB + n * 2048 + cc);
#pragma unroll
            for (int m = 0; m < 4; ++m)
#pragma unroll
                for (int n = 0; n < 4; ++n) acc[m][n] = __builtin_amdgcn_mfma_f32_16x16x32_bf16(bfr[n], af[m], acc[m][n], 0, 0, 0);
        }
        asm volatile("s_waitcnt vmcnt(0)" ::: "memory");
        __syncthreads();
        cur ^= 1;
    }
}
template <int MR> struct GemmSrcT { const bf16_t* a[MR / 2]; const bf16_t* b[2]; };
template <int MR>
__device__ __forceinline__ void gemm_stage_t(const GemmSrcT<MR>& s, int kt, char* buf, int tid) {
#pragma unroll
    for (int i = 0; i < MR / 2; ++i) __builtin_amdgcn_global_load_lds((const unsigned*)(s.a[i] + kt), (unsigned*)(buf + i * 4096 + tid * 16), 16, 0, 0);
#pragma unroll
    for (int i = 0; i < 2; ++i) __builtin_amdgcn_global_load_lds((const unsigned*)(s.b[i] + kt), (unsigned*)(buf + MR * 2048 + i * 4096 + tid * 16), 16, 0, 0);
}
template <int N> __device__ __forceinline__ void wait_vmcnt() { asm volatile("s_waitcnt vmcnt(%0)" :: "n"(N) : "memory"); }
template <int MR>
__device__ __forceinline__ void gemm_kloop_t(f32x4 (&acc)[MR][4], const GemmSrcT<MR>& s, int K, char* lds) {
    constexpr int NBUF = (MR == 8) ? 3 : 4, P = NBUF - 1, L = MR / 2 + 2, BUFB = MR * 2048 + 8192;
    const int tid = tidx(), wid = tid >> 6, lane = tid & 63, wr = wid >> 1, wc = wid & 1, fr = lane & 15, fq = lane >> 4;
    const int cc = (fq ^ ((-(fr >> 2)) & 3)) * 16;
    const int offA = (wr * (MR * 16) + fr) * 64 + cc, offB = MR * 2048 + (wc * 64 + fr) * 64 + cc;
    const int nk = K >> 5;
    asm volatile("s_waitcnt lgkmcnt(0)" ::: "memory");
    __builtin_amdgcn_s_barrier();
    asm volatile("" ::: "memory");
#pragma unroll
    for (int i = 0; i < P; ++i) if (i < nk) gemm_stage_t<MR>(s, i * 32, lds + i * BUFB, tid);
    int cur = 0, nxt = P;
#pragma unroll 1
    for (int k = 0; k < nk; ++k) {
        const int rem = nk - 1 - k;
        if (P >= 3 && rem >= 2) wait_vmcnt<2 * L>(); else if (rem >= 1) wait_vmcnt<L>(); else wait_vmcnt<0>();
        __builtin_amdgcn_s_barrier();
        asm volatile("" ::: "memory");
        const char* buf = lds + cur * BUFB;
        bf16x8 af[MR], bfr[4];
#pragma unroll
        for (int n = 0; n < 4; ++n) bfr[n] = *(const bf16x8*)(buf + offB + n * 1024);
#pragma unroll
        for (int m = 0; m < MR; ++m) af[m] = *(const bf16x8*)(buf + offA + m * 1024);
        __builtin_amdgcn_sched_barrier(0);
        if (k + P < nk) gemm_stage_t<MR>(s, (k + P) * 32, lds + nxt * BUFB, tid);
        __builtin_amdgcn_sched_barrier(0);
#pragma unroll
        for (int m = 0; m < MR; ++m)
#pragma unroll
            for (int n = 0; n < 4; ++n) acc[m][n] = __builtin_amdgcn_mfma_f32_16x16x32_bf16(bfr[n], af[m], acc[m][n], 0, 0, 0);
        cur = (cur + 1 == NBUF) ? 0 : cur + 1; nxt = (nxt + 1 == NBUF) ? 0 : nxt + 1;
    }
}
__device__ __forceinline__ void gemm_kloop2(f32x4 (&acc)[8][4], const GemmSrcT<8>& s, int K, char* lds) { gemm_kloop_t<8>(acc, s, K, lds); }
typedef GemmSrcT<8> GemmSrc2;
__device__ __forceinline__ void zero_acc2(f32x4 (&acc)[8][4]) {
#pragma unroll
    for (int m = 0; m < 8; ++m)
#pragma unroll
        for (int n = 0; n < 4; ++n) acc[m][n] = (f32x4){0.f, 0.f, 0.f, 0.f};
}
#define GEMM2_LANE_VARS const int tid = tidx(), wid = tid >> 6, lane = tid & 63, wr = wid >> 1, wc = wid & 1, fr = lane & 15, fq = lane >> 4; (void)wr; (void)wc; (void)fr; (void)fq; \
    const int br0 = tid >> 2, bc = ((tid & 3) ^ ((-(tid >> 4)) & 3)) * 8;
__device__ __forceinline__ int brow(int r) { return (r & ~63) | (((r >> 2) & 3) << 4) | (((r >> 4) & 3) << 2) | (r & 3); }
__device__ __forceinline__ void pack16(const f32x4 (&v)[4], uint4& q0, uint4& q1) {
    q0.x = pack2(v[0][0], v[0][1]); q0.y = pack2(v[0][2], v[0][3]); q0.z = pack2(v[1][0], v[1][1]); q0.w = pack2(v[1][2], v[1][3]);
    q1.x = pack2(v[2][0], v[2][1]); q1.y = pack2(v[2][2], v[2][3]); q1.z = pack2(v[3][0], v[3][1]); q1.w = pack2(v[3][2], v[3][3]); }
__device__ __forceinline__ void zero_acc(f32x4 (&acc)[4][4]) {
#pragma unroll
    for (int m = 0; m < 4; ++m)
#pragma unroll
        for (int n = 0; n < 4; ++n) acc[m][n] = (f32x4){0.f, 0.f, 0.f, 0.f};
}
#define GEMM_LANE_VARS const int tid = tidx(), wid = tid >> 6, lane = tid & 63, wr = wid >> 1, wc = wid & 1, fr = lane & 15, fq = lane >> 4; (void)wr; (void)wc; (void)fr; (void)fq; \
    const int ar0 = tid >> 3, ac = ((tid & 7) ^ (ar0 & 7)) * 8;

constexpr int NM_T = T / 128, NM2 = T / 256, N_INPROJ = ((NM2 + 7) / 8) * 8 * 65;
__device__ __forceinline__ void stage_inproj(PRef p, int layer, int item, char* lds) {
    GEMM2_LANE_VARS
    const int grp = item / (8 * 65), w = item % (8 * 65);
    int mt, nt;
    { const int gsz = (NM2 - grp * 8) < 8 ? (NM2 - grp * 8) : 8; mt = grp * 8 + (w % gsz); nt = w / gsz; }
    if (nt >= 65) return;
    const bf16_t* A = p.h + (size_t)(mt * 256) * D; const bf16_t* B = p.w_in_t + ((size_t)layer * WIN_ROWS + nt * 128) * D;
    f32x4 acc[8][4]; zero_acc2(acc);
    { GemmSrc2 s;
#pragma unroll
      for (int i = 0; i < 4; ++i) s.a[i] = A + (size_t)(br0 + 64 * i) * D + bc;
#pragma unroll
      for (int i = 0; i < 2; ++i) s.b[i] = B + (size_t)brow(br0 + 64 * i) * D + bc;
      gemm_kloop2(acc, s, D, lds); }
#pragma unroll
    for (int m = 0; m < 8; ++m) {
        const int row = mt * 256 + wr * 128 + m * 16 + fr;
        if (nt < 64) {
            const int gc = nt * 128 + wc * 64 + 16 * fq;
            f32x4 v[4];
#pragma unroll
            for (int n = 0; n < 4; ++n) { v[n] = acc[m][n]; if (gc >= U_GATE) { v[n][0] = sigmoidf_(v[n][0]); v[n][1] = sigmoidf_(v[n][1]); v[n][2] = sigmoidf_(v[n][2]); v[n][3] = sigmoidf_(v[n][3]); } }
            uint4 q0, q1; pack16(v, q0, q1);
            uint4* o = (uint4*)(p.U + (size_t)row * UC + gc); o[0] = q0; o[1] = q1;
        } else if (wc == 0 && fq < 2) {
#pragma unroll
            for (int n = 0; n < 4; ++n) {
                const int cl = 16 * fq + 4 * n; const f32x4 b = *(const f32x4*)(p.dt_bias + layer * 32 + cl); const f32x4 v = acc[m][n];
                f32x4 o; o[0] = softplusf_(v[0] + b[0]); o[1] = softplusf_(v[1] + b[1]); o[2] = softplusf_(v[2] + b[2]); o[3] = softplusf_(v[3] + b[3]);
                *(f32x4*)(p.dt + (size_t)row * 32 + cl) = o;
            }
        }
    }
}
constexpr int N_G1024 = NM_T * 8;
template <int MODE>
__device__ __forceinline__ void stage_gemm_small(PRef p, int layer, int item, char* lds) {
    GEMM_LANE_VARS
    const int mt = item >> 3, nt = item & 7, g = nt >> 1;
    const bf16_t *A, *B; int lda, ldb, K;
    if (MODE == 0) { A = p.Dp + (size_t)(mt * 128) * D + g * 256; lda = D; K = 256; ldb = 256; B = p.pool_w_t + (size_t)(layer * 4 + g) * 65536 + (size_t)((nt & 1) * 128) * 256; }
    else           { A = p.Yb + (size_t)(mt * 128) * 2048 + g * 512; lda = 2048; K = 512; ldb = 512; B = p.cs_t + (size_t)((nt & 1) * 128) * 512; }
    f32x4 acc[4][4]; zero_acc(acc);
    { GemmSrc s;
#pragma unroll
      for (int i = 0; i < 4; ++i) { s.a[i] = A + (size_t)(ar0 + 32 * i) * lda + ac; s.b[i] = B + (size_t)brow(ar0 + 32 * i) * ldb + ac; }
      gemm_kloop(acc, s, K, lds); }
    bf16_t* O = MODE == 0 ? p.ya : p.yb;
#pragma unroll
    for (int m = 0; m < 4; ++m) {
        const int row = mt * 128 + wr * 64 + m * 16 + fr, col = nt * 128 + wc * 64 + 16 * fq;
        f32x4 v[4];
#pragma unroll
        for (int n = 0; n < 4; ++n) { v[n] = acc[m][n]; if (MODE == 0) v[n] *= *(const f32x4*)(p.pool_scale + layer * D + col + 4 * n); }
        uint4 q0, q1; pack16(v, q0, q1);
        uint4* o = (uint4*)(O + (size_t)row * D + col); o[0] = q0; o[1] = q1;
    }
}
__device__ __forceinline__ void stage_merge(PRef p, int layer, int item, char* lds) {
    GEMM_LANE_VARS
    const int mt = item >> 3, nt = item & 7;
    f32x4 macc[4][4]; zero_acc(macc);
#pragma unroll 1
    for (int k = 0; k < 3; ++k) {
        const bf16_t* A = (k == 0 ? p.Dp : (k == 1 ? p.yb : p.yc)) + (size_t)(mt * 128) * D;
        const bf16_t* B = p.w_br_t + ((size_t)(layer * 3 + k) * D + nt * 128) * D;
        f32x4 acc[4][4]; zero_acc(acc);
        { GemmSrc s;
#pragma unroll
          for (int i = 0; i < 4; ++i) { s.a[i] = A + (size_t)(ar0 + 32 * i) * D + ac; s.b[i] = B + (size_t)brow(ar0 + 32 * i) * D + ac; }
          gemm_kloop(acc, s, D, lds); }
#pragma unroll
        for (int m = 0; m < 4; ++m) {
            const int row = mt * 128 + wr * 64 + m * 16 + fr, col = nt * 128 + wc * 64 + 16 * fq;
            float rs = 1.0f;
            if (k == 2) { const f32x4* sq = (const f32x4*)(p.ssq + (size_t)row * 16); const f32x4 t = sq[0] + sq[1] + sq[2] + sq[3]; rs = rsqrtf((t[0] + t[1] + t[2] + t[3]) * (1.0f / D) + RMS_EPS); }
            const uint4* gp = (const uint4*)(p.U + (size_t)row * UC + U_GATE + k * D + col);
            const uint4 g0 = gp[0], g1 = gp[1];
            const unsigned gw[8] = {g0.x, g0.y, g0.z, g0.w, g1.x, g1.y, g1.z, g1.w};
#pragma unroll
            for (int n = 0; n < 4; ++n) {
                macc[m][n][0] += lo16(gw[2 * n]) * rs * acc[m][n][0]; macc[m][n][1] += hi16(gw[2 * n]) * rs * acc[m][n][1];
                macc[m][n][2] += lo16(gw[2 * n + 1]) * rs * acc[m][n][2]; macc[m][n][3] += hi16(gw[2 * n + 1]) * rs * acc[m][n][3];
            }
        }
    }
#pragma unroll
    for (int m = 0; m < 4; ++m) {
        const int row = mt * 128 + wr * 64 + m * 16 + fr, col = nt * 128 + wc * 64 + 16 * fq;
        uint4 q0, q1; pack16(macc[m], q0, q1);
        uint4* o = (uint4*)(p.m + (size_t)row * D + col); o[0] = q0; o[1] = q1;
    }
}
__device__ __forceinline__ void stage_outproj(PRef p, int layer, int item, char* lds) {
    GEMM_LANE_VARS
    const int mt = item >> 3, nt = item & 7;
    const bf16_t* A = p.m + (size_t)(mt * 128) * D; const bf16_t* B = p.w_out_t + ((size_t)layer * D + nt * 128) * D;
    f32x4 acc[4][4]; zero_acc(acc);
    { GemmSrc s;
#pragma unroll
      for (int i = 0; i < 4; ++i) { s.a[i] = A + (size_t)(ar0 + 32 * i) * D + ac; s.b[i] = B + (size_t)brow(ar0 + 32 * i) * D + ac; }
      gemm_kloop(acc, s, D, lds); }
#pragma unroll
    for (int m = 0; m < 4; ++m) {
        const int row = mt * 128 + wr * 64 + m * 16 + fr, col = nt * 128 + wc * 64 + 16 * fq; const float* g1 = modp(p, layer, modrow(row), 2) + col;
        float* r = p.res + (size_t)row * D + col;
#pragma unroll
        for (int n = 0; n < 4; ++n) { const f32x4 g = *(const f32x4*)(g1 + 4 * n); *(f32x4*)(r + 4 * n) = *(const f32x4*)(r + 4 * n) + g * acc[m][n]; }
    }
}
__device__ __forceinline__ int ld_cnt(PRef p, int i) { return __hip_atomic_load(p.cnt + i, __ATOMIC_RELAXED, __HIP_MEMORY_SCOPE_AGENT); }
struct MoeTile { int e, mt, nt, cnt, off; };
template <int NT>
__device__ __forceinline__ bool moe_decode(PRef p, int layer, int item, MoeTile& t) {
    const int mg = item / NT; t.nt = item % NT;
    int accm = 0, off = 0;
    for (int e = 0; e < NE; ++e) {
        const int c = ld_cnt(p, layer * NE + e), mtn = (c + 255) >> 8;
        if (mg < accm + mtn) { t.e = e; t.mt = mg - accm; t.cnt = c; t.off = off; return true; }
        accm += mtn; off += c;
    }
    return false;
}
__device__ __forceinline__ int moe_total_mtiles(PRef p, int layer) { int s = 0; for (int e = 0; e < NE; ++e) s += (ld_cnt(p, layer * NE + e) + 255) >> 8; return s; }
__device__ __forceinline__ void stage_moe1(PRef p, int layer, int item, char* lds) {
    GEMM2_LANE_VARS
    MoeTile t; if (!moe_decode<16>(p, layer, item, t)) return;
    const int* lst = p.list + (size_t)(layer * NE + t.e) * T;
    const bf16_t* B = p.w1_t + ((size_t)(layer * NE + t.e) * 2048 + t.nt * 128) * D;
    f32x4 acc[8][4]; zero_acc2(acc);
    { GemmSrc2 s;
#pragma unroll
      for (int i = 0; i < 4; ++i) { const int ii = t.mt * 256 + br0 + 64 * i; const int tok = lst[ii < t.cnt ? ii : t.cnt - 1] >> 2; s.a[i] = p.h + (size_t)tok * D + bc; }
#pragma unroll
      for (int i = 0; i < 2; ++i) s.b[i] = B + (size_t)brow(br0 + 64 * i) * D + bc;
      gemm_kloop2(acc, s, D, lds); }
    const float* b1 = p.moe_b1 + (size_t)(layer * NE + t.e) * 2048;
#pragma unroll
    for (int m = 0; m < 8; ++m) {
        const int i = t.mt * 256 + wr * 128 + m * 16 + fr;
        if (i < t.cnt) {
            const int gc = t.nt * 64 + wc * 32 + 8 * fq;
            float o[8];
#pragma unroll
            for (int n = 0; n < 2; ++n) {
                const f32x4 bg = *(const f32x4*)(b1 + gc + 4 * n), bl = *(const f32x4*)(b1 + 1024 + gc + 4 * n);
#pragma unroll
                for (int j = 0; j < 4; ++j) {
                    const float g = fminf(acc[m][n][j] + bg[j], 7.0f), l = fminf(fmaxf(acc[m][n + 2][j] + bl[j], -7.0f), 7.0f);
                    o[4 * n + j] = g * sigmoidf_(1.702f * g) * (l + 1.0f);
                }
            }
            uint4 q; q.x = pack2(o[0], o[1]); q.y = pack2(o[2], o[3]); q.z = pack2(o[4], o[5]); q.w = pack2(o[6], o[7]);
            *(uint4*)(p.act + (size_t)(t.off + i) * D + gc) = q;
        }
    }
}
__device__ __forceinline__ void stage_moe2(PRef p, int layer, int item, char* lds) {
    GEMM2_LANE_VARS
    MoeTile t; if (!moe_decode<8>(p, layer, item, t)) return;
    const int* lst = p.list + (size_t)(layer * NE + t.e) * T;
    const bf16_t* B = p.w2_t + ((size_t)(layer * NE + t.e) * D + t.nt * 128) * D;
    f32x4 acc[8][4]; zero_acc2(acc);
    { GemmSrc2 s;
#pragma unroll
      for (int i = 0; i < 4; ++i) { const int ii = t.mt * 256 + br0 + 64 * i; s.a[i] = p.act + (size_t)(t.off + (ii < t.cnt ? ii : t.cnt - 1)) * D + bc; }
#pragma unroll
      for (int i = 0; i < 2; ++i) s.b[i] = B + (size_t)brow(br0 + 64 * i) * D + bc;
      gemm_kloop2(acc, s, D, lds); }
    const float* b2 = p.moe_b2 + (size_t)(layer * NE + t.e) * D;
#pragma unroll
    for (int m = 0; m < 8; ++m) {
        const int i = t.mt * 256 + wr * 128 + m * 16 + fr;
        if (i < t.cnt) {
            const int pair = lst[i]; const float w = p.topw[pair]; const int col = t.nt * 128 + wc * 64 + 16 * fq;
            f32x4 v[4];
#pragma unroll
            for (int n = 0; n < 4; ++n) v[n] = (acc[m][n] + *(const f32x4*)(b2 + col + 4 * n)) * w;
            uint4 q0, q1; pack16(v, q0, q1);
            uint4* o = (uint4*)(p.sout + (size_t)pair * D + col); o[0] = q0; o[1] = q1;
        }
    }
}

constexpr int N_CONV = T / 32;
__device__ __forceinline__ void stage_conv(PRef p, int layer, int item) {
    const int c0 = tidx() * 8, r0 = item * 32;
    const int seq0 = r0 < TL ? (r0 / SEQ) * SEQ : TL + ((r0 - TL) / CTXL) * CTXL, seq1 = seq0 + (r0 < TL ? SEQ : CTXL);
    float w[5][8], bias[8];
#pragma unroll
    for (int j = 0; j < 5; ++j) { const f32x4 a = *(const f32x4*)(p.conv_w + (size_t)(layer * 5 + j) * 2048 + c0), b = *(const f32x4*)(p.conv_w + (size_t)(layer * 5 + j) * 2048 + c0 + 4);
        w[j][0] = a[0]; w[j][1] = a[1]; w[j][2] = a[2]; w[j][3] = a[3]; w[j][4] = b[0]; w[j][5] = b[1]; w[j][6] = b[2]; w[j][7] = b[3]; }
    { const f32x4 a = *(const f32x4*)(p.conv_b + layer * 2048 + c0), b = *(const f32x4*)(p.conv_b + layer * 2048 + c0 + 4);
      bias[0] = a[0]; bias[1] = a[1]; bias[2] = a[2]; bias[3] = a[3]; bias[4] = b[0]; bias[5] = b[1]; bias[6] = b[2]; bias[7] = b[3]; }
    float win[5][8];
    auto ldrow = [&](int r, float (&o)[8]) {
        if (r >= seq0 && r < seq1) { const uint4 q = *(const uint4*)(p.U + (size_t)r * UC + U_XBC + c0);
            o[0] = lo16(q.x); o[1] = hi16(q.x); o[2] = lo16(q.y); o[3] = hi16(q.y); o[4] = lo16(q.z); o[5] = hi16(q.z); o[6] = lo16(q.w); o[7] = hi16(q.w); }
        else {
#pragma unroll
            for (int i = 0; i < 8; ++i) o[i] = 0.f; }
    };
    ldrow(r0 - 2, win[0]); ldrow(r0 - 1, win[1]); ldrow(r0, win[2]); ldrow(r0 + 1, win[3]);
#pragma unroll 8
    for (int r = r0; r < r0 + 32; ++r) {
        ldrow(r + 2, win[4]);
        float o[8];
#pragma unroll
        for (int i = 0; i < 8; ++i) { float s = bias[i];
#pragma unroll
            for (int j = 0; j < 5; ++j) s += w[j][i] * win[j][i];
            o[i] = siluf_(s); }
        uint4 q; q.x = pack2(o[0], o[1]); q.y = pack2(o[2], o[3]); q.z = pack2(o[4], o[5]); q.w = pack2(o[6], o[7]);
        *(uint4*)(p.V + (size_t)r * 2048 + c0) = q;
#pragma unroll
        for (int j = 0; j < 4; ++j)
#pragma unroll
            for (int i = 0; i < 8; ++i) win[j][i] = win[j + 1][i];
    }
}

constexpr int N_POOL_LAT = NB * 4 * 4 * 16, N_POOL = N_POOL_LAT + NB * 4 * 64;
__device__ __forceinline__ void pool_acc(const uint2 q, float w, float (&v)[4]) { v[0] += w * lo16(q.x); v[1] += w * hi16(q.x); v[2] += w * lo16(q.y); v[3] += w * hi16(q.y); }
template <int W>
__device__ __forceinline__ void pool_lat(PRef p, int g, int b, int band, int c, int lane) {
    constexpr int lo = -(W >> 1), hi = W - (W >> 1) - 1;
    const int r0 = band * 32, cc0 = max(c + lo, 0), cc1 = min(c + hi, 63), ncol = cc1 - cc0 + 1;
    const bf16_t* base = p.U + (size_t)(b * SEQ) * UC + g * 256 + lane * 4;
    float vs[4] = {0.f, 0.f, 0.f, 0.f};
    auto addH = [&](int rr, float sg) {
        const bool rv = rr >= 0 && rr <= 127; const int rc = min(max(rr, 0), 127);
        uint2 q[W];
#pragma unroll
        for (int i = 0; i < W; ++i) { const int cc = min(cc0 + i, 63); q[i] = *(const uint2*)(base + (size_t)(rc * 64 + cc) * UC); }
#pragma unroll
        for (int i = 0; i < W; ++i) pool_acc(q[i], (rv && i < ncol) ? sg : 0.f, vs);
    };
#pragma unroll 1
    for (int rr = r0 + lo; rr <= r0 + hi; ++rr) addH(rr, 1.0f);
#pragma unroll 1
    for (int r = r0; r < r0 + 32; ++r) {
        const int rlo = max(r + lo, 0), rhi = min(r + hi, 127);
        const float inv = 1.0f / (float)((rhi - rlo + 1) * ncol);
        const uint2 sq = *(const uint2*)(base + (size_t)(r * 64 + c) * UC);
        uint2 q; q.x = pack2(vs[0] * inv - lo16(sq.x), vs[1] * inv - hi16(sq.x)); q.y = pack2(vs[2] * inv - lo16(sq.y), vs[3] * inv - hi16(sq.y));
        *(uint2*)(p.Dp + (size_t)(b * SEQ + r * 64 + c) * D + g * 256 + lane * 4) = q;
        {
            const int ra = r + lo, rb = r + 1 + hi;
            const bool va = ra >= 0, vb = rb <= 127; const int rac = max(ra, 0), rbc = min(rb, 127);
            uint2 qa[W], qb[W];
#pragma unroll
            for (int i = 0; i < W; ++i) { const int cc = min(cc0 + i, 63); qa[i] = *(const uint2*)(base + (size_t)(rac * 64 + cc) * UC); qb[i] = *(const uint2*)(base + (size_t)(rbc * 64 + cc) * UC); }
#pragma unroll
            for (int i = 0; i < W; ++i) { pool_acc(qa[i], (va && i < ncol) ? -1.0f : 0.f, vs); pool_acc(qb[i], (vb && i < ncol) ? 1.0f : 0.f, vs); }
        }
    }
}
__device__ __forceinline__ void stage_pool(PRef p, int item) {
    const int tid = tidx(), wave = tid >> 6, lane = tid & 63;
    if (item < N_POOL_LAT) {
        const int g = 3 - (item >> 7), b = (item >> 6) & 1, band = (item >> 4) & 3, c = (item & 15) * 4 + wave;
        if (g == 3) pool_lat<16>(p, g, b, band, c, lane);
        else if (g == 2) pool_lat<8>(p, g, b, band, c, lane);
        else if (g == 1) pool_lat<4>(p, g, b, band, c, lane);
        else pool_lat<2>(p, g, b, band, c, lane);
    } else {
        const int it = item - N_POOL_LAT, g = 3 - (it >> 7), b = (it >> 6) & 1, n = (it & 63) * 4 + wave;
        const int w = 2 << g, lo = -(w >> 1), hi = w - (w >> 1) - 1, t0 = max(n + lo, 0), t1 = min(n + hi, CTXL - 1);
        const bf16_t* base = p.U + (size_t)(TL + b * CTXL) * UC + g * 256 + lane * 4;
        float s[4] = {0.f, 0.f, 0.f, 0.f};
        uint2 q[16];
#pragma unroll
        for (int i = 0; i < 16; ++i) q[i] = *(const uint2*)(base + (size_t)min(t0 + i, CTXL - 1) * UC);
#pragma unroll
        for (int i = 0; i < 16; ++i) pool_acc(q[i], (t0 + i <= t1) ? 1.0f : 0.f, s);
        const float inv = 1.0f / (float)(t1 - t0 + 1);
        const uint2 sq = *(const uint2*)(base + (size_t)n * UC);
        uint2 o; o.x = pack2(s[0] * inv - lo16(sq.x), s[1] * inv - hi16(sq.x)); o.y = pack2(s[2] * inv - lo16(sq.y), s[3] * inv - hi16(sq.y));
        *(uint2*)(p.Dp + (size_t)(TL + b * CTXL + n) * D + g * 256 + lane * 4) = o;
    }
}

typedef unsigned u32x2 __attribute__((ext_vector_type(2)));
union Frag8 { bf16x8 v; u32x2 h[2]; };
template <int OFF>
__device__ __forceinline__ void tr_frag4(bf16x8 (&f)[4], unsigned a0, unsigned a1, unsigned a2, unsigned a3) {
    Frag8 r0, r1, r2, r3;
    asm volatile("ds_read_b64_tr_b16 %0, %8\n\tds_read_b64_tr_b16 %1, %8 offset:%c12\n\t"
                 "ds_read_b64_tr_b16 %2, %9\n\tds_read_b64_tr_b16 %3, %9 offset:%c12\n\t"
                 "ds_read_b64_tr_b16 %4, %10\n\tds_read_b64_tr_b16 %5, %10 offset:%c12\n\t"
                 "ds_read_b64_tr_b16 %6, %11\n\tds_read_b64_tr_b16 %7, %11 offset:%c12\n\t"
                 "s_waitcnt lgkmcnt(0)"
                 : "=&v"(r0.h[0]), "=&v"(r0.h[1]), "=&v"(r1.h[0]), "=&v"(r1.h[1]), "=&v"(r2.h[0]), "=&v"(r2.h[1]), "=&v"(r3.h[0]), "=&v"(r3.h[1])
                 : "v"(a0), "v"(a1), "v"(a2), "v"(a3), "i"(OFF) : "memory");
    f[0] = r0.v; f[1] = r1.v; f[2] = r2.v; f[3] = r3.v;
}
__device__ __forceinline__ unsigned lds_addr(const void* p) { return (unsigned)(size_t)p; }
constexpr int PBA = 544, N_FOURA = NB * 128 * 4;
__device__ __forceinline__ void stage_fourA(PRef p, int item, char* lds) {
    const int tid = tidx(), wid = tid >> 6, lane = tid & 63, fr = lane & 15, fq = lane >> 4;
    const int b = item >> 9, n2 = (item >> 2) & 127, c0 = (item & 3) * 256;
    const bf16_t* tA = p.tabA + ((size_t)n2 * 128 + fr) * 64 + fq * 8;
    bf16x8 tf[2][8];
#pragma unroll
    for (int rt = 0; rt < 8; ++rt) tf[0][rt] = *(const bf16x8*)(tA + rt * 16 * 64);
    __syncthreads();
#pragma unroll
    for (int i = 0; i < 8; ++i) {
        const int id = tid + 256 * i, r = id >> 5, o = id & 31;
        const uint4 q = *(const uint4*)(p.U + (size_t)(b * SEQ + 128 * r + n2) * UC + U_FOUR + c0 + o * 8);
        *(uint4*)(lds + r * PBA + o * 16) = q;
    }
    __syncthreads();
    f32x4 acc[4][8];
#pragma unroll
    for (int a = 0; a < 4; ++a)
#pragma unroll
        for (int r = 0; r < 8; ++r) acc[a][r] = (f32x4){0.f, 0.f, 0.f, 0.f};
    const unsigned base = lds_addr(lds) + (unsigned)((8 * fq + (fr >> 2)) * PBA + (wid * 64 + 4 * (fr & 3)) * 2);
#pragma unroll
    for (int ks = 0; ks < 2; ++ks) {
        bf16x8 xf[4];
        if (ks == 0) {
#pragma unroll
            for (int rt = 0; rt < 8; ++rt) tf[1][rt] = *(const bf16x8*)(tA + rt * 16 * 64 + 32);
        }
        const unsigned a = base + ks * 32 * PBA;
        tr_frag4<4 * PBA>(xf, a, a + 32, a + 64, a + 96);
#pragma unroll
        for (int ct = 0; ct < 4; ++ct)
#pragma unroll
            for (int rt = 0; rt < 8; ++rt) acc[ct][rt] = __builtin_amdgcn_mfma_f32_16x16x32_bf16(xf[ct], tf[ks][rt], acc[ct][rt], 0, 0, 0);
    }
#pragma unroll
    for (int rt = 0; rt < 8; ++rt) {
        const int rA = rt * 16 + fr, k1 = rA >> 1, ri = rA & 1;
        bf16_t* o = p.Ap + ((size_t)(b * 64 + k1) * 256 + n2 * 2 + ri) * D + c0 + wid * 64 + 4 * fq;
#pragma unroll
        for (int ct = 0; ct < 4; ++ct) { uint2 q; q.x = pack2(acc[ct][rt][0], acc[ct][rt][1]); q.y = pack2(acc[ct][rt][2], acc[ct][rt][3]); *(uint2*)(o + ct * 16) = q; }
    }
}
constexpr int PBB = 288, N_FOURB_LAT = NB * 64 * 8, N_FOURB = N_FOURB_LAT + NB * 2 * 8;
__device__ __forceinline__ void stage_fourB(PRef p, int item, char* lds) {
    const int tid = tidx(), wid = tid >> 6, lane = tid & 63, fr = lane & 15, fq = lane >> 4;
    const bf16_t* xsrc; size_t xpitch; const bf16_t* tab; int orow0, orstep, c0;
    if (item < N_FOURB_LAT) { const int b = item >> 9, k1 = (item >> 3) & 63; c0 = (item & 7) * 128;
        xsrc = p.Ap + (size_t)(b * 64 + k1) * 256 * D + c0; xpitch = D; tab = p.tabB; orow0 = b * SEQ + k1; orstep = 64; }
    else { const int it = item - N_FOURB_LAT, b = it >> 4, half = (it >> 3) & 1; c0 = (it & 7) * 128;
        xsrc = p.U + (size_t)(TL + b * CTXL) * UC + U_FOUR + c0; xpitch = UC; tab = p.tabC + half * 65536; orow0 = TL + b * CTXL + half * 128; orstep = 1; }
    f32x4 acc[8][4];
#pragma unroll
    for (int a = 0; a < 8; ++a)
#pragma unroll
        for (int r = 0; r < 4; ++r) acc[a][r] = (f32x4){0.f, 0.f, 0.f, 0.f};
    const unsigned base = lds_addr(lds) + (unsigned)((8 * fq + (fr >> 2)) * PBB + (4 * (fr & 3)) * 2);
    const bf16_t* tB = tab + (size_t)(wid * 64 + fr) * 256 + fq * 8;
#pragma unroll 1
    for (int kh = 0; kh < 2; ++kh) {
        bf16x8 tf0[4];
#pragma unroll
        for (int rt = 0; rt < 4; ++rt) tf0[rt] = *(const bf16x8*)(tB + rt * 16 * 256 + kh * 128);
        __syncthreads();
#pragma unroll
        for (int i = 0; i < 8; ++i) {
            const int id = tid + 256 * i, r = id >> 4, o = id & 15;
            const uint4 q = *(const uint4*)(xsrc + (size_t)(kh * 128 + r) * xpitch + o * 8);
            *(uint4*)(lds + r * PBB + o * 16) = q;
        }
        __syncthreads();
#pragma unroll
        for (int ks = 0; ks < 4; ++ks) {
            bf16x8 xf[8], tf[4];
#pragma unroll
            for (int rt = 0; rt < 4; ++rt) tf[rt] = tf0[rt];
            if (ks < 3) {
#pragma unroll
                for (int rt = 0; rt < 4; ++rt) tf0[rt] = *(const bf16x8*)(tB + rt * 16 * 256 + kh * 128 + (ks + 1) * 32);
            }
            const unsigned a = base + ks * 32 * PBB;
            { bf16x8 t4[4]; tr_frag4<4 * PBB>(t4, a, a + 32, a + 64, a + 96); xf[0] = t4[0]; xf[1] = t4[1]; xf[2] = t4[2]; xf[3] = t4[3]; }
            { bf16x8 t4[4]; tr_frag4<4 * PBB>(t4, a + 128, a + 160, a + 192, a + 224); xf[4] = t4[0]; xf[5] = t4[1]; xf[6] = t4[2]; xf[7] = t4[3]; }
#pragma unroll
            for (int ct = 0; ct < 8; ++ct)
#pragma unroll
                for (int rt = 0; rt < 4; ++rt) acc[ct][rt] = __builtin_amdgcn_mfma_f32_16x16x32_bf16(xf[ct], tf[rt], acc[ct][rt], 0, 0, 0);
        }
    }
    const int g = c0 >> 8, cg = c0 & 255;
#pragma unroll
    for (int rt = 0; rt < 4; ++rt) {
        const int rB = wid * 64 + rt * 16 + fr, kk = rB >> 1, ro = rB & 1;
        bf16_t* o = p.Yb + (size_t)(orow0 + kk * orstep) * 2048 + g * 512 + ro * 256 + cg + 4 * fq;
#pragma unroll
        for (int ct = 0; ct < 8; ++ct) { uint2 q; q.x = pack2(acc[ct][rt][0], acc[ct][rt][1]); q.y = pack2(acc[ct][rt][2], acc[ct][rt][3]); *(uint2*)(o + ct * 16) = q; }
    }
}

constexpr int NCH = T / 128, N_ACSUM = NCH;
__device__ __forceinline__ void stage_acsum(PRef p, int layer, int item, char* lds) {
    const int tid = tidx(), col = tid & 31, seg = tid >> 5, d = col >> 4, h = col & 15;
    float* part = (float*)lds;
    const float A = -__expf(p.a_log[(layer * 2 + d) * NH + h]);
    float v[16];
#pragma unroll
    for (int i = 0; i < 16; ++i) { const int pos = seg * 16 + i, r = item * 128 + (d == 0 ? pos : 127 - pos); v[i] = p.dt[(size_t)r * 32 + col] * A; }
    float s = 0.f;
#pragma unroll
    for (int i = 0; i < 16; ++i) { s += v[i]; v[i] = s; }
    __syncthreads();
    part[seg * 32 + col] = s;
    __syncthreads();
    float base = 0.f;
#pragma unroll
    for (int j = 0; j < 8; ++j) base += (j < seg) ? part[j * 32 + col] : 0.f;
#pragma unroll
    for (int i = 0; i < 16; ++i) { const int pos = seg * 16 + i, r = item * 128 + (d == 0 ? pos : 127 - pos); p.ac[(size_t)r * 32 + col] = base + v[i]; }
}
template <int OFF>
__device__ __forceinline__ void tr_frag4b(bf16x8 (&f)[4], unsigned a, int step) { tr_frag4<OFF>(f, a, a + step, a + 2 * step, a + 3 * step); }
constexpr int PBS = 288, PXS = 160, N_CSTATE = NCH * NH;
__device__ __forceinline__ void stage_cstate(PRef p, int item, char* lds) {
    const int tid = tidx(), wid = tid >> 6, lane = tid & 63, fr = lane & 15, fq = lane >> 4;
    const int cid = item >> 4, hh = item & 15, g = hh >> 2, row0 = cid * 128;
    char* LB = lds; char* LX = lds + 128 * PBS; float* wgt = (float*)(lds + 128 * PBS + 128 * PXS);
    __syncthreads();
#pragma unroll
    for (int i = 0; i < 8; ++i) { const int id = tid + 256 * i, r = id >> 4, o = id & 15;
        *(uint4*)(LB + r * PBS + o * 16) = *(const uint4*)(p.V + (size_t)(row0 + r) * 2048 + 1024 + g * NS + o * 8); }
#pragma unroll
    for (int i = 0; i < 4; ++i) { const int id = tid + 256 * i, r = id >> 3, o = id & 7;
        *(uint4*)(LX + r * PXS + o * 16) = *(const uint4*)(p.V + (size_t)(row0 + r) * 2048 + hh * HD + o * 8); }
    { const int d = tid >> 7, l = tid & 127; const int col = d * 16 + hh;
      const float tot = p.ac[(size_t)(row0 + (d == 0 ? 127 : 0)) * 32 + col];
      wgt[tid] = p.dt[(size_t)(row0 + l) * 32 + col] * __expf(tot - p.ac[(size_t)(row0 + l) * 32 + col]); }
    __syncthreads();
    const int d = wid >> 1, nh = wid & 1;
    f32x4 acc[4][4];
#pragma unroll
    for (int a = 0; a < 4; ++a)
#pragma unroll
        for (int b = 0; b < 4; ++b) acc[a][b] = (f32x4){0.f, 0.f, 0.f, 0.f};
    const unsigned rowoff = 8 * fq + (fr >> 2), coloff = 4 * (fr & 3);
    const unsigned baseB = lds_addr(LB) + rowoff * PBS + (nh * 64 + coloff) * 2, baseX = lds_addr(LX) + rowoff * PXS + coloff * 2;
#pragma unroll
    for (int ks = 0; ks < 4; ++ks) {
        bf16x8 bt[4], xr[4], xs[4];
        tr_frag4b<4 * PBS>(bt, baseB + ks * 32 * PBS, 32);
        tr_frag4b<4 * PXS>(xr, baseX + ks * 32 * PXS, 32);
        const f32x4 w0 = *(const f32x4*)(wgt + d * 128 + ks * 32 + 8 * fq), w1 = *(const f32x4*)(wgt + d * 128 + ks * 32 + 8 * fq + 4);
#pragma unroll
        for (int pt = 0; pt < 4; ++pt)
#pragma unroll
            for (int e = 0; e < 8; ++e) xs[pt][e] = (short)f2bf(bf2f((bf16_t)xr[pt][e]) * (e < 4 ? w0[e & 3] : w1[e & 3]));
#pragma unroll
        for (int nt = 0; nt < 4; ++nt)
#pragma unroll
            for (int pt = 0; pt < 4; ++pt) acc[nt][pt] = __builtin_amdgcn_mfma_f32_16x16x32_bf16(bt[nt], xs[pt], acc[nt][pt], 0, 0, 0);
    }
    bf16_t* o = p.Scs + ((size_t)((cid * 2 + d) * 16 + hh) * 64) * NS + nh * 64 + 4 * fq;
#pragma unroll
    for (int pt = 0; pt < 4; ++pt)
#pragma unroll
        for (int nt = 0; nt < 4; ++nt) { uint2 q; q.x = pack2(acc[nt][pt][0], acc[nt][pt][1]); q.y = pack2(acc[nt][pt][2], acc[nt][pt][3]);
            *(uint2*)(o + (size_t)(pt * 16 + fr) * NS + nt * 16) = q; }
}
constexpr int N_SCAN = NB * 2 * NH * HD * 16 / 256;
__device__ __forceinline__ void stage_scan(PRef p, int item) {
    const int idx = item * 256 + tidx(), n8 = idx & 15, pp = (idx >> 4) & 63, hh = (idx >> 10) & 15, d = (idx >> 14) & 1, b = idx >> 15;
    float s[8];
#pragma unroll
    for (int i = 0; i < 8; ++i) s[i] = 0.f;
#pragma unroll 4
    for (int t = 0; t < 66; ++t) {
        const int cid = t < 2 ? 128 + b * 2 + (d == 0 ? t : 1 - t) : b * 64 + (d == 0 ? t - 2 : 65 - t);
        const size_t o = ((size_t)((cid * 2 + d) * 16 + hh) * 64 + pp) * NS + n8 * 8;
        uint4 q; q.x = pack2(s[0], s[1]); q.y = pack2(s[2], s[3]); q.z = pack2(s[4], s[5]); q.w = pack2(s[6], s[7]);
        *(uint4*)(p.Sst + o) = q;
        const uint4 c = *(const uint4*)(p.Scs + o);
        const float dec = __expf(p.ac[(size_t)(cid * 128 + (d == 0 ? 127 : 0)) * 32 + d * 16 + hh]);
        s[0] = s[0] * dec + lo16(c.x); s[1] = s[1] * dec + hi16(c.x); s[2] = s[2] * dec + lo16(c.y); s[3] = s[3] * dec + hi16(c.y);
        s[4] = s[4] * dec + lo16(c.z); s[5] = s[5] * dec + hi16(c.z); s[6] = s[6] * dec + lo16(c.w); s[7] = s[7] * dec + hi16(c.w);
    }
}
constexpr int N_SSDOUT = 128 * 4 + 4 * 4 * 4;
__device__ __forceinline__ void stage_ssdout(PRef p, int layer, int item, char* lds) {
    const int tid = tidx(), wid = tid >> 6, lane = tid & 63, fr = lane & 15, fq = lane >> 4;
    int cid, g, h0, nh;
    if (item < 512) { cid = item >> 2; g = item & 3; h0 = 0; nh = 4; } else { const int it = item - 512; cid = 128 + (it >> 4); g = (it >> 2) & 3; h0 = it & 3; nh = 1; }
    const int row0 = cid * 128;
    char* LX = lds; float* acd = (float*)(lds + 128 * PXS); float* dtd = acd + 256;
    char* SB = lds + 128 * PXS + 2048;
    const int srow = tid >> 4, sslot = tid & 15, schunk = (sslot ^ (srow & 15)) * 8;
    __syncthreads();
#pragma unroll
    for (int i = 0; i < 8; ++i) __builtin_amdgcn_global_load_lds((const unsigned*)(p.V + (size_t)(row0 + srow + 16 * i) * 2048 + 1024 + g * NS + schunk), (unsigned*)(SB + i * 4096 + tid * 16), 16, 0, 0);
    bf16x8 cf[2][4];
#pragma unroll
    for (int lt = 0; lt < 2; ++lt)
#pragma unroll
        for (int ks = 0; ks < 4; ++ks) cf[lt][ks] = *(const bf16x8*)(p.V + (size_t)(row0 + wid * 32 + lt * 16 + fr) * 2048 + 1536 + g * NS + ks * 32 + fq * 8);
    asm volatile("s_waitcnt vmcnt(0)" ::: "memory");
    __syncthreads();
    f32x4 cbt[8][2];
#pragma unroll
    for (int st = 0; st < 8; ++st) {
        bf16x8 bfA[4];
#pragma unroll
        for (int ks = 0; ks < 4; ++ks) bfA[ks] = *(const bf16x8*)(SB + (st * 16 + fr) * 256 + (((ks * 4 + fq) ^ fr) * 16));
#pragma unroll
        for (int lt = 0; lt < 2; ++lt) { f32x4 a = {0.f, 0.f, 0.f, 0.f};
#pragma unroll
            for (int ks = 0; ks < 4; ++ks) a = __builtin_amdgcn_mfma_f32_16x16x32_bf16(bfA[ks], cf[lt][ks], a, 0, 0, 0);
            cbt[st][lt] = a; }
    }
    const unsigned baseX = lds_addr(LX) + (4 * fq + (fr >> 2)) * PXS + 4 * (fr & 3) * 2;
#pragma unroll 1
    for (int hi = h0; hi < h0 + nh; ++hi) {
        const int hh = g * 4 + hi;
        float ssq[2] = {0.f, 0.f};
        __syncthreads();
        { const int t2 = tidx(), srow2 = t2 >> 4, schunk2 = ((t2 & 15) ^ (srow2 & 15)) * 8;
#pragma unroll
        for (int d = 0; d < 2; ++d) { const bf16_t* S = p.Sst + ((size_t)((cid * 2 + d) * 16 + hh) * 64) * NS;
#pragma unroll
            for (int i = 0; i < 4; ++i) __builtin_amdgcn_global_load_lds((const unsigned*)(S + (size_t)(srow2 + 16 * i) * NS + schunk2), (unsigned*)(SB + d * 16384 + i * 4096 + t2 * 16), 16, 0, 0); } }
#pragma unroll
        for (int i = 0; i < 4; ++i) { const int id = tid + 256 * i, r = id >> 3, o = id & 7;
            *(uint4*)(LX + r * PXS + o * 16) = *(const uint4*)(p.V + (size_t)(row0 + r) * 2048 + hh * HD + o * 8); }
        { const int d = tid >> 7, l = tid & 127; acd[tid] = p.ac[(size_t)(row0 + l) * 32 + d * 16 + hh]; dtd[tid] = p.dt[(size_t)(row0 + l) * 32 + d * 16 + hh]; }
        asm volatile("s_waitcnt vmcnt(0)" ::: "memory");
        __syncthreads();
        f32x4 yacc[4][2];
#pragma unroll
        for (int pt = 0; pt < 4; ++pt) { yacc[pt][0] = (f32x4){0.f, 0.f, 0.f, 0.f}; yacc[pt][1] = (f32x4){0.f, 0.f, 0.f, 0.f}; }
#pragma unroll
        for (int d = 0; d < 2; ++d) {
            const float el0 = acd[d * 128 + wid * 32 + fr], el1 = acd[d * 128 + wid * 32 + 16 + fr];
#pragma unroll
            for (int ks = 0; ks < 4; ++ks) {
                if (d == 0 ? ks > wid : ks < wid) continue;
                const int s0 = 32 * ks + 4 * fq;
                const f32x4 as0 = *(const f32x4*)(acd + d * 128 + s0), as1 = *(const f32x4*)(acd + d * 128 + s0 + 16);
                const f32x4 ds0 = *(const f32x4*)(dtd + d * 128 + s0), ds1 = *(const f32x4*)(dtd + d * 128 + s0 + 16);
                bf16x8 gf[2];
#pragma unroll
                for (int lt = 0; lt < 2; ++lt) {
                    const int l = wid * 32 + lt * 16 + fr; const float el = lt ? el1 : el0;
#pragma unroll
                    for (int e = 0; e < 4; ++e) {
                        const int sa = s0 + e, sb = s0 + 16 + e;
                        const bool ma = d == 0 ? (sa <= l) : (sa >= l), mb = d == 0 ? (sb <= l) : (sb >= l);
                        const float va = ma ? cbt[2 * ks][lt][e] * __expf(fminf(el - as0[e], 0.f)) * ds0[e] : 0.f;
                        const float vb = mb ? cbt[2 * ks + 1][lt][e] * __expf(fminf(el - as1[e], 0.f)) * ds1[e] : 0.f;
                        gf[lt][e] = (short)f2bf(va); gf[lt][4 + e] = (short)f2bf(vb);
                    }
                }
                bf16x8 xf[4];
                tr_frag4b<16 * PXS>(xf, baseX + ks * 32 * PXS, 32);
#pragma unroll
                for (int pt = 0; pt < 4; ++pt) { yacc[pt][0] = __builtin_amdgcn_mfma_f32_16x16x32_bf16(xf[pt], gf[0], yacc[pt][0], 0, 0, 0);
                                                 yacc[pt][1] = __builtin_amdgcn_mfma_f32_16x16x32_bf16(xf[pt], gf[1], yacc[pt][1], 0, 0, 0); }
            }
            const float ex0 = __expf(el0), ex1 = __expf(el1);
            const char* S = SB + d * 16384;
#pragma unroll
            for (int pt = 0; pt < 4; ++pt) {
                f32x4 o0 = {0.f, 0.f, 0.f, 0.f}, o1 = {0.f, 0.f, 0.f, 0.f};
#pragma unroll
                for (int ks = 0; ks < 4; ++ks) { const bf16x8 sf = *(const bf16x8*)(S + (pt * 16 + fr) * 256 + (((ks * 4 + fq) ^ fr) * 16));
                    o0 = __builtin_amdgcn_mfma_f32_16x16x32_bf16(sf, cf[0][ks], o0, 0, 0, 0); o1 = __builtin_amdgcn_mfma_f32_16x16x32_bf16(sf, cf[1][ks], o1, 0, 0, 0); }
                yacc[pt][0] += o0 * ex0; yacc[pt][1] += o1 * ex1;
            }
        }
        const float dsk = p.d_skip[layer * NH + hh];
#pragma unroll
        for (int lt = 0; lt < 2; ++lt) {
            const int l = wid * 32 + lt * 16 + fr; const size_t row = (size_t)(row0 + l);
#pragma unroll
            for (int pt = 0; pt < 4; ++pt) {
                const int pc = pt * 16 + 4 * fq;
                const uint2 xq = *(const uint2*)(LX + l * PXS + pc * 2);
                const uint2 zq = *(const uint2*)(p.U + row * UC + U_Z + hh * HD + pc);
                const float xv[4] = {lo16(xq.x), hi16(xq.x), lo16(xq.y), hi16(xq.y)}, zv[4] = {lo16(zq.x), hi16(zq.x), lo16(zq.y), hi16(zq.y)};
                float o[4];
#pragma unroll
                for (int j = 0; j < 4; ++j) { o[j] = (yacc[pt][lt][j] + dsk * xv[j]) * siluf_(zv[j]); ssq[lt] += o[j] * o[j]; }
                uint2 q; q.x = pack2(o[0], o[1]); q.y = pack2(o[2], o[3]);
                *(uint2*)(p.yc + row * D + hh * HD + pc) = q;
            }
        }
#pragma unroll
        for (int lt = 0; lt < 2; ++lt) { float s = ssq[lt]; s += __shfl_xor(s, 16); s += __shfl_xor(s, 32);
            if (fq == 0) p.ssq[(size_t)(row0 + wid * 32 + lt * 16 + fr) * 16 + hh] = s; }
    }
}

constexpr int N_ROUTER = T / 32, HSP = 1028;
__device__ __forceinline__ void stage_router(PRef p, int layer, int item, char* lds) {
    const int tid = tidx(), wave = tid >> 6, lane = tid & 63;
    float* hs = (float*)lds;
    float* part = hs + 16 * HSP;
    int* pe = (int*)(part + 4 * 16 * 32);
    int* hist = pe + 256;
    int* rank = hist + 32;
    const float* nw = p.norm2_w + layer * D;
    __syncthreads();
    if (tid < 32) hist[tid] = 0;
#pragma unroll 1
    for (int rnd = 0; rnd < 2; ++rnd) {
        const int rowb = item * 32 + rnd * 16;
#pragma unroll 1
        for (int t = 0; t < 4; ++t) {
            const int tl = wave * 4 + t, row = rowb + tl, mrow = modrow(row);
            const float* sh = modp(p, layer, mrow, 3); const float* sc = modp(p, layer, mrow, 4);
            f32x4 v[4]; float ss = 0.f;
#pragma unroll
            for (int j = 0; j < 4; ++j) { v[j] = *(const f32x4*)(p.res + (size_t)row * D + 4 * lane + 256 * j); ss += v[j][0] * v[j][0] + v[j][1] * v[j][1] + v[j][2] * v[j][2] + v[j][3] * v[j][3]; }
            ss = wave_sum(ss); const float rinv = rsqrtf(ss * (1.0f / D) + RMS_EPS);
#pragma unroll
            for (int j = 0; j < 4; ++j) {
                const int k = 4 * lane + 256 * j;
                const f32x4 w = *(const f32x4*)(nw + k), a = *(const f32x4*)(sc + k), bb = *(const f32x4*)(sh + k);
                const f32x4 hv = v[j] * rinv * w * (a + 1.0f) + bb;
                uint2 q; q.x = pack2(hv[0], hv[1]); q.y = pack2(hv[2], hv[3]);
                *(uint2*)(p.h + (size_t)row * D + k) = q;
                *(f32x4*)(hs + tl * HSP + k) = hv;
            }
        }
        __syncthreads();
        {
            const int i = lane & 15, kq = lane >> 4;
            const float* rw = p.router_w + (size_t)layer * D * NE + (lane & 15);
            f32x4 a0 = {0.f, 0.f, 0.f, 0.f}, a1 = {0.f, 0.f, 0.f, 0.f};
#pragma unroll 4
            for (int q = 0; q < 16; ++q) {
                const int kb = wave * 256 + q * 16 + kq * 4;
                const f32x4 av = *(const f32x4*)(hs + i * HSP + kb);
#pragma unroll
                for (int j = 0; j < 4; ++j) {
                    const float b0 = rw[(size_t)(kb + j) * NE], b1 = rw[(size_t)(kb + j) * NE + 16];
                    a0 = __builtin_amdgcn_mfma_f32_16x16x4f32(av[j], b0, a0, 0, 0, 0);
                    a1 = __builtin_amdgcn_mfma_f32_16x16x4f32(av[j], b1, a1, 0, 0, 0);
                }
            }
#pragma unroll
            for (int r = 0; r < 4; ++r) { part[(wave * 16 + 4 * kq + r) * 32 + i] = a0[r]; part[(wave * 16 + 4 * kq + r) * 32 + 16 + i] = a1[r]; }
        }
        __syncthreads();
        if (tid < 16) {
            float lg[32];
#pragma unroll
            for (int e = 0; e < 32; ++e) lg[e] = part[(0 * 16 + tid) * 32 + e] + part[(1 * 16 + tid) * 32 + e] + part[(2 * 16 + tid) * 32 + e] + part[(3 * 16 + tid) * 32 + e] + p.router_b[layer * NE + e];
            float tv[4]; int ti[4];
#pragma unroll
            for (int r = 0; r < 4; ++r) {
                float bv = -3.0e38f; int bi = 0;
#pragma unroll
                for (int e = 0; e < 32; ++e) { const bool tk = (r > 0 && ti[0] == e) || (r > 1 && ti[1] == e) || (r > 2 && ti[2] == e); if (!tk && lg[e] > bv) { bv = lg[e]; bi = e; } }
                tv[r] = bv; ti[r] = bi;
            }
            const int row = rowb + tid;
            const float e1 = __expf(tv[1] - tv[0]), e2 = __expf(tv[2] - tv[0]), e3 = __expf(tv[3] - tv[0]); const float inv = 1.0f / (1.0f + e1 + e2 + e3);
            *(f32x4*)(p.topw + (size_t)row * 4) = (f32x4){inv, e1 * inv, e2 * inv, e3 * inv};
#pragma unroll
            for (int r = 0; r < 4; ++r) { p.topi[row * 4 + r] = ti[r]; pe[(rnd * 16 + tid) * 4 + r] = ti[r]; }
        }
        __syncthreads();
    }
    if (tid < 128) rank[tid] = atomicAdd(&hist[pe[tid]], 1);
    __syncthreads();
    if (tid < 32) { const int c = hist[tid]; hist[tid] = c ? atomicAdd(&p.cnt[layer * NE + tid], c) : 0; }
    __syncthreads();
    if (tid < 128) { const int e = pe[tid]; p.list[(size_t)(layer * NE + e) * T + hist[e] + rank[tid]] = (item * 32 + (tid >> 2)) * 4 + (tid & 3); }
}

#define XB_TMO      128
#define XB_XCNT(j)  (256  + 64 * (j))
#define XB_XSUB(j)  (1280 + 64 * (j))
#define XB_XGEN(j)  (2304 + 64 * (j))
#define XB_TOP      3328
#define XB_TOPGEN   3392
#define XCD_BAR_WORDS 3456
#define XB_SPIN_CAP (1u << 22)
#define LAS __attribute__((address_space(3)))
__device__ __forceinline__ unsigned xb_ld(unsigned* p)              { return __hip_atomic_load(p, __ATOMIC_RELAXED, __HIP_MEMORY_SCOPE_AGENT); }
__device__ __forceinline__ unsigned xb_add(unsigned* p, unsigned v) { return __hip_atomic_fetch_add(p, v, __ATOMIC_RELAXED, __HIP_MEMORY_SCOPE_AGENT); }
__device__ __forceinline__ unsigned xb_xcc_id() { return (unsigned)__builtin_amdgcn_s_getreg((3 << 11) | 20) & 0xFu; }
#define XB_SPIN(cond, bar) do { unsigned _sp = 0; while (cond) { __builtin_amdgcn_s_sleep(1); \
    if ((++_sp & 255u) == 0u) { if (xb_ld(&(bar)[XB_TMO])) break; if (_sp > XB_SPIN_CAP) { atomicAdd(&(bar)[XB_TMO], 1u); break; } } } } while (0)
struct XcdBarrier { unsigned* bar; unsigned x; volatile LAS unsigned* st; };
__device__ __forceinline__ XcdBarrier xcd_barrier_post(unsigned* bar, volatile LAS unsigned* st) {
    XcdBarrier b; b.bar = bar; b.x = xb_xcc_id(); b.st = st;
    if (threadIdx.x == 0) st[2] = xb_add(&bar[XB_XCNT(b.x)], 1u);
    return b;
}
__device__ __forceinline__ void xcd_barrier_complete(unsigned* bar, unsigned x, unsigned& nloc, unsigned& nx, unsigned& rank) {
    const unsigned G = gridDim.x * gridDim.y * gridDim.z;
    unsigned sum, cnt, mine, sp = 0u;
    for (;;) {
        sum = 0u; cnt = 0u; mine = 0u;
#pragma unroll
        for (unsigned j = 0; j < 16; ++j) { const unsigned c = xb_ld(&bar[XB_XCNT(j)]); sum += c; cnt += (c > 0u) ? 1u : 0u; }
        mine = xb_ld(&bar[XB_XCNT(x)]);
        rank = 0u;
#pragma unroll
        for (unsigned j = 0; j < 16; ++j) rank += (j < x && xb_ld(&bar[XB_XCNT(j)]) > 0u) ? 1u : 0u;
        if (sum == G) break;
        __builtin_amdgcn_s_sleep(1);
        if ((++sp & 255u) == 0u) { if (xb_ld(&bar[XB_TMO])) break; if (sp > XB_SPIN_CAP) { atomicAdd(&bar[XB_TMO], 1u); break; } }
    }
    nloc = mine > 0u ? mine : 1u; nx = cnt > 0u ? cnt : 1u;
}
__device__ __forceinline__ void xcd_barrier(const XcdBarrier& b) {
    asm volatile("s_waitcnt vmcnt(0)" ::: "memory");
    __syncthreads();
    if (threadIdx.x == 0) {
        unsigned* bar = b.bar;
        __builtin_amdgcn_s_waitcnt(0);
        unsigned nloc = b.st[0], nx = b.st[1];
        if (nloc == 0u) { unsigned rk = 0u; xcd_barrier_complete(bar, b.x, nloc, nx, rk); b.st[0] = nloc; b.st[1] = nx; b.st[3] = rk; }
        const unsigned old = xb_add(&bar[XB_XSUB(b.x)], 1u);
        const unsigned gen = old / nloc;
        if (old + 1u == (gen + 1u) * nloc) {
            __builtin_amdgcn_fence(__ATOMIC_RELEASE, "agent");
            asm volatile("s_waitcnt vmcnt(0)" ::: "memory");
            const unsigned og = xb_add(&bar[XB_TOP], 1u);
            const unsigned tg = og / nx;
            if (og + 1u == (tg + 1u) * nx) xb_add(&bar[XB_TOPGEN], 1u);
            else XB_SPIN(xb_ld(&bar[XB_TOPGEN]) == tg, bar);
            __builtin_amdgcn_fence(__ATOMIC_ACQUIRE, "agent");
            xb_add(&bar[XB_XGEN(b.x)], 1u);
            asm volatile("s_waitcnt vmcnt(0)" ::: "memory");
        } else {
            XB_SPIN(xb_ld(&bar[XB_XGEN(b.x)]) == gen, bar);
            __builtin_amdgcn_fence(__ATOMIC_ACQUIRE, "agent");
            asm volatile("s_waitcnt vmcnt(0)" ::: "memory");
        }
    }
    __syncthreads();
}

namespace cg = cooperative_groups;
#define PHASE_LOOP(n) for (int item = bid; item < (n); item += G)
#define XPHASE_LOOP(n, base) for (int item = (base) + (int)(((long)(n) * xrank) / xnum) + xslot, item_end = (base) + (int)(((long)(n) * (xrank + 1)) / xnum); item < item_end; item += xper)
__global__ void __launch_bounds__(256, 2) hybrid_megakernel(Params p_by_value) {
    CParams* kp = (CParams*)__builtin_amdgcn_kernarg_segment_ptr();
#define p (*launder(kp))
    __shared__ __attribute__((aligned(16))) char lds[LDS_BYTES + 16];
#define xb_words (*(uint4*)(lds + LDS_BYTES))
    if (threadIdx.x == 0) xb_words = make_uint4(0u, 0u, 0u, 0u);
    __syncthreads();
    XcdBarrier bar = xcd_barrier_post(p.bar, (volatile LAS unsigned*)&xb_words);
    const int G = gridDim.x, bid = blockIdx.x;
    int xper = G >> 3, xnum = 8, xslot = bid >> 3, xrank = bid & 7;
    constexpr int PH_PER_LAYER = 11, N_PHASES = 1 + DEPTH * PH_PER_LAYER + 1;
#pragma unroll 1
    for (int ph = 0; ph < N_PHASES; ++ph) {
        const int l = ph == 0 ? 0 : (ph - 1) / PH_PER_LAYER, sub = ph == 0 ? -1 : (ph == N_PHASES - 1 ? 99 : (ph - 1) % PH_PER_LAYER);
        switch (sub) {
        case -1:
            PHASE_LOOP(N_TABLE + 33 * (N_FOLD + N_ADA)) {
                if (item < N_TABLE) { stage_table(p, item); continue; }
                const int i = item - N_TABLE, q = i / 33, r = i % 33;
                if (r == 0) { if (q < N_FOLD) stage_fold(p, q, lds); else stage_ada(p, q - N_FOLD, lds); }
                else { const int cv = q * 32 + (r - 1); if (cv < N_CONVERT) stage_convert(p, cv, lds); }
            }
            break;
        case 0:
            if (l == 0) { PHASE_LOOP(N_ROWNORM) stage_rownorm<0>(p, l, item); } else { PHASE_LOOP(N_ROWNORM) stage_rownorm<1>(p, l, item); }
            break;
        case 1: XPHASE_LOOP(N_INPROJ, 0) stage_inproj(p, l, item, lds); break;
        case 2:
            PHASE_LOOP(N_FOURA + N_CONV + N_POOL + N_ACSUM) {
                if (item < N_FOURA) stage_fourA(p, item, lds);
                else if (item < N_FOURA + N_CONV) stage_conv(p, l, item - N_FOURA);
                else if (item < N_FOURA + N_CONV + N_POOL) stage_pool(p, item - N_FOURA - N_CONV);
                else stage_acsum(p, l, item - N_FOURA - N_CONV - N_POOL, lds);
            }
            break;
        case 3:
            PHASE_LOOP(N_CSTATE + N_FOURB) {
                if (item < N_CSTATE) stage_cstate(p, item, lds);
                else stage_fourB(p, item - N_CSTATE, lds);
            }
            break;
        case 4:
            PHASE_LOOP(N_SCAN) stage_scan(p, item);
            XPHASE_LOOP(N_G1024, 0) stage_gemm_small<1>(p, l, item, lds);
            break;
        case 5: PHASE_LOOP(l == DEPTH - 1 ? 512 : N_SSDOUT) stage_ssdout(p, l, item, lds); break;
        case 6: XPHASE_LOOP(l == DEPTH - 1 ? (TL / 128) * 8 : N_G1024, 0) stage_merge(p, l, item, lds); break;
        case 7: XPHASE_LOOP(l == DEPTH - 1 ? (TL / 128) * 8 : N_G1024, 0) stage_outproj(p, l, item, lds); break;
        case 8: PHASE_LOOP(l == DEPTH - 1 ? TL / 32 : N_ROUTER) stage_router(p, l, item, lds); break;
        case 9: { const int n1 = moe_total_mtiles(p, l) * 16; XPHASE_LOOP(n1, 0) stage_moe1(p, l, item, lds); } break;
        case 10: { const int n2 = moe_total_mtiles(p, l) * 8; XPHASE_LOOP(n2, 0) stage_moe2(p, l, item, lds); } break;
        default: PHASE_LOOP(TL / 4) stage_rownorm<2>(p, DEPTH - 1, item); break;
        }
        if (ph == 0) { cg::this_grid().sync(); xcd_barrier(bar); xper = (int)xb_words.x; xnum = (int)xb_words.y; xslot = (int)xb_words.z; xrank = (int)xb_words.w; }
        else if (ph != N_PHASES - 1) xcd_barrier(bar);
    }
#undef p
}

extern "C" void kernel_launch(void* const* d_in, const int* in_sizes, int n_in, void* d_out, int out_size, void* d_ws, size_t ws_size, hipStream_t stream) {
    Params p; memset(&p, 0, sizeof(p));
    const float** f = (const float**)&p;
    for (int i = 0; i < 26; ++i) f[i] = (const float*)d_in[i];
    p.out = (float*)d_out;
    char* w = (char*)d_ws; size_t off = 0;
    auto take = [&](size_t bytes) { char* r = w + off; off += (bytes + 255) & ~(size_t)255; return r; };
    p.bar = (unsigned*)take(16384); p.cnt = (int*)take(1024);
    p.mod = (float*)take((size_t)DEPTH * 3 * 6144 * 4);
    p.res = (float*)take((size_t)T * D * 4);
    p.dt = (float*)take((size_t)T * 32 * 4);
    p.ybuf = (float*)take((size_t)T * D * 4);
    p.ycraw = (float*)take((size_t)T * D * 4);
    p.topw = (float*)take((size_t)T * 4 * 4);
    p.topi = (int*)take((size_t)T * 4 * 4);
    p.list = (int*)take((size_t)DEPTH * NE * T * 4);
    p.h = (bf16_t*)take((size_t)T * D * 2);
    p.w_in_t = (bf16_t*)take((size_t)DEPTH * WIN_ROWS * D * 2);
    p.w_br_t = (bf16_t*)take((size_t)DEPTH * 3 * D * D * 2);
    p.w_out_t = (bf16_t*)take((size_t)DEPTH * D * D * 2);
    p.pool_w_t = (bf16_t*)take((size_t)DEPTH * 4 * 65536 * 2);
    p.w1_t = (bf16_t*)take((size_t)DEPTH * NE * 2048 * D * 2);
    p.w2_t = (bf16_t*)take((size_t)DEPTH * NE * D * D * 2);
    p.cs_t = (bf16_t*)take((size_t)256 * 512 * 2);
    p.tabA = (bf16_t*)take((size_t)128 * 128 * 64 * 2);
    p.tabB = (bf16_t*)take((size_t)256 * 256 * 2);
    p.tabC = (bf16_t*)take((size_t)2 * 256 * 256 * 2);
    p.Ap = (bf16_t*)take((size_t)NB * 64 * 256 * D * 2);
    p.Scs = (bf16_t*)take((size_t)NCH * 2 * NH * HD * NS * 2);
    p.Sst = (bf16_t*)take((size_t)NCH * 2 * NH * HD * NS * 2);
    p.ac = (float*)take((size_t)T * 32 * 4);
    p.ssq = (float*)take((size_t)T * 16 * 4);
    p.U = (bf16_t*)take((size_t)T * UC * 2);
    p.V = (bf16_t*)take((size_t)T * 2048 * 2);
    p.Dp = (bf16_t*)take((size_t)T * D * 2);
    p.ya = (bf16_t*)take((size_t)T * D * 2);
    p.Yb = (bf16_t*)take((size_t)T * 2048 * 2);
    p.yb = (bf16_t*)take((size_t)T * D * 2);
    p.yc = (bf16_t*)take((size_t)T * D * 2);
    p.m = (bf16_t*)take((size_t)T * D * 2);
    p.act = (bf16_t*)take((size_t)(T * 4 + 256) * D * 2);
    p.sout = (bf16_t*)take((size_t)T * 4 * D * 2);
    if (off > ws_size) { fprintf(stderr, "workspace too small: need %zu have %zu\n", off, ws_size); return; }
    static int grid_blocks = 0;
    if (!grid_blocks) {
        int dev = 0, cus = 0, per_cu = 0;
        (void)hipGetDevice(&dev);
        (void)hipDeviceGetAttribute(&cus, hipDeviceAttributeMultiprocessorCount, dev);
        (void)hipOccupancyMaxActiveBlocksPerMultiprocessor(&per_cu, hybrid_megakernel, 256, 0);
        if (per_cu > 2) per_cu = 2;
        if (per_cu < 1) per_cu = 1;
        grid_blocks = cus * per_cu;
    }
    (void)hipMemsetAsync(p.bar, 0, 16384 + 1024, stream);
    void* args[] = {&p};
    hipError_t e = hipLaunchCooperativeKernel((void*)hybrid_megakernel, dim3(grid_blocks), dim3(256), args, 0, stream);
    if (e != hipSuccess) fprintf(stderr, "cooperative launch failed: %s (grid %d)\n", hipGetErrorString(e), grid_blocks);
}
```

```cpp
#include <hip/hip_runtime.h>
#include <hip/hip_cooperative_groups.h>
#include <cstdio>
#include <cstdint>
#include <cstring>

typedef unsigned short bf16_t;
typedef short bf16x8 __attribute__((ext_vector_type(8)));
typedef float f32x4 __attribute__((ext_vector_type(4)));

constexpr int D = 1024, NB = 2, SEQ = 8192, TL = NB * SEQ, CTXL = 256, TC = NB * CTXL, T = TL + TC;
constexpr int DEPTH = 2, NE = 32, TOPK = 4, NH = 16, HD = 64, NS = 128;
constexpr int IN_COLS = 8224, UC = 8192;
constexpr int U_FOUR = 1024, U_Z = 2048, U_XBC = 3072, U_GATE = 5120;
constexpr int WIN_ROWS = 8320;
constexpr float RMS_EPS = 1e-6f;
constexpr int LDS_BYTES = 77824;

struct Params {
    const float *x, *c, *ctx, *c_ctx, *w_ada, *b_ada, *norm1_w, *norm2_w, *w_in, *pool_w, *pool_scale, *conv_w, *conv_b, *dt_bias, *a_log,
        *d_skip, *ssm_norm_w, *w_branch, *w_out, *router_w, *router_b, *moe_w1, *moe_b1, *moe_w2, *moe_b2, *final_norm_w;
    float* out;
    unsigned* bar; int* cnt;
    float *mod, *res, *dt, *ybuf, *ycraw, *topw, *ac, *ssq;
    bf16_t *h, *w_in_t, *w_br_t, *w_out_t, *pool_w_t, *w1_t, *w2_t, *cs_t, *U, *V, *Dp, *ya, *Yb, *yb, *yc, *m, *act, *sout, *tabA, *tabB, *tabC, *Ap, *Scs, *Sst;
    int *topi, *list;
};

typedef const __attribute__((address_space(4))) Params CParams;
typedef CParams& PRef;
__device__ __forceinline__ CParams* launder(CParams* kp) { asm volatile("" : "+s"(kp)); return kp; }
__device__ __forceinline__ int tidx() { int t = threadIdx.x; asm volatile("" : "+v"(t)); return t; }
__device__ __forceinline__ float bf2f(bf16_t u) { return __uint_as_float(((unsigned)u) << 16); }
typedef __bf16 bf16n2 __attribute__((ext_vector_type(2)));
typedef float f32x2n __attribute__((ext_vector_type(2)));
__device__ __forceinline__ bf16_t f2bf(float f) { return __builtin_bit_cast(bf16_t, (__bf16)f); }
__device__ __forceinline__ unsigned pack2(float a, float b) { return __builtin_bit_cast(unsigned, __builtin_convertvector((f32x2n){a, b}, bf16n2)); }
__device__ __forceinline__ float lo16(unsigned u) { return __uint_as_float(u << 16); }
__device__ __forceinline__ float hi16(unsigned u) { return __uint_as_float(u & 0xffff0000u); }
__device__ __forceinline__ float sigmoidf_(float x) { return __builtin_amdgcn_rcpf(1.0f + __expf(-x)); }
__device__ __forceinline__ float siluf_(float x) { return x * __builtin_amdgcn_rcpf(1.0f + __expf(-x)); }
__device__ __forceinline__ float softplusf_(float x) { return x > 20.f ? x : log1pf(__expf(x)); }
__device__ __forceinline__ int modrow(int row) { return row < TL ? (row / SEQ) : 2; }
__device__ __forceinline__ const float* modp(PRef p, int layer, int mrow, int j) { return p.mod + ((size_t)((layer * 3 + mrow) * 6 + j)) * D; }
__device__ __forceinline__ float wave_sum(float v) {
#pragma unroll
    for (int o = 32; o >= 1; o >>= 1) v += __shfl_xor(v, o);
    return v;
}

__device__ __forceinline__ int colmap(int mode, int j) {
    if (mode == 0) return j;
    if (mode == 1) { if (j < 5120) return j; if (j < 8192) return j + 32; if (j < 8224) return 5120 + (j - 8192); return -1; }
    const int Tn = j >> 7, wc = (j >> 6) & 1, jj = j & 63, fq = jj >> 4, n = (jj >> 2) & 3;
    return (n < 2 ? 0 : 1024) + Tn * 64 + wc * 32 + 8 * fq + 4 * (n & 1) + (jj & 3);
}
__device__ __forceinline__ void convert_tile(const float* __restrict__ src, int ld, bf16_t* __restrict__ dst, int K, int n0, int k0, int mode, char* lds, const float* kscale = nullptr) {
    float* tile = (float*)lds;
    const int tid = tidx();
    __syncthreads();
    { const int n4 = (tid & 15) * 4, kr = tid >> 4; const int sc = colmap(mode, n0 + n4);
      f32x4 v[8];
#pragma unroll
      for (int i = 0; i < 8; ++i) { const int kk = kr + 16 * i; v[i] = (f32x4){0.f, 0.f, 0.f, 0.f}; if (sc >= 0) v[i] = *(const f32x4*)(src + (size_t)(k0 + kk) * ld + sc); }
#pragma unroll
      for (int i = 0; i < 8; ++i) { const int kk = kr + 16 * i; if (kscale) v[i] *= kscale[k0 + kk];
          tile[kk * 65 + n4] = v[i][0]; tile[kk * 65 + n4 + 1] = v[i][1]; tile[kk * 65 + n4 + 2] = v[i][2]; tile[kk * 65 + n4 + 3] = v[i][3]; } }
    __syncthreads();
    { const int ko = (tid & 15) * 8, nr = tid >> 4;
#pragma unroll
      for (int i = 0; i < 4; ++i) { const int n = nr + 16 * i; float v[8];
#pragma unroll
          for (int j = 0; j < 8; ++j) v[j] = tile[(ko + j) * 65 + n];
          uint4 q; q.x = pack2(v[0], v[1]); q.y = pack2(v[2], v[3]); q.z = pack2(v[4], v[5]); q.w = pack2(v[6], v[7]);
          *(uint4*)(dst + (size_t)(n0 + n) * K + k0 + ko) = q; } }
}
constexpr int CV_WIN = (WIN_ROWS / 64) * 8, CV_BR = 3 * 128, CV_OUT = 128, CV_POOL = 4 * 8, CV_W1 = NE * 32 * 8, CV_W2 = NE * 128;
constexpr int CV_LAYER = CV_WIN + CV_BR + CV_OUT + CV_POOL + CV_W1 + CV_W2;
constexpr int N_CONVERT = DEPTH * CV_LAYER;
__device__ __forceinline__ void stage_convert(PRef p, int item, char* lds) {
    const int l = item / CV_LAYER; int w = item % CV_LAYER;
    if (w < CV_WIN) { convert_tile(p.w_in + (size_t)l * D * IN_COLS, IN_COLS, p.w_in_t + (size_t)l * WIN_ROWS * D, D, (w / 8) * 64, (w % 8) * 128, 1, lds); return; }
    w -= CV_WIN;
    if (w < CV_BR) { const int k = w / 128, t = w % 128; if (k == 0) return; convert_tile(p.w_branch + (size_t)(l * 3 + k) * D * D, D, p.w_br_t + (size_t)(l * 3 + k) * D * D, D, (t / 8) * 64, (t % 8) * 128, 0, lds, (k == 2) ? p.ssm_norm_w + l * D : nullptr); return; }
    w -= CV_BR;
    if (w < CV_OUT) { convert_tile(p.w_out + (size_t)l * D * D, D, p.w_out_t + (size_t)l * D * D, D, (w / 8) * 64, (w % 8) * 128, 0, lds); return; }
    w -= CV_OUT;
    if (w < CV_POOL) { return; const int g = w / 8, t = w % 8; convert_tile(p.pool_w + (size_t)(l * 4 + g) * 65536, 256, p.pool_w_t + (size_t)(l * 4 + g) * 65536, 256, (t / 2) * 64, (t % 2) * 128, 0, lds); return; }
    w -= CV_POOL;
    if (w < CV_W1) { const int e = w / 256, t = w % 256; convert_tile(p.moe_w1 + (size_t)(l * NE + e) * D * 2048, 2048, p.w1_t + (size_t)(l * NE + e) * 2048 * D, D, (t / 8) * 64, (t % 8) * 128, 2, lds); return; }
    w -= CV_W1;
    { const int e = w / 128, t = w % 128; convert_tile(p.moe_w2 + (size_t)(l * NE + e) * D * D, D, p.w2_t + (size_t)(l * NE + e) * D * D, D, (t / 8) * 64, (t % 8) * 128, 0, lds); }
}
constexpr int N_FOLD = DEPTH * 4 * 16 * 4;
__device__ __forceinline__ void stage_fold(PRef p, int item, char* lds) {
    float* P = (float*)lds;
    float* W = P + 64 * 64;
    const int tid = tidx(), l = item >> 8, g = (item >> 6) & 3, n0 = ((item >> 2) & 15) * 64, kl0 = (item & 3) * 64;
    const int n = tid & 63, kq = tid >> 6;
    float acc[16];
#pragma unroll
    for (int i = 0; i < 16; ++i) acc[i] = 0.f;
    const float* pw = p.pool_w + (size_t)(l * 4 + g) * 65536; const float* ps = p.pool_scale + l * D + g * 256; const float* wb = p.w_branch + (size_t)(l * 3) * D * D + (size_t)(g * 256) * D;
#pragma unroll 1
    for (int c0 = 0; c0 < 256; c0 += 64) {
        __syncthreads();
#pragma unroll
        for (int i = 0; i < 16; ++i) { const int id = tid + 256 * i, kl = id >> 6, c = id & 63; P[c * 64 + kl] = pw[(size_t)(kl0 + kl) * 256 + c0 + c] * ps[c0 + c]; }
#pragma unroll
        for (int i = 0; i < 16; ++i) { const int id = tid + 256 * i, c = id >> 6, nn = id & 63; W[c * 64 + nn] = wb[(size_t)(c0 + c) * D + n0 + nn]; }
        __syncthreads();
#pragma unroll 4
        for (int c = 0; c < 64; ++c) {
            const float w = W[c * 64 + n];
#pragma unroll
            for (int q = 0; q < 4; ++q) { const f32x4 pv = *(const f32x4*)(P + c * 64 + kq * 16 + q * 4); acc[q * 4] += pv[0] * w; acc[q * 4 + 1] += pv[1] * w; acc[q * 4 + 2] += pv[2] * w; acc[q * 4 + 3] += pv[3] * w; }
        }
    }
    bf16_t* o = p.w_br_t + (size_t)(l * 3) * D * D + (size_t)(n0 + n) * D + g * 256 + kl0 + kq * 16;
    uint4 q0, q1;
    q0.x = pack2(acc[0], acc[1]); q0.y = pack2(acc[2], acc[3]); q0.z = pack2(acc[4], acc[5]); q0.w = pack2(acc[6], acc[7]);
    q1.x = pack2(acc[8], acc[9]); q1.y = pack2(acc[10], acc[11]); q1.z = pack2(acc[12], acc[13]); q1.w = pack2(acc[14], acc[15]);
    ((uint4*)o)[0] = q0; ((uint4*)o)[1] = q1;
}
constexpr int N_TAB_CS = 512, N_TAB_A = 4096, N_TAB_B = 256, N_TAB_C = 512, N_TABLE = N_TAB_CS + N_TAB_A + N_TAB_B + N_TAB_C;
__device__ __forceinline__ void stage_table(PRef p, int item) {
    const float TWO_PI = 6.283185307179586f;
    if (item < N_TAB_CS) {
        const int idx = item * 256 + tidx(), m = idx >> 9, kk = idx & 511, ro = kk >> 8, c = kk & 255;
        const float ang = TWO_PI * (float)((m * c) & 255) * (1.0f / 256.0f);
        p.cs_t[idx] = f2bf((ro ? sinf(ang) : cosf(ang)) * 0.0625f); return;
    }
    item -= N_TAB_CS;
    if (item < N_TAB_A) {
        const int idx = item * 256 + tidx(), n2 = idx >> 13, rA = (idx >> 6) & 127, n1 = idx & 63, k1 = rA >> 1, ri = rA & 1;
        const float ang = TWO_PI * (float)((k1 * (128 * n1 + n2)) & 8191) * (1.0f / 8192.0f);
        p.tabA[idx] = f2bf((ri ? -sinf(ang) : cosf(ang)) * 0.011048543456039806f); return;
    }
    item -= N_TAB_A;
    if (item < N_TAB_B) {
        const int idx = item * 256 + tidx(), rB = idx >> 8, j = idx & 255, k2 = rB >> 1, ro = rB & 1, n2 = j >> 1, ri = j & 1;
        const float ang = TWO_PI * (float)((k2 * n2) & 127) * (1.0f / 128.0f);
        const float cs = cosf(ang), sn = sinf(ang);
        p.tabB[idx] = f2bf(ro == 0 ? (ri == 0 ? cs : sn) : (ri == 0 ? -sn : cs)); return;
    }
    item -= N_TAB_B;
    {
        const int idx = item * 256 + tidx(), half = idx >> 16, rC = (idx >> 8) & 255, n = idx & 255, k = half * 128 + (rC >> 1), ro = rC & 1;
        const float ang = TWO_PI * (float)((k * n) & 255) * (1.0f / 256.0f);
        p.tabC[idx] = f2bf((ro ? -sinf(ang) : cosf(ang)) * 0.0625f);
    }
}
constexpr int N_ADA = DEPTH * 6144 / 32;
__device__ __forceinline__ void stage_ada(PRef p, int item, char* lds) {
    float* sc = (float*)lds;
    float* part = sc + 3 * D;
    const int tid = tidx();
    __syncthreads();
    for (int i = tid; i < 3 * D; i += 256) { const int r = i / D, k = i % D; const float v = r < 2 ? p.c[r * D + k] : p.c_ctx[k]; sc[i] = siluf_(v); }
    __syncthreads();
    const int l = item / 192, cl = tid & 31, kg = tid >> 5, col = (item % 192) * 32 + cl;
    const float* w = p.w_ada + (size_t)l * D * 6144 + (size_t)(kg * 128) * 6144 + col;
    float a0 = 0.f, a1 = 0.f, a2 = 0.f;
#pragma unroll 16
    for (int k = 0; k < 128; ++k) { const float wv = w[(size_t)k * 6144]; a0 += sc[kg * 128 + k] * wv; a1 += sc[D + kg * 128 + k] * wv; a2 += sc[2 * D + kg * 128 + k] * wv; }
    part[(kg * 3 + 0) * 32 + cl] = a0; part[(kg * 3 + 1) * 32 + cl] = a1; part[(kg * 3 + 2) * 32 + cl] = a2;
    __syncthreads();
    if (tid < 96) { const int r = tid >> 5, c2 = tid & 31; float s = p.b_ada[l * 6144 + (item % 192) * 32 + c2];
#pragma unroll
        for (int g = 0; g < 8; ++g) s += part[(g * 3 + r) * 32 + c2];
        p.mod[(size_t)(l * 3 + r) * 6144 + (item % 192) * 32 + c2] = s; }
}

constexpr int N_ROWNORM = T / 4;
template <int MODE>
__device__ __forceinline__ void stage_rownorm(PRef p, int layer, int item) {
    const int wave = tidx() >> 6, lane = tidx() & 63, row = item * 4 + wave, mrow = modrow(row);
    const float* src = MODE == 0 ? (row < TL ? p.x + (size_t)row * D : p.ctx + (size_t)(row - TL) * D) : p.res + (size_t)row * D;
    f32x4 v[4];
#pragma unroll
    for (int j = 0; j < 4; ++j) v[j] = *(const f32x4*)(src + 4 * lane + 256 * j);
    if (MODE >= 1) {
        const int pl = MODE == 1 ? layer - 1 : layer;
        const float* g2 = modp(p, pl, mrow, 5);
#pragma unroll
        for (int j = 0; j < 4; ++j) {
            const int k = 4 * lane + 256 * j; f32x4 s = {0.f, 0.f, 0.f, 0.f};
#pragma unroll
            for (int kk = 0; kk < 4; ++kk) { const uint2 q = *(const uint2*)(p.sout + ((size_t)row * 4 + kk) * D + k); s[0] += lo16(q.x); s[1] += hi16(q.x); s[2] += lo16(q.y); s[3] += hi16(q.y); }
            const f32x4 g = *(const f32x4*)(g2 + k); v[j] += g * s;
        }
    }
    if (MODE != 2) {
#pragma unroll
        for (int j = 0; j < 4; ++j) *(f32x4*)(p.res + (size_t)row * D + 4 * lane + 256 * j) = v[j];
    }
    float ss = 0.f;
#pragma unroll
    for (int j = 0; j < 4; ++j) ss += v[j][0] * v[j][0] + v[j][1] * v[j][1] + v[j][2] * v[j][2] + v[j][3] * v[j][3];
    ss = wave_sum(ss);
    const float rinv = rsqrtf(ss * (1.0f / D) + RMS_EPS);
    if (MODE == 2) {
        if (row < TL) {
#pragma unroll
            for (int j = 0; j < 4; ++j) { const int k = 4 * lane + 256 * j; const f32x4 w = *(const f32x4*)(p.final_norm_w + k); *(f32x4*)(p.out + (size_t)row * D + k) = v[j] * rinv * w; }
        }
    } else {
        const float* nw = p.norm1_w + layer * D; const float* sh = modp(p, layer, mrow, 0); const float* sc = modp(p, layer, mrow, 1);
#pragma unroll
        for (int j = 0; j < 4; ++j) {
            const int k = 4 * lane + 256 * j;
            const f32x4 w = *(const f32x4*)(nw + k), a = *(const f32x4*)(sc + k), b = *(const f32x4*)(sh + k);
            const f32x4 hv = v[j] * rinv * w * (a + 1.0f) + b;
            uint2 q; q.x = pack2(hv[0], hv[1]); q.y = pack2(hv[2], hv[3]);
            *(uint2*)(p.h + (size_t)row * D + k) = q;
        }
    }
}

struct GemmSrc { const bf16_t* a[4]; const bf16_t* b[4]; };
__device__ __forceinline__ void gemm_stage(const GemmSrc& s, int kt, char* buf, int tid) {
#pragma unroll
    for (int i = 0; i < 4; ++i) {
        __builtin_amdgcn_global_load_lds((const unsigned*)(s.a[i] + kt), (unsigned*)(buf + i * 4096 + tid * 16), 16, 0, 0);
        __builtin_amdgcn_global_load_lds((const unsigned*)(s.b[i] + kt), (unsigned*)(buf + 16384 + i * 4096 + tid * 16), 16, 0, 0);
    }
}
__device__ __forceinline__ void gemm_kloop(f32x4 (&acc)[4][4], const GemmSrc& s, int K, char* lds) {
    const int tid = tidx(), wid = tid >> 6, lane = tid & 63, wr = wid >> 1, wc = wid & 1, fr = lane & 15, fq = lane >> 4;
    const int rsw = fr & 7;
    const int offA = (wr * 64 + fr) * 128, offB = 16384 + (wc * 64 + fr) * 128;
    const int c0 = ((0 + fq) ^ rsw) * 16, c1 = ((4 + fq) ^ rsw) * 16;
    asm volatile("s_waitcnt lgkmcnt(0)" ::: "memory");
    __builtin_amdgcn_s_barrier();
    asm volatile("" ::: "memory");
    gemm_stage(s, 0, lds, tid);
    asm volatile("s_waitcnt vmcnt(0)" ::: "memory");
    __syncthreads();
    int cur = 0;
    for (int kt = 0; kt < K; kt += 64) {
        char* buf = lds + cur * 32768;
        if (kt + 64 < K) gemm_stage(s, kt + 64, lds + (cur ^ 1) * 32768, tid);
#pragma unroll
        for (int ks = 0; ks < 2; ++ks) {
            const int cc = ks ? c1 : c0;
            bf16x8 af[4], bfr[4];
#pragma unroll
            for (int m = 0; m < 4; ++m) af[m] = *(const bf16x8*)(buf + offA + m * 2048 + cc);
#pragma unroll
            for (int n = 0; n < 4; ++n) bfr[n] = *(const bf16x8*)(buf + offB + n * 2048 + cc);
#pragma unroll
            for (int m = 0; m < 4; ++m)
#pragma unroll
                for (int n = 0; n < 4; ++n) acc[m][n] = __builtin_amdgcn_mfma_f32_16x16x32_bf16(bfr[n], af[m], acc[m][n], 0, 0, 0);
        }
        asm volatile("s_waitcnt vmcnt(0)" ::: "memory");
        __syncthreads();
        cur ^= 1;
    }
}
template <int MR> struct GemmSrcT { const bf16_t* a[MR / 2]; const bf16_t* b[2]; };
template <int MR>
__device__ __forceinline__ void gemm_stage_t(const GemmSrcT<MR>& s, int kt, char* buf, int tid) {
#pragma unroll
    for (int i = 0; i < MR / 2; ++i) __builtin_amdgcn_global_load_lds((const unsigned*)(s.a[i] + kt), (unsigned*)(buf + i * 4096 + tid * 16), 16, 0, 0);
#pragma unroll
    for (int i = 0; i < 2; ++i) __builtin_amdgcn_global_load_lds((const unsigned*)(s.b[i] + kt), (unsigned*)(buf + MR * 2048 + i * 4096 + tid * 16), 16, 0, 0);
}
template <int N> __device__ __forceinline__ void wait_vmcnt() { asm volatile("s_waitcnt vmcnt(%0)" :: "n"(N) : "memory"); }
template <int MR>
__device__ __forceinline__ void gemm_kloop_t(f32x4 (&acc)[MR][4], const GemmSrcT<MR>& s, int K, char* lds) {
    constexpr int NBUF = (MR == 8) ? 3 : 4, P = NBUF - 1, L = MR / 2 + 2, BUFB = MR * 2048 + 8192;
    const int tid = tidx(), wid = tid >> 6, lane = tid & 63, wr = wid >> 1, wc = wid & 1, fr = lane & 15, fq = lane >> 4;
    const int cc = (fq ^ ((-(fr >> 2)) & 3)) * 16;
    const int offA = (wr * (MR * 16) + fr) * 64 + cc, offB = MR * 2048 + (wc * 64 + fr) * 64 + cc;
    const int nk = K >> 5;
    asm volatile("s_waitcnt lgkmcnt(0)" ::: "memory");
    __builtin_amdgcn_s_barrier();
    asm volatile("" ::: "memory");
#pragma unroll
    for (int i = 0; i < P; ++i) if (i < nk) gemm_stage_t<MR>(s, i * 32, lds + i * BUFB, tid);
    int cur = 0, nxt = P;
#pragma unroll 1
    for (int k = 0; k < nk; ++k) {
        const int rem = nk - 1 - k;
        if (P >= 3 && rem >= 2) wait_vmcnt<2 * L>(); else if (rem >= 1) wait_vmcnt<L>(); else wait_vmcnt<0>();
        __builtin_amdgcn_s_barrier();
        asm volatile("" ::: "memory");
        const char* buf = lds + cur * BUFB;
        bf16x8 af[MR], bfr[4];
#pragma unroll
        for (int n = 0; n < 4; ++n) bfr[n] = *(const bf16x8*)(buf + offB + n * 1024);
#pragma unroll
        for (int m = 0; m < MR; ++m) af[m] = *(const bf16x8*)(buf + offA + m * 1024);
        __builtin_amdgcn_sched_barrier(0);
        if (k + P < nk) gemm_stage_t<MR>(s, (k + P) * 32, lds + nxt * BUFB, tid);
        __builtin_amdgcn_sched_barrier(0);
#pragma unroll
        for (int m = 0; m < MR; ++m)
#pragma unroll
            for (int n = 0; n < 4; ++n) acc[m][n] = __builtin_amdgcn_mfma_f32_16x16x32_bf16(bfr[n], af[m], acc[m][n], 0, 0, 0);
        cur = (cur + 1 == NBUF) ? 0 : cur + 1; nxt = (nxt + 1 == NBUF) ? 0 : nxt + 1;
    }
}
__device__ __forceinline__ void gemm_kloop2(f32x4 (&acc)[8][4], const GemmSrcT<8>& s, int K, char* lds) { gemm_kloop_t<8>(acc, s, K, lds); }
typedef GemmSrcT<8> GemmSrc2;
__device__ __forceinline__ void zero_acc2(f32x4 (&acc)[8][4]) {
#pragma unroll
    for (int m = 0; m < 8; ++m)
#pragma unroll
        for (int n = 0; n < 4; ++n) acc[m][n] = (f32x4){0.f, 0.f, 0.f, 0.f};
}
#define GEMM2_LANE_VARS const int tid = tidx(), wid = tid >> 6, lane = tid & 63, wr = wid >> 1, wc = wid & 1, fr = lane & 15, fq = lane >> 4; (void)wr; (void)wc; (void)fr; (void)fq; \
    const int br0 = tid >> 2, bc = ((tid & 3) ^ ((-(tid >> 4)) & 3)) * 8;
__device__ __forceinline__ int brow(int r) { return (r & ~63) | (((r >> 2) & 3) << 4) | (((r >> 4) & 3) << 2) | (r & 3); }
__device__ __forceinline__ void pack16(const f32x4 (&v)[4], uint4& q0, uint4& q1) {
    q0.x = pack2(v[0][0], v[0][1]); q0.y = pack2(v[0][2], v[0][3]); q0.z = pack2(v[1][0], v[1][1]); q0.w = pack2(v[1][2], v[1][3]);
    q1.x = pack2(v[2][0], v[2][1]); q1.y = pack2(v[2][2], v[2][3]); q1.z = pack2(v[3][0], v[3][1]); q1.w = pack2(v[3][2], v[3][3]); }
__device__ __forceinline__ void zero_acc(f32x4 (&acc)[4][4]) {
#pragma unroll
    for (int m = 0; m < 4; ++m)
#pragma unroll
        for (int n = 0; n < 4; ++n) acc[m][n] = (f32x4){0.f, 0.f, 0.f, 0.f};
}
#define GEMM_LANE_VARS const int tid = tidx(), wid = tid >> 6, lane = tid & 63, wr = wid >> 1, wc = wid & 1, fr = lane & 15, fq = lane >> 4; (void)wr; (void)wc; (void)fr; (void)fq; \
    const int ar0 = tid >> 3, ac = ((tid & 7) ^ (ar0 & 7)) * 8;

constexpr int NM_T = T / 128, NM2 = T / 256, N_INPROJ = ((NM2 + 7) / 8) * 8 * 65;
__device__ __forceinline__ void stage_inproj(PRef p, int layer, int item, char* lds) {
    GEMM2_LANE_VARS
    const int grp = item / (8 * 65), w = item % (8 * 65);
    int mt, nt;
    { const int gsz = (NM2 - grp * 8) < 8 ? (NM2 - grp * 8) : 8; mt = grp * 8 + (w % gsz); nt = w / gsz; }
    if (nt >= 65) return;
    const bf16_t* A = p.h + (size_t)(mt * 256) * D; const bf16_t* B = p.w_in_t + ((size_t)layer * WIN_ROWS + nt * 128) * D;
    f32x4 acc[8][4]; zero_acc2(acc);
    { GemmSrc2 s;
#pragma unroll
      for (int i = 0; i < 4; ++i) s.a[i] = A + (size_t)(br0 + 64 * i) * D + bc;
#pragma unroll
      for (int i = 0; i < 2; ++i) s.b[i] = B + (size_t)brow(br0 + 64 * i) * D + bc;
      gemm_kloop2(acc, s, D, lds); }
#pragma unroll
    for (int m = 0; m < 8; ++m) {
        const int row = mt * 256 + wr * 128 + m * 16 + fr;
        if (nt < 64) {
            const int gc = nt * 128 + wc * 64 + 16 * fq;
            f32x4 v[4];
#pragma unroll
            for (int n = 0; n < 4; ++n) { v[n] = acc[m][n]; if (gc >= U_GATE) { v[n][0] = sigmoidf_(v[n][0]); v[n][1] = sigmoidf_(v[n][1]); v[n][2] = sigmoidf_(v[n][2]); v[n][3] = sigmoidf_(v[n][3]); } }
            uint4 q0, q1; pack16(v, q0, q1);
            uint4* o = (uint4*)(p.U + (size_t)row * UC + gc); o[0] = q0; o[1] = q1;
        } else if (wc == 0 && fq < 2) {
#pragma unroll
            for (int n = 0; n < 4; ++n) {
                const int cl = 16 * fq + 4 * n; const f32x4 b = *(const f32x4*)(p.dt_bias + layer * 32 + cl); const f32x4 v = acc[m][n];
                f32x4 o; o[0] = softplusf_(v[0] + b[0]); o[1] = softplusf_(v[1] + b[1]); o[2] = softplusf_(v[2] + b[2]); o[3] = softplusf_(v[3] + b[3]);
                *(f32x4*)(p.dt + (size_t)row * 32 + cl) = o;
            }
        }
    }
}
constexpr int N_G1024 = NM_T * 8;
template <int MODE>
__device__ __forceinline__ void stage_gemm_small(PRef p, int layer, int item, char* lds) {
    GEMM_LANE_VARS
    const int mt = item >> 3, nt = item & 7, g = nt >> 1;
    const bf16_t *A, *B; int lda, ldb, K;
    if (MODE == 0) { A = p.Dp + (size_t)(mt * 128) * D + g * 256; lda = D; K = 256; ldb = 256; B = p.pool_w_t + (size_t)(layer * 4 + g) * 65536 + (size_t)((nt & 1) * 128) * 256; }
    else           { A = p.Yb + (size_t)(mt * 128) * 2048 + g * 512; lda = 2048; K = 512; ldb = 512; B = p.cs_t + (size_t)((nt & 1) * 128) * 512; }
    f32x4 acc[4][4]; zero_acc(acc);
    { GemmSrc s;
#pragma unroll
      for (int i = 0; i < 4; ++i) { s.a[i] = A + (size_t)(ar0 + 32 * i) * lda + ac; s.b[i] = B + (size_t)brow(ar0 + 32 * i) * ldb + ac; }
      gemm_kloop(acc, s, K, lds); }
    bf16_t* O = MODE == 0 ? p.ya : p.yb;
#pragma unroll
    for (int m = 0; m < 4; ++m) {
        const int row = mt * 128 + wr * 64 + m * 16 + fr, col = nt * 128 + wc * 64 + 16 * fq;
        f32x4 v[4];
#pragma unroll
        for (int n = 0; n < 4; ++n) { v[n] = acc[m][n]; if (MODE == 0) v[n] *= *(const f32x4*)(p.pool_scale + layer * D + col + 4 * n); }
        uint4 q0, q1; pack16(v, q0, q1);
        uint4* o = (uint4*)(O + (size_t)row * D + col); o[0] = q0; o[1] = q1;
    }
}
__device__ __forceinline__ void stage_merge(PRef p, int layer, int item, char* lds) {
    GEMM_LANE_VARS
    const int mt = item >> 3, nt = item & 7;
    f32x4 macc[4][4]; zero_acc(macc);
#pragma unroll 1
    for (int k = 0; k < 3; ++k) {
        const bf16_t* A = (k == 0 ? p.Dp : (k == 1 ? p.yb : p.yc)) + (size_t)(mt * 128) * D;
        const bf16_t* B = p.w_br_t + ((size_t)(layer * 3 + k) * D + nt * 128) * D;
        f32x4 acc[4][4]; zero_acc(acc);
        { GemmSrc s;
#pragma unroll
          for (int i = 0; i < 4; ++i) { s.a[i] = A + (size_t)(ar0 + 32 * i) * D + ac; s.b[i] = B + (size_t)brow(ar0 + 32 * i) * D + ac; }
          gemm_kloop(acc, s, D, lds); }
#pragma unroll
        for (int m = 0; m < 4; ++m) {
            const int row = mt * 128 + wr * 64 + m * 16 + fr, col = nt * 128 + wc * 64 + 16 * fq;
            float rs = 1.0f;
            if (k == 2) { const f32x4* sq = (const f32x4*)(p.ssq + (size_t)row * 16); const f32x4 t = sq[0] + sq[1] + sq[2] + sq[3]; rs = rsqrtf((t[0] + t[1] + t[2] + t[3]) * (1.0f / D) + RMS_EPS); }
            const uint4* gp = (const uint4*)(p.U + (size_t)row * UC + U_GATE + k * D + col);
            const uint4 g0 = gp[0], g1 = gp[1];
            const unsigned gw[8] = {g0.x, g0.y, g0.z, g0.w, g1.x, g1.y, g1.z, g1.w};
#pragma unroll
            for (int n = 0; n < 4; ++n) {
                macc[m][n][0] += lo16(gw[2 * n]) * rs * acc[m][n][0]; macc[m][n][1] += hi16(gw[2 * n]) * rs * acc[m][n][1];
                macc[m][n][2] += lo16(gw[2 * n + 1]) * rs * acc[m][n][2]; macc[m][n][3] += hi16(gw[2 * n + 1]) * rs * acc[m][n][3];
            }
        }
    }
#pragma unroll
    for (int m = 0; m < 4; ++m) {
        const int row = mt * 128 + wr * 64 + m * 16 + fr, col = nt * 128 + wc * 64 + 16 * fq;
        uint4 q0, q1; pack16(macc[m], q0, q1);
        uint4* o = (uint4*)(p.m + (size_t)row * D + col); o[0] = q0; o[1] = q1;
    }
}
__device__ __forceinline__ void stage_outproj(PRef p, int layer, int item, char* lds) {
    GEMM_LANE_VARS
    const int mt = item >> 3, nt = item & 7;
    const bf16_t* A = p.m + (size_t)(mt * 128) * D; const bf16_t* B = p.w_out_t + ((size_t)layer * D + nt * 128) * D;
    f32x4 acc[4][4]; zero_acc(acc);
    { GemmSrc s;
#pragma unroll
      for (int i = 0; i < 4; ++i) { s.a[i] = A + (size_t)(ar0 + 32 * i) * D + ac; s.b[i] = B + (size_t)brow(ar0 + 32 * i) * D + ac; }
      gemm_kloop(acc, s, D, lds); }
#pragma unroll
    for (int m = 0; m < 4; ++m) {
        const int row = mt * 128 + wr * 64 + m * 16 + fr, col = nt * 128 + wc * 64 + 16 * fq; const float* g1 = modp(p, layer, modrow(row), 2) + col;
        float* r = p.res + (size_t)row * D + col;
#pragma unroll
        for (int n = 0; n < 4; ++n) { const f32x4 g = *(const f32x4*)(g1 + 4 * n); *(f32x4*)(r + 4 * n) = *(const f32x4*)(r + 4 * n) + g * acc[m][n]; }
    }
}
__device__ __forceinline__ int ld_cnt(PRef p, int i) { return __hip_atomic_load(p.cnt + i, __ATOMIC_RELAXED, __HIP_MEMORY_SCOPE_AGENT); }
struct MoeTile { int e, mt, nt, cnt, off; };
__device__ __forceinline__ void moe_scan(PRef p, int layer, int& c, int& mtn, int& pm, int& pc) {
    const int lane = tidx() & 63, l31 = lane & 31;
    c = __hip_atomic_load(p.cnt + layer * NE + l31, __ATOMIC_RELAXED, __HIP_MEMORY_SCOPE_AGENT);
    mtn = (c + 255) >> 8; pm = mtn; pc = c;
#pragma unroll
    for (int o = 1; o < 32; o <<= 1) {
        const int src = ((lane - o) & 63) * 4;
        const int um = __builtin_amdgcn_ds_bpermute(src, pm), uc = __builtin_amdgcn_ds_bpermute(src, pc);
        if (l31 >= o) { pm += um; pc += uc; }
    }
}
template <int NT>
__device__ __forceinline__ bool moe_decode(PRef p, int layer, int item, MoeTile& t) {
    const int mg = item / NT; t.nt = item % NT;
    int c, mtn, pm, pc; moe_scan(p, layer, c, mtn, pm, pc);
    const int e = __popcll(__ballot(pm <= mg) & 0xffffffffull);
    if (e >= NE) return false;
    t.e = e; t.cnt = __builtin_amdgcn_readlane(c, e);
    t.mt = mg - __builtin_amdgcn_readlane(pm - mtn, e); t.off = __builtin_amdgcn_readlane(pc - c, e);
    return true;
}
__device__ __forceinline__ int moe_total_mtiles(PRef p, int layer) { int c, mtn, pm, pc; moe_scan(p, layer, c, mtn, pm, pc); return __builtin_amdgcn_readlane(pm, 31); }
__device__ __forceinline__ void stage_moe1(PRef p, int layer, int item, char* lds) {
    GEMM2_LANE_VARS
    MoeTile t; if (!moe_decode<16>(p, layer, item, t)) return;
    const int* lst = p.list + (size_t)(layer * NE + t.e) * T;
    const bf16_t* B = p.w1_t + ((size_t)(layer * NE + t.e) * 2048 + t.nt * 128) * D;
    f32x4 acc[8][4]; zero_acc2(acc);
    { GemmSrc2 s;
#pragma unroll
      for (int i = 0; i < 4; ++i) { const int ii = t.mt * 256 + br0 + 64 * i; const int tok = lst[ii < t.cnt ? ii : t.cnt - 1] >> 2; s.a[i] = p.h + (size_t)tok * D + bc; }
#pragma unroll
      for (int i = 0; i < 2; ++i) s.b[i] = B + (size_t)brow(br0 + 64 * i) * D + bc;
      gemm_kloop2(acc, s, D, lds); }
    const float* b1 = p.moe_b1 + (size_t)(layer * NE + t.e) * 2048;
#pragma unroll
    for (int m = 0; m < 8; ++m) {
        const int i = t.mt * 256 + wr * 128 + m * 16 + fr;
        if (i < t.cnt) {
            const int gc = t.nt * 64 + wc * 32 + 8 * fq;
            float o[8];
#pragma unroll
            for (int n = 0; n < 2; ++n) {
                const f32x4 bg = *(const f32x4*)(b1 + gc + 4 * n), bl = *(const f32x4*)(b1 + 1024 + gc + 4 * n);
#pragma unroll
                for (int j = 0; j < 4; ++j) {
                    const float g = fminf(acc[m][n][j] + bg[j], 7.0f), l = fminf(fmaxf(acc[m][n + 2][j] + bl[j], -7.0f), 7.0f);
                    o[4 * n + j] = g * sigmoidf_(1.702f * g) * (l + 1.0f);
                }
            }
            uint4 q; q.x = pack2(o[0], o[1]); q.y = pack2(o[2], o[3]); q.z = pack2(o[4], o[5]); q.w = pack2(o[6], o[7]);
            *(uint4*)(p.act + (size_t)(t.off + i) * D + gc) = q;
        }
    }
}
__device__ __forceinline__ void stage_moe2(PRef p, int layer, int item, char* lds) {
    GEMM2_LANE_VARS
    MoeTile t; if (!moe_decode<8>(p, layer, item, t)) return;
    const int* lst = p.list + (size_t)(layer * NE + t.e) * T;
    const bf16_t* B = p.w2_t + ((size_t)(layer * NE + t.e) * D + t.nt * 128) * D;
    f32x4 acc[8][4]; zero_acc2(acc);
    { GemmSrc2 s;
#pragma unroll
      for (int i = 0; i < 4; ++i) { const int ii = t.mt * 256 + br0 + 64 * i; s.a[i] = p.act + (size_t)(t.off + (ii < t.cnt ? ii : t.cnt - 1)) * D + bc; }
#pragma unroll
      for (int i = 0; i < 2; ++i) s.b[i] = B + (size_t)brow(br0 + 64 * i) * D + bc;
      gemm_kloop2(acc, s, D, lds); }
    const float* b2 = p.moe_b2 + (size_t)(layer * NE + t.e) * D;
#pragma unroll
    for (int m = 0; m < 8; ++m) {
        const int i = t.mt * 256 + wr * 128 + m * 16 + fr;
        if (i < t.cnt) {
            const int pair = lst[i]; const float w = p.topw[pair]; const int col = t.nt * 128 + wc * 64 + 16 * fq;
            f32x4 v[4];
#pragma unroll
            for (int n = 0; n < 4; ++n) v[n] = (acc[m][n] + *(const f32x4*)(b2 + col + 4 * n)) * w;
            uint4 q0, q1; pack16(v, q0, q1);
            uint4* o = (uint4*)(p.sout + (size_t)pair * D + col); o[0] = q0; o[1] = q1;
        }
    }
}

constexpr int N_CONV = T / 32;
__device__ __forceinline__ void stage_conv(PRef p, int layer, int item) {
    const int c0 = tidx() * 8, r0 = item * 32;
    const int seq0 = r0 < TL ? (r0 / SEQ) * SEQ : TL + ((r0 - TL) / CTXL) * CTXL, seq1 = seq0 + (r0 < TL ? SEQ : CTXL);
    float w[5][8], bias[8];
#pragma unroll
    for (int j = 0; j < 5; ++j) { const f32x4 a = *(const f32x4*)(p.conv_w + (size_t)(layer * 5 + j) * 2048 + c0), b = *(const f32x4*)(p.conv_w + (size_t)(layer * 5 + j) * 2048 + c0 + 4);
        w[j][0] = a[0]; w[j][1] = a[1]; w[j][2] = a[2]; w[j][3] = a[3]; w[j][4] = b[0]; w[j][5] = b[1]; w[j][6] = b[2]; w[j][7] = b[3]; }
    { const f32x4 a = *(const f32x4*)(p.conv_b + layer * 2048 + c0), b = *(const f32x4*)(p.conv_b + layer * 2048 + c0 + 4);
      bias[0] = a[0]; bias[1] = a[1]; bias[2] = a[2]; bias[3] = a[3]; bias[4] = b[0]; bias[5] = b[1]; bias[6] = b[2]; bias[7] = b[3]; }
    float win[5][8];
    auto ldrow = [&](int r, float (&o)[8]) {
        if (r >= seq0 && r < seq1) { const uint4 q = *(const uint4*)(p.U + (size_t)r * UC + U_XBC + c0);
            o[0] = lo16(q.x); o[1] = hi16(q.x); o[2] = lo16(q.y); o[3] = hi16(q.y); o[4] = lo16(q.z); o[5] = hi16(q.z); o[6] = lo16(q.w); o[7] = hi16(q.w); }
        else {
#pragma unroll
            for (int i = 0; i < 8; ++i) o[i] = 0.f; }
    };
    ldrow(r0 - 2, win[0]); ldrow(r0 - 1, win[1]); ldrow(r0, win[2]); ldrow(r0 + 1, win[3]);
#pragma unroll 8
    for (int r = r0; r < r0 + 32; ++r) {
        ldrow(r + 2, win[4]);
        float o[8];
#pragma unroll
        for (int i = 0; i < 8; ++i) { float s = bias[i];
#pragma unroll
            for (int j = 0; j < 5; ++j) s += w[j][i] * win[j][i];
            o[i] = siluf_(s); }
        uint4 q; q.x = pack2(o[0], o[1]); q.y = pack2(o[2], o[3]); q.z = pack2(o[4], o[5]); q.w = pack2(o[6], o[7]);
        *(uint4*)(p.V + (size_t)r * 2048 + c0) = q;
#pragma unroll
        for (int j = 0; j < 4; ++j)
#pragma unroll
            for (int i = 0; i < 8; ++i) win[j][i] = win[j + 1][i];
    }
}

constexpr int N_POOL_LAT = NB * 4 * 4 * 16, N_POOL = N_POOL_LAT + NB * 4 * 64;
__device__ __forceinline__ void pool_acc(const uint2 q, float w, float (&v)[4]) { v[0] += w * lo16(q.x); v[1] += w * hi16(q.x); v[2] += w * lo16(q.y); v[3] += w * hi16(q.y); }
template <int W>
__device__ __forceinline__ void pool_lat(PRef p, int g, int b, int band, int c, int lane) {
    constexpr int lo = -(W >> 1), hi = W - (W >> 1) - 1;
    const int r0 = band * 32, cc0 = max(c + lo, 0), cc1 = min(c + hi, 63), ncol = cc1 - cc0 + 1;
    const bf16_t* base = p.U + (size_t)(b * SEQ) * UC + g * 256 + lane * 4;
    float vs[4] = {0.f, 0.f, 0.f, 0.f};
    auto addH = [&](int rr, float sg) {
        const bool rv = rr >= 0 && rr <= 127; const int rc = min(max(rr, 0), 127);
        uint2 q[W];
#pragma unroll
        for (int i = 0; i < W; ++i) { const int cc = min(cc0 + i, 63); q[i] = *(const uint2*)(base + (size_t)(rc * 64 + cc) * UC); }
#pragma unroll
        for (int i = 0; i < W; ++i) pool_acc(q[i], (rv && i < ncol) ? sg : 0.f, vs);
    };
#pragma unroll 1
    for (int rr = r0 + lo; rr <= r0 + hi; ++rr) addH(rr, 1.0f);
#pragma unroll 1
    for (int r = r0; r < r0 + 32; ++r) {
        const int rlo = max(r + lo, 0), rhi = min(r + hi, 127);
        const float inv = 1.0f / (float)((rhi - rlo + 1) * ncol);
        const uint2 sq = *(const uint2*)(base + (size_t)(r * 64 + c) * UC);
        uint2 q; q.x = pack2(vs[0] * inv - lo16(sq.x), vs[1] * inv - hi16(sq.x)); q.y = pack2(vs[2] * inv - lo16(sq.y), vs[3] * inv - hi16(sq.y));
        *(uint2*)(p.Dp + (size_t)(b * SEQ + r * 64 + c) * D + g * 256 + lane * 4) = q;
        {
            const int ra = r + lo, rb = r + 1 + hi;
            const bool va = ra >= 0, vb = rb <= 127; const int rac = max(ra, 0), rbc = min(rb, 127);
            uint2 qa[W], qb[W];
#pragma unroll
            for (int i = 0; i < W; ++i) { const int cc = min(cc0 + i, 63); qa[i] = *(const uint2*)(base + (size_t)(rac * 64 + cc) * UC); qb[i] = *(const uint2*)(base + (size_t)(rbc * 64 + cc) * UC); }
#pragma unroll
            for (int i = 0; i < W; ++i) { pool_acc(qa[i], (va && i < ncol) ? -1.0f : 0.f, vs); pool_acc(qb[i], (vb && i < ncol) ? 1.0f : 0.f, vs); }
        }
    }
}
__device__ __forceinline__ void stage_pool(PRef p, int item) {
    const int tid = tidx(), wave = tid >> 6, lane = tid & 63;
    if (item < N_POOL_LAT) {
        const int g = 3 - (item >> 7), b = (item >> 6) & 1, band = (item >> 4) & 3, c = (item & 15) * 4 + wave;
        if (g == 3) pool_lat<16>(p, g, b, band, c, lane);
        else if (g == 2) pool_lat<8>(p, g, b, band, c, lane);
        else if (g == 1) pool_lat<4>(p, g, b, band, c, lane);
        else pool_lat<2>(p, g, b, band, c, lane);
    } else {
        const int it = item - N_POOL_LAT, g = 3 - (it >> 7), b = (it >> 6) & 1, n = (it & 63) * 4 + wave;
        const int w = 2 << g, lo = -(w >> 1), hi = w - (w >> 1) - 1, t0 = max(n + lo, 0), t1 = min(n + hi, CTXL - 1);
        const bf16_t* base = p.U + (size_t)(TL + b * CTXL) * UC + g * 256 + lane * 4;
        float s[4] = {0.f, 0.f, 0.f, 0.f};
        uint2 q[16];
#pragma unroll
        for (int i = 0; i < 16; ++i) q[i] = *(const uint2*)(base + (size_t)min(t0 + i, CTXL - 1) * UC);
#pragma unroll
        for (int i = 0; i < 16; ++i) pool_acc(q[i], (t0 + i <= t1) ? 1.0f : 0.f, s);
        const float inv = 1.0f / (float)(t1 - t0 + 1);
        const uint2 sq = *(const uint2*)(base + (size_t)n * UC);
        uint2 o; o.x = pack2(s[0] * inv - lo16(sq.x), s[1] * inv - hi16(sq.x)); o.y = pack2(s[2] * inv - lo16(sq.y), s[3] * inv - hi16(sq.y));
        *(uint2*)(p.Dp + (size_t)(TL + b * CTXL + n) * D + g * 256 + lane * 4) = o;
    }
}

typedef unsigned u32x2 __attribute__((ext_vector_type(2)));
union Frag8 { bf16x8 v; u32x2 h[2]; };
template <int OFF>
__device__ __forceinline__ void tr_frag4(bf16x8 (&f)[4], unsigned a0, unsigned a1, unsigned a2, unsigned a3) {
    Frag8 r0, r1, r2, r3;
    asm volatile("ds_read_b64_tr_b16 %0, %8\n\tds_read_b64_tr_b16 %1, %8 offset:%c12\n\t"
                 "ds_read_b64_tr_b16 %2, %9\n\tds_read_b64_tr_b16 %3, %9 offset:%c12\n\t"
                 "ds_read_b64_tr_b16 %4, %10\n\tds_read_b64_tr_b16 %5, %10 offset:%c12\n\t"
                 "ds_read_b64_tr_b16 %6, %11\n\tds_read_b64_tr_b16 %7, %11 offset:%c12\n\t"
                 "s_waitcnt lgkmcnt(0)"
                 : "=&v"(r0.h[0]), "=&v"(r0.h[1]), "=&v"(r1.h[0]), "=&v"(r1.h[1]), "=&v"(r2.h[0]), "=&v"(r2.h[1]), "=&v"(r3.h[0]), "=&v"(r3.h[1])
                 : "v"(a0), "v"(a1), "v"(a2), "v"(a3), "i"(OFF) : "memory");
    f[0] = r0.v; f[1] = r1.v; f[2] = r2.v; f[3] = r3.v;
}
__device__ __forceinline__ unsigned lds_addr(const void* p) { return (unsigned)(size_t)p; }
constexpr int PBA = 544, N_FOURA = NB * 128 * 4;
__device__ __forceinline__ void stage_fourA(PRef p, int item, char* lds) {
    const int tid = tidx(), wid = tid >> 6, lane = tid & 63, fr = lane & 15, fq = lane >> 4;
    const int b = item >> 9, n2 = (item >> 2) & 127, c0 = (item & 3) * 256;
    const bf16_t* tA = p.tabA + ((size_t)n2 * 128 + fr) * 64 + fq * 8;
    bf16x8 tf[2][8];
#pragma unroll
    for (int rt = 0; rt < 8; ++rt) tf[0][rt] = *(const bf16x8*)(tA + rt * 16 * 64);
    __syncthreads();
#pragma unroll
    for (int i = 0; i < 8; ++i) {
        const int id = tid + 256 * i, r = id >> 5, o = id & 31;
        const uint4 q = *(const uint4*)(p.U + (size_t)(b * SEQ + 128 * r + n2) * UC + U_FOUR + c0 + o * 8);
        *(uint4*)(lds + r * PBA + o * 16) = q;
    }
    __syncthreads();
    f32x4 acc[4][8];
#pragma unroll
    for (int a = 0; a < 4; ++a)
#pragma unroll
        for (int r = 0; r < 8; ++r) acc[a][r] = (f32x4){0.f, 0.f, 0.f, 0.f};
    const unsigned base = lds_addr(lds) + (unsigned)((8 * fq + (fr >> 2)) * PBA + (wid * 64 + 4 * (fr & 3)) * 2);
#pragma unroll
    for (int ks = 0; ks < 2; ++ks) {
        bf16x8 xf[4];
        if (ks == 0) {
#pragma unroll
            for (int rt = 0; rt < 8; ++rt) tf[1][rt] = *(const bf16x8*)(tA + rt * 16 * 64 + 32);
        }
        const unsigned a = base + ks * 32 * PBA;
        tr_frag4<4 * PBA>(xf, a, a + 32, a + 64, a + 96);
#pragma unroll
        for (int ct = 0; ct < 4; ++ct)
#pragma unroll
            for (int rt = 0; rt < 8; ++rt) acc[ct][rt] = __builtin_amdgcn_mfma_f32_16x16x32_bf16(xf[ct], tf[ks][rt], acc[ct][rt], 0, 0, 0);
    }
#pragma unroll
    for (int rt = 0; rt < 8; ++rt) {
        const int rA = rt * 16 + fr, k1 = rA >> 1, ri = rA & 1;
        bf16_t* o = p.Ap + ((size_t)(b * 64 + k1) * 256 + n2 * 2 + ri) * D + c0 + wid * 64 + 4 * fq;
#pragma unroll
        for (int ct = 0; ct < 4; ++ct) { uint2 q; q.x = pack2(acc[ct][rt][0], acc[ct][rt][1]); q.y = pack2(acc[ct][rt][2], acc[ct][rt][3]); *(uint2*)(o + ct * 16) = q; }
    }
}
constexpr int PBB = 288, N_FOURB_LAT = NB * 64 * 8, N_FOURB = N_FOURB_LAT + NB * 2 * 8;
__device__ __forceinline__ void stage_fourB(PRef p, int item, char* lds) {
    const int tid = tidx(), wid = tid >> 6, lane = tid & 63, fr = lane & 15, fq = lane >> 4;
    const bf16_t* xsrc; size_t xpitch; const bf16_t* tab; int orow0, orstep, c0;
    if (item < N_FOURB_LAT) { const int b = item >> 9, k1 = (item >> 3) & 63; c0 = (item & 7) * 128;
        xsrc = p.Ap + (size_t)(b * 64 + k1) * 256 * D + c0; xpitch = D; tab = p.tabB; orow0 = b * SEQ + k1; orstep = 64; }
    else { const int it = item - N_FOURB_LAT, b = it >> 4, half = (it >> 3) & 1; c0 = (it & 7) * 128;
        xsrc = p.U + (size_t)(TL + b * CTXL) * UC + U_FOUR + c0; xpitch = UC; tab = p.tabC + half * 65536; orow0 = TL + b * CTXL + half * 128; orstep = 1; }
    f32x4 acc[8][4];
#pragma unroll
    for (int a = 0; a < 8; ++a)
#pragma unroll
        for (int r = 0; r < 4; ++r) acc[a][r] = (f32x4){0.f, 0.f, 0.f, 0.f};
    const unsigned base = lds_addr(lds) + (unsigned)((8 * fq + (fr >> 2)) * PBB + (4 * (fr & 3)) * 2);
    const bf16_t* tB = tab + (size_t)(wid * 64 + fr) * 256 + fq * 8;
#pragma unroll 1
    for (int kh = 0; kh < 2; ++kh) {
        bf16x8 tf0[4];
#pragma unroll
        for (int rt = 0; rt < 4; ++rt) tf0[rt] = *(const bf16x8*)(tB + rt * 16 * 256 + kh * 128);
        __syncthreads();
#pragma unroll
        for (int i = 0; i < 8; ++i) {
            const int id = tid + 256 * i, r = id >> 4, o = id & 15;
            const uint4 q = *(const uint4*)(xsrc + (size_t)(kh * 128 + r) * xpitch + o * 8);
            *(uint4*)(lds + r * PBB + o * 16) = q;
        }
        __syncthreads();
#pragma unroll
        for (int ks = 0; ks < 4; ++ks) {
            bf16x8 xf[8], tf[4];
#pragma unroll
            for (int rt = 0; rt < 4; ++rt) tf[rt] = tf0[rt];
            if (ks < 3) {
#pragma unroll
                for (int rt = 0; rt < 4; ++rt) tf0[rt] = *(const bf16x8*)(tB + rt * 16 * 256 + kh * 128 + (ks + 1) * 32);
            }
            const unsigned a = base + ks * 32 * PBB;
            { bf16x8 t4[4]; tr_frag4<4 * PBB>(t4, a, a + 32, a + 64, a + 96); xf[0] = t4[0]; xf[1] = t4[1]; xf[2] = t4[2]; xf[3] = t4[3]; }
            { bf16x8 t4[4]; tr_frag4<4 * PBB>(t4, a + 128, a + 160, a + 192, a + 224); xf[4] = t4[0]; xf[5] = t4[1]; xf[6] = t4[2]; xf[7] = t4[3]; }
#pragma unroll
            for (int ct = 0; ct < 8; ++ct)
#pragma unroll
                for (int rt = 0; rt < 4; ++rt) acc[ct][rt] = __builtin_amdgcn_mfma_f32_16x16x32_bf16(xf[ct], tf[rt], acc[ct][rt], 0, 0, 0);
        }
    }
    const int g = c0 >> 8, cg = c0 & 255;
#pragma unroll
    for (int rt = 0; rt < 4; ++rt) {
        const int rB = wid * 64 + rt * 16 + fr, kk = rB >> 1, ro = rB & 1;
        bf16_t* o = p.Yb + (size_t)(orow0 + kk * orstep) * 2048 + g * 512 + ro * 256 + cg + 4 * fq;
#pragma unroll
        for (int ct = 0; ct < 8; ++ct) { uint2 q; q.x = pack2(acc[ct][rt][0], acc[ct][rt][1]); q.y = pack2(acc[ct][rt][2], acc[ct][rt][3]); *(uint2*)(o + ct * 16) = q; }
    }
}

constexpr int NCH = T / 128, N_ACSUM = NCH;
__device__ __forceinline__ void stage_acsum(PRef p, int layer, int item, char* lds) {
    const int tid = tidx(), col = tid & 31, seg = tid >> 5, d = col >> 4, h = col & 15;
    float* part = (float*)lds;
    const float A = -__expf(p.a_log[(layer * 2 + d) * NH + h]);
    float v[16];
#pragma unroll
    for (int i = 0; i < 16; ++i) { const int pos = seg * 16 + i, r = item * 128 + (d == 0 ? pos : 127 - pos); v[i] = p.dt[(size_t)r * 32 + col] * A; }
    float s = 0.f;
#pragma unroll
    for (int i = 0; i < 16; ++i) { s += v[i]; v[i] = s; }
    __syncthreads();
    part[seg * 32 + col] = s;
    __syncthreads();
    float base = 0.f;
#pragma unroll
    for (int j = 0; j < 8; ++j) base += (j < seg) ? part[j * 32 + col] : 0.f;
#pragma unroll
    for (int i = 0; i < 16; ++i) { const int pos = seg * 16 + i, r = item * 128 + (d == 0 ? pos : 127 - pos); p.ac[(size_t)r * 32 + col] = base + v[i]; }
}
template <int OFF>
__device__ __forceinline__ void tr_frag4b(bf16x8 (&f)[4], unsigned a, int step) { tr_frag4<OFF>(f, a, a + step, a + 2 * step, a + 3 * step); }
constexpr int PBS = 288, PXS = 160, N_CSTATE = NCH * NH;
__device__ __forceinline__ void stage_cstate(PRef p, int item, char* lds) {
    const int tid = tidx(), wid = tid >> 6, lane = tid & 63, fr = lane & 15, fq = lane >> 4;
    const int cid = item >> 4, hh = item & 15, g = hh >> 2, row0 = cid * 128;
    char* LB = lds; char* LX = lds + 128 * PBS; float* wgt = (float*)(lds + 128 * PBS + 128 * PXS);
    __syncthreads();
#pragma unroll
    for (int i = 0; i < 8; ++i) { const int id = tid + 256 * i, r = id >> 4, o = id & 15;
        *(uint4*)(LB + r * PBS + o * 16) = *(const uint4*)(p.V + (size_t)(row0 + r) * 2048 + 1024 + g * NS + o * 8); }
#pragma unroll
    for (int i = 0; i < 4; ++i) { const int id = tid + 256 * i, r = id >> 3, o = id & 7;
        *(uint4*)(LX + r * PXS + o * 16) = *(const uint4*)(p.V + (size_t)(row0 + r) * 2048 + hh * HD + o * 8); }
    { const int d = tid >> 7, l = tid & 127; const int col = d * 16 + hh;
      const float tot = p.ac[(size_t)(row0 + (d == 0 ? 127 : 0)) * 32 + col];
      wgt[tid] = p.dt[(size_t)(row0 + l) * 32 + col] * __expf(tot - p.ac[(size_t)(row0 + l) * 32 + col]); }
    __syncthreads();
    const int d = wid >> 1, nh = wid & 1;
    f32x4 acc[4][4];
#pragma unroll
    for (int a = 0; a < 4; ++a)
#pragma unroll
        for (int b = 0; b < 4; ++b) acc[a][b] = (f32x4){0.f, 0.f, 0.f, 0.f};
    const unsigned rowoff = 8 * fq + (fr >> 2), coloff = 4 * (fr & 3);
    const unsigned baseB = lds_addr(LB) + rowoff * PBS + (nh * 64 + coloff) * 2, baseX = lds_addr(LX) + rowoff * PXS + coloff * 2;
#pragma unroll
    for (int ks = 0; ks < 4; ++ks) {
        bf16x8 bt[4], xr[4], xs[4];
        tr_frag4b<4 * PBS>(bt, baseB + ks * 32 * PBS, 32);
        tr_frag4b<4 * PXS>(xr, baseX + ks * 32 * PXS, 32);
        const f32x4 w0 = *(const f32x4*)(wgt + d * 128 + ks * 32 + 8 * fq), w1 = *(const f32x4*)(wgt + d * 128 + ks * 32 + 8 * fq + 4);
#pragma unroll
        for (int pt = 0; pt < 4; ++pt)
#pragma unroll
            for (int e = 0; e < 8; ++e) xs[pt][e] = (short)f2bf(bf2f((bf16_t)xr[pt][e]) * (e < 4 ? w0[e & 3] : w1[e & 3]));
#pragma unroll
        for (int nt = 0; nt < 4; ++nt)
#pragma unroll
            for (int pt = 0; pt < 4; ++pt) acc[nt][pt] = __builtin_amdgcn_mfma_f32_16x16x32_bf16(bt[nt], xs[pt], acc[nt][pt], 0, 0, 0);
    }
    bf16_t* o = p.Scs + ((size_t)((cid * 2 + d) * 16 + hh) * 64) * NS + nh * 64 + 4 * fq;
#pragma unroll
    for (int pt = 0; pt < 4; ++pt)
#pragma unroll
        for (int nt = 0; nt < 4; ++nt) { uint2 q; q.x = pack2(acc[nt][pt][0], acc[nt][pt][1]); q.y = pack2(acc[nt][pt][2], acc[nt][pt][3]);
            *(uint2*)(o + (size_t)(pt * 16 + fr) * NS + nt * 16) = q; }
}
constexpr int N_SCAN = NB * 2 * NH * HD * 16 / 256;
__device__ __forceinline__ void stage_scan(PRef p, int item) {
    const int idx = item * 256 + tidx(), n8 = idx & 15, pp = (idx >> 4) & 63, hh = (idx >> 10) & 15, d = (idx >> 14) & 1, b = idx >> 15;
    float s[8];
#pragma unroll
    for (int i = 0; i < 8; ++i) s[i] = 0.f;
#pragma unroll 4
    for (int t = 0; t < 66; ++t) {
        const int cid = t < 2 ? 128 + b * 2 + (d == 0 ? t : 1 - t) : b * 64 + (d == 0 ? t - 2 : 65 - t);
        const size_t o = ((size_t)((cid * 2 + d) * 16 + hh) * 64 + pp) * NS + n8 * 8;
        uint4 q; q.x = pack2(s[0], s[1]); q.y = pack2(s[2], s[3]); q.z = pack2(s[4], s[5]); q.w = pack2(s[6], s[7]);
        *(uint4*)(p.Sst + o) = q;
        const uint4 c = *(const uint4*)(p.Scs + o);
        const float dec = __expf(p.ac[(size_t)(cid * 128 + (d == 0 ? 127 : 0)) * 32 + d * 16 + hh]);
        s[0] = s[0] * dec + lo16(c.x); s[1] = s[1] * dec + hi16(c.x); s[2] = s[2] * dec + lo16(c.y); s[3] = s[3] * dec + hi16(c.y);
        s[4] = s[4] * dec + lo16(c.z); s[5] = s[5] * dec + hi16(c.z); s[6] = s[6] * dec + lo16(c.w); s[7] = s[7] * dec + hi16(c.w);
    }
}
constexpr int N_SSDOUT = 128 * 4 + 4 * 4 * 4;
__device__ __forceinline__ void stage_ssdout(PRef p, int layer, int item, char* lds) {
    const int tid = tidx(), wid = tid >> 6, lane = tid & 63, fr = lane & 15, fq = lane >> 4;
    int cid, g, h0, nh;
    if (item < 512) { cid = item >> 2; g = item & 3; h0 = 0; nh = 4; } else { const int it = item - 512; cid = 128 + (it >> 4); g = (it >> 2) & 3; h0 = it & 3; nh = 1; }
    const int row0 = cid * 128;
    char* LX = lds; float* acd = (float*)(lds + 128 * PXS); float* dtd = acd + 256;
    char* SB = lds + 128 * PXS + 2048;
    const int srow = tid >> 4, sslot = tid & 15, schunk = (sslot ^ (srow & 15)) * 8;
    __syncthreads();
#pragma unroll
    for (int i = 0; i < 8; ++i) __builtin_amdgcn_global_load_lds((const unsigned*)(p.V + (size_t)(row0 + srow + 16 * i) * 2048 + 1024 + g * NS + schunk), (unsigned*)(SB + i * 4096 + tid * 16), 16, 0, 0);
    bf16x8 cf[2][4];
#pragma unroll
    for (int lt = 0; lt < 2; ++lt)
#pragma unroll
        for (int ks = 0; ks < 4; ++ks) cf[lt][ks] = *(const bf16x8*)(p.V + (size_t)(row0 + wid * 32 + lt * 16 + fr) * 2048 + 1536 + g * NS + ks * 32 + fq * 8);
    asm volatile("s_waitcnt vmcnt(0)" ::: "memory");
    __syncthreads();
    f32x4 cbt[8][2];
#pragma unroll
    for (int st = 0; st < 8; ++st) {
        bf16x8 bfA[4];
#pragma unroll
        for (int ks = 0; ks < 4; ++ks) bfA[ks] = *(const bf16x8*)(SB + (st * 16 + fr) * 256 + (((ks * 4 + fq) ^ fr) * 16));
#pragma unroll
        for (int lt = 0; lt < 2; ++lt) { f32x4 a = {0.f, 0.f, 0.f, 0.f};
#pragma unroll
            for (int ks = 0; ks < 4; ++ks) a = __builtin_amdgcn_mfma_f32_16x16x32_bf16(bfA[ks], cf[lt][ks], a, 0, 0, 0);
            cbt[st][lt] = a; }
    }
    const unsigned baseX = lds_addr(LX) + (4 * fq + (fr >> 2)) * PXS + 4 * (fr & 3) * 2;
#pragma unroll 1
    for (int hi = h0; hi < h0 + nh; ++hi) {
        const int hh = g * 4 + hi;
        float ssq[2] = {0.f, 0.f};
        __syncthreads();
        { const int t2 = tidx(), srow2 = t2 >> 4, schunk2 = ((t2 & 15) ^ (srow2 & 15)) * 8;
#pragma unroll
        for (int d = 0; d < 2; ++d) { const bf16_t* S = p.Sst + ((size_t)((cid * 2 + d) * 16 + hh) * 64) * NS;
#pragma unroll
            for (int i = 0; i < 4; ++i) __builtin_amdgcn_global_load_lds((const unsigned*)(S + (size_t)(srow2 + 16 * i) * NS + schunk2), (unsigned*)(SB + d * 16384 + i * 4096 + t2 * 16), 16, 0, 0); } }
#pragma unroll
        for (int i = 0; i < 4; ++i) { const int id = tid + 256 * i, r = id >> 3, o = id & 7;
            *(uint4*)(LX + r * PXS + o * 16) = *(const uint4*)(p.V + (size_t)(row0 + r) * 2048 + hh * HD + o * 8); }
        { const int d = tid >> 7, l = tid & 127; acd[tid] = p.ac[(size_t)(row0 + l) * 32 + d * 16 + hh]; dtd[tid] = p.dt[(size_t)(row0 + l) * 32 + d * 16 + hh]; }
        asm volatile("s_waitcnt vmcnt(0)" ::: "memory");
        __syncthreads();
        f32x4 yacc[4][2];
#pragma unroll
        for (int pt = 0; pt < 4; ++pt) { yacc[pt][0] = (f32x4){0.f, 0.f, 0.f, 0.f}; yacc[pt][1] = (f32x4){0.f, 0.f, 0.f, 0.f}; }
#pragma unroll
        for (int d = 0; d < 2; ++d) {
            const float el0 = acd[d * 128 + wid * 32 + fr], el1 = acd[d * 128 + wid * 32 + 16 + fr];
#pragma unroll
            for (int ks = 0; ks < 4; ++ks) {
                if (d == 0 ? ks > wid : ks < wid) continue;
                const int s0 = 32 * ks + 4 * fq;
                const f32x4 as0 = *(const f32x4*)(acd + d * 128 + s0), as1 = *(const f32x4*)(acd + d * 128 + s0 + 16);
                const f32x4 ds0 = *(const f32x4*)(dtd + d * 128 + s0), ds1 = *(const f32x4*)(dtd + d * 128 + s0 + 16);
                bf16x8 gf[2];
#pragma unroll
                for (int lt = 0; lt < 2; ++lt) {
                    const int l = wid * 32 + lt * 16 + fr; const float el = lt ? el1 : el0;
#pragma unroll
                    for (int e = 0; e < 4; ++e) {
                        const int sa = s0 + e, sb = s0 + 16 + e;
                        const bool ma = d == 0 ? (sa <= l) : (sa >= l), mb = d == 0 ? (sb <= l) : (sb >= l);
                        const float va = ma ? cbt[2 * ks][lt][e] * __expf(fminf(el - as0[e], 0.f)) * ds0[e] : 0.f;
                        const float vb = mb ? cbt[2 * ks + 1][lt][e] * __expf(fminf(el - as1[e], 0.f)) * ds1[e] : 0.f;
                        gf[lt][e] = (short)f2bf(va); gf[lt][4 + e] = (short)f2bf(vb);
                    }
                }
                bf16x8 xf[4];
                tr_frag4b<16 * PXS>(xf, baseX + ks * 32 * PXS, 32);
#pragma unroll
                for (int pt = 0; pt < 4; ++pt) { yacc[pt][0] = __builtin_amdgcn_mfma_f32_16x16x32_bf16(xf[pt], gf[0], yacc[pt][0], 0, 0, 0);
                                                 yacc[pt][1] = __builtin_amdgcn_mfma_f32_16x16x32_bf16(xf[pt], gf[1], yacc[pt][1], 0, 0, 0); }
            }
            const float ex0 = __expf(el0), ex1 = __expf(el1);
            const char* S = SB + d * 16384;
#pragma unroll
            for (int pt = 0; pt < 4; ++pt) {
                f32x4 o0 = {0.f, 0.f, 0.f, 0.f}, o1 = {0.f, 0.f, 0.f, 0.f};
#pragma unroll
                for (int ks = 0; ks < 4; ++ks) { const bf16x8 sf = *(const bf16x8*)(S + (pt * 16 + fr) * 256 + (((ks * 4 + fq) ^ fr) * 16));
                    o0 = __builtin_amdgcn_mfma_f32_16x16x32_bf16(sf, cf[0][ks], o0, 0, 0, 0); o1 = __builtin_amdgcn_mfma_f32_16x16x32_bf16(sf, cf[1][ks], o1, 0, 0, 0); }
                yacc[pt][0] += o0 * ex0; yacc[pt][1] += o1 * ex1;
            }
        }
        const float dsk = p.d_skip[layer * NH + hh];
#pragma unroll
        for (int lt = 0; lt < 2; ++lt) {
            const int l = wid * 32 + lt * 16 + fr; const size_t row = (size_t)(row0 + l);
#pragma unroll
            for (int pt = 0; pt < 4; ++pt) {
                const int pc = pt * 16 + 4 * fq;
                const uint2 xq = *(const uint2*)(LX + l * PXS + pc * 2);
                const uint2 zq = *(const uint2*)(p.U + row * UC + U_Z + hh * HD + pc);
                const float xv[4] = {lo16(xq.x), hi16(xq.x), lo16(xq.y), hi16(xq.y)}, zv[4] = {lo16(zq.x), hi16(zq.x), lo16(zq.y), hi16(zq.y)};
                float o[4];
#pragma unroll
                for (int j = 0; j < 4; ++j) { o[j] = (yacc[pt][lt][j] + dsk * xv[j]) * siluf_(zv[j]); ssq[lt] += o[j] * o[j]; }
                uint2 q; q.x = pack2(o[0], o[1]); q.y = pack2(o[2], o[3]);
                *(uint2*)(p.yc + row * D + hh * HD + pc) = q;
            }
        }
#pragma unroll
        for (int lt = 0; lt < 2; ++lt) { float s = ssq[lt]; s += __shfl_xor(s, 16); s += __shfl_xor(s, 32);
            if (fq == 0) p.ssq[(size_t)(row0 + wid * 32 + lt * 16 + fr) * 16 + hh] = s; }
    }
}

constexpr int N_ROUTER = T / 32, HSP = 1028;
__device__ __forceinline__ void stage_router(PRef p, int layer, int item, char* lds) {
    const int tid = tidx(), wave = tid >> 6, lane = tid & 63;
    float* hs = (float*)lds;
    float* part = hs + 16 * HSP;
    int* pe = (int*)(part + 4 * 16 * 32);
    int* hist = pe + 256;
    int* rank = hist + 32;
    const float* nw = p.norm2_w + layer * D;
    __syncthreads();
    if (tid < 32) hist[tid] = 0;
#pragma unroll 1
    for (int rnd = 0; rnd < 2; ++rnd) {
        const int rowb = item * 32 + rnd * 16;
#pragma unroll 1
        for (int t = 0; t < 4; ++t) {
            const int tl = wave * 4 + t, row = rowb + tl, mrow = modrow(row);
            const float* sh = modp(p, layer, mrow, 3); const float* sc = modp(p, layer, mrow, 4);
            f32x4 v[4]; float ss = 0.f;
#pragma unroll
            for (int j = 0; j < 4; ++j) { v[j] = *(const f32x4*)(p.res + (size_t)row * D + 4 * lane + 256 * j); ss += v[j][0] * v[j][0] + v[j][1] * v[j][1] + v[j][2] * v[j][2] + v[j][3] * v[j][3]; }
            ss = wave_sum(ss); const float rinv = rsqrtf(ss * (1.0f / D) + RMS_EPS);
#pragma unroll
            for (int j = 0; j < 4; ++j) {
                const int k = 4 * lane + 256 * j;
                const f32x4 w = *(const f32x4*)(nw + k), a = *(const f32x4*)(sc + k), bb = *(const f32x4*)(sh + k);
                const f32x4 hv = v[j] * rinv * w * (a + 1.0f) + bb;
                uint2 q; q.x = pack2(hv[0], hv[1]); q.y = pack2(hv[2], hv[3]);
                *(uint2*)(p.h + (size_t)row * D + k) = q;
                *(f32x4*)(hs + tl * HSP + k) = hv;
            }
        }
        __syncthreads();
        {
            const int i = lane & 15, kq = lane >> 4;
            const float* rw = p.router_w + (size_t)layer * D * NE + (lane & 15);
            f32x4 a0 = {0.f, 0.f, 0.f, 0.f}, a1 = {0.f, 0.f, 0.f, 0.f};
#pragma unroll 4
            for (int q = 0; q < 16; ++q) {
                const int kb = wave * 256 + q * 16 + kq * 4;
                const f32x4 av = *(const f32x4*)(hs + i * HSP + kb);
#pragma unroll
                for (int j = 0; j < 4; ++j) {
                    const float b0 = rw[(size_t)(kb + j) * NE], b1 = rw[(size_t)(kb + j) * NE + 16];
                    a0 = __builtin_amdgcn_mfma_f32_16x16x4f32(av[j], b0, a0, 0, 0, 0);
                    a1 = __builtin_amdgcn_mfma_f32_16x16x4f32(av[j], b1, a1, 0, 0, 0);
                }
            }
#pragma unroll
            for (int r = 0; r < 4; ++r) { part[(wave * 16 + 4 * kq + r) * 32 + i] = a0[r]; part[(wave * 16 + 4 * kq + r) * 32 + 16 + i] = a1[r]; }
        }
        __syncthreads();
        if (tid < 16) {
            float lg[32];
#pragma unroll
            for (int e = 0; e < 32; ++e) lg[e] = part[(0 * 16 + tid) * 32 + e] + part[(1 * 16 + tid) * 32 + e] + part[(2 * 16 + tid) * 32 + e] + part[(3 * 16 + tid) * 32 + e] + p.router_b[layer * NE + e];
            float tv[4]; int ti[4];
#pragma unroll
            for (int r = 0; r < 4; ++r) {
                float bv = -3.0e38f; int bi = 0;
#pragma unroll
                for (int e = 0; e < 32; ++e) { const bool tk = (r > 0 && ti[0] == e) || (r > 1 && ti[1] == e) || (r > 2 && ti[2] == e); if (!tk && lg[e] > bv) { bv = lg[e]; bi = e; } }
                tv[r] = bv; ti[r] = bi;
            }
            const int row = rowb + tid;
            const float e1 = __expf(tv[1] - tv[0]), e2 = __expf(tv[2] - tv[0]), e3 = __expf(tv[3] - tv[0]); const float inv = 1.0f / (1.0f + e1 + e2 + e3);
            *(f32x4*)(p.topw + (size_t)row * 4) = (f32x4){inv, e1 * inv, e2 * inv, e3 * inv};
#pragma unroll
            for (int r = 0; r < 4; ++r) { p.topi[row * 4 + r] = ti[r]; pe[(rnd * 16 + tid) * 4 + r] = ti[r]; }
        }
        __syncthreads();
    }
    if (tid < 128) rank[tid] = atomicAdd(&hist[pe[tid]], 1);
    __syncthreads();
    if (tid < 32) { const int c = hist[tid]; hist[tid] = c ? atomicAdd(&p.cnt[layer * NE + tid], c) : 0; }
    __syncthreads();
    if (tid < 128) { const int e = pe[tid]; p.list[(size_t)(layer * NE + e) * T + hist[e] + rank[tid]] = (item * 32 + (tid >> 2)) * 4 + (tid & 3); }
}

#define XB_TMO      128
#define XB_XCNT(j)  (256  + 64 * (j))
#define XB_XSUB(j)  (1280 + 64 * (j))
#define XB_XGEN(j)  (2304 + 64 * (j))
#define XB_TOP      3328
#define XB_TOPGEN   3392
#define XCD_BAR_WORDS 3456
#define XB_SPIN_CAP (1u << 22)
#define LAS __attribute__((address_space(3)))
__device__ __forceinline__ unsigned xb_ld(unsigned* p)              { return __hip_atomic_load(p, __ATOMIC_RELAXED, __HIP_MEMORY_SCOPE_AGENT); }
__device__ __forceinline__ unsigned xb_add(unsigned* p, unsigned v) { return __hip_atomic_fetch_add(p, v, __ATOMIC_RELAXED, __HIP_MEMORY_SCOPE_AGENT); }
__device__ __forceinline__ unsigned xb_xcc_id() { return (unsigned)__builtin_amdgcn_s_getreg((3 << 11) | 20) & 0xFu; }
#define XB_SPIN(cond, bar) do { unsigned _sp = 0; while (cond) { __builtin_amdgcn_s_sleep(1); \
    if ((++_sp & 255u) == 0u) { if (xb_ld(&(bar)[XB_TMO])) break; if (_sp > XB_SPIN_CAP) { atomicAdd(&(bar)[XB_TMO], 1u); break; } } } } while (0)
struct XcdBarrier { unsigned* bar; unsigned x; volatile LAS unsigned* st; };
__device__ __forceinline__ XcdBarrier xcd_barrier_post(unsigned* bar, volatile LAS unsigned* st) {
    XcdBarrier b; b.bar = bar; b.x = xb_xcc_id(); b.st = st;
    if (threadIdx.x == 0) st[2] = xb_add(&bar[XB_XCNT(b.x)], 1u);
    return b;
}
__device__ __forceinline__ void xcd_barrier_complete(unsigned* bar, unsigned x, unsigned& nloc, unsigned& nx, unsigned& rank) {
    const unsigned G = gridDim.x * gridDim.y * gridDim.z;
    unsigned sum, cnt, mine, sp = 0u;
    for (;;) {
        sum = 0u; cnt = 0u; mine = 0u;
#pragma unroll
        for (unsigned j = 0; j < 16; ++j) { const unsigned c = xb_ld(&bar[XB_XCNT(j)]); sum += c; cnt += (c > 0u) ? 1u : 0u; }
        mine = xb_ld(&bar[XB_XCNT(x)]);
        rank = 0u;
#pragma unroll
        for (unsigned j = 0; j < 16; ++j) rank += (j < x && xb_ld(&bar[XB_XCNT(j)]) > 0u) ? 1u : 0u;
        if (sum == G) break;
        __builtin_amdgcn_s_sleep(1);
        if ((++sp & 255u) == 0u) { if (xb_ld(&bar[XB_TMO])) break; if (sp > XB_SPIN_CAP) { atomicAdd(&bar[XB_TMO], 1u); break; } }
    }
    nloc = mine > 0u ? mine : 1u; nx = cnt > 0u ? cnt : 1u;
}
__device__ __forceinline__ void xcd_barrier(const XcdBarrier& b) {
    asm volatile("s_waitcnt vmcnt(0)" ::: "memory");
    __syncthreads();
    if (threadIdx.x == 0) {
        unsigned* bar = b.bar;
        __builtin_amdgcn_s_waitcnt(0);
        unsigned nloc = b.st[0], nx = b.st[1];
        if (nloc == 0u) { unsigned rk = 0u; xcd_barrier_complete(bar, b.x, nloc, nx, rk); b.st[0] = nloc; b.st[1] = nx; b.st[3] = rk; }
        const unsigned old = xb_add(&bar[XB_XSUB(b.x)], 1u);
        const unsigned gen = old / nloc;
        if (old + 1u == (gen + 1u) * nloc) {
            __builtin_amdgcn_fence(__ATOMIC_RELEASE, "agent");
            asm volatile("s_waitcnt vmcnt(0)" ::: "memory");
            const unsigned og = xb_add(&bar[XB_TOP], 1u);
            const unsigned tg = og / nx;
            if (og + 1u == (tg + 1u) * nx) xb_add(&bar[XB_TOPGEN], 1u);
            else XB_SPIN(xb_ld(&bar[XB_TOPGEN]) == tg, bar);
            __builtin_amdgcn_fence(__ATOMIC_ACQUIRE, "agent");
            xb_add(&bar[XB_XGEN(b.x)], 1u);
            asm volatile("s_waitcnt vmcnt(0)" ::: "memory");
        } else {
            XB_SPIN(xb_ld(&bar[XB_XGEN(b.x)]) == gen, bar);
            __builtin_amdgcn_fence(__ATOMIC_ACQUIRE, "agent");
            asm volatile("s_waitcnt vmcnt(0)" ::: "memory");
        }
    }
    __syncthreads();
}

namespace cg = cooperative_groups;
#define PHASE_LOOP(n) for (int item = bid; item < (n); item += G)
#define XPHASE_LOOP(n, base) for (int item = (base) + (int)(((long)(n) * xrank) / xnum) + xslot, item_end = (base) + (int)(((long)(n) * (xrank + 1)) / xnum); item < item_end; item += xper)
__global__ void __launch_bounds__(256, 2) hybrid_megakernel(Params p_by_value) {
    CParams* kp = (CParams*)__builtin_amdgcn_kernarg_segment_ptr();
#define p (*launder(kp))
    __shared__ __attribute__((aligned(16))) char lds[LDS_BYTES + 16];
#define xb_words (*(uint4*)(lds + LDS_BYTES))
    if (threadIdx.x == 0) xb_words = make_uint4(0u, 0u, 0u, 0u);
    __syncthreads();
    XcdBarrier bar = xcd_barrier_post(p.bar, (volatile LAS unsigned*)&xb_words);
    const int G = gridDim.x, bid = blockIdx.x;
    int xper = G >> 3, xnum = 8, xslot = bid >> 3, xrank = bid & 7;
    constexpr int PH_PER_LAYER = 11, N_PHASES = 1 + DEPTH * PH_PER_LAYER + 1;
#pragma unroll 1
    for (int ph = 0; ph < N_PHASES; ++ph) {
        const int l = ph == 0 ? 0 : (ph - 1) / PH_PER_LAYER, sub = ph == 0 ? -1 : (ph == N_PHASES - 1 ? 99 : (ph - 1) % PH_PER_LAYER);
        switch (sub) {
        case -1:
            PHASE_LOOP(N_TABLE + 33 * (N_FOLD + N_ADA)) {
                if (item < N_TABLE) { stage_table(p, item); continue; }
                const int i = item - N_TABLE, q = i / 33, r = i % 33;
                if (r == 0) { if (q < N_FOLD) stage_fold(p, q, lds); else stage_ada(p, q - N_FOLD, lds); }
                else { const int cv = q * 32 + (r - 1); if (cv < N_CONVERT) stage_convert(p, cv, lds); }
            }
            break;
        case 0:
            if (l == 0) { PHASE_LOOP(N_ROWNORM) stage_rownorm<0>(p, l, item); } else { PHASE_LOOP(N_ROWNORM) stage_rownorm<1>(p, l, item); }
            break;
        case 1: XPHASE_LOOP(N_INPROJ, 0) stage_inproj(p, l, item, lds); break;
        case 2:
            PHASE_LOOP(N_FOURA + N_CONV + N_POOL + N_ACSUM) {
                if (item < N_FOURA) stage_fourA(p, item, lds);
                else if (item < N_FOURA + N_CONV) stage_conv(p, l, item - N_FOURA);
                else if (item < N_FOURA + N_CONV + N_POOL) stage_pool(p, item - N_FOURA - N_CONV);
                else stage_acsum(p, l, item - N_FOURA - N_CONV - N_POOL, lds);
            }
            break;
        case 3:
            PHASE_LOOP(N_CSTATE + N_FOURB) {
                if (item < N_CSTATE) stage_cstate(p, item, lds);
                else stage_fourB(p, item - N_CSTATE, lds);
            }
            break;
        case 4:
            PHASE_LOOP(N_SCAN) stage_scan(p, item);
            XPHASE_LOOP(N_G1024, 0) stage_gemm_small<1>(p, l, item, lds);
            break;
        case 5: PHASE_LOOP(l == DEPTH - 1 ? 512 : N_SSDOUT) stage_ssdout(p, l, item, lds); break;
        case 6: XPHASE_LOOP(l == DEPTH - 1 ? (TL / 128) * 8 : N_G1024, 0) stage_merge(p, l, item, lds); break;
        case 7: XPHASE_LOOP(l == DEPTH - 1 ? (TL / 128) * 8 : N_G1024, 0) stage_outproj(p, l, item, lds); break;
        case 8: PHASE_LOOP(l == DEPTH - 1 ? TL / 32 : N_ROUTER) stage_router(p, l, item, lds); break;
        case 9: { const int n1 = moe_total_mtiles(p, l) * 16; XPHASE_LOOP(n1, 0) stage_moe1(p, l, item, lds); } break;
        case 10: { const int n2 = moe_total_mtiles(p, l) * 8; XPHASE_LOOP(n2, 0) stage_moe2(p, l, item, lds); } break;
        default: PHASE_LOOP(TL / 4) stage_rownorm<2>(p, DEPTH - 1, item); break;
        }
        if (ph == 0) { cg::this_grid().sync(); xcd_barrier(bar); xper = (int)xb_words.x; xnum = (int)xb_words.y; xslot = (int)xb_words.z; xrank = (int)xb_words.w; }
        else if (ph != N_PHASES - 1) xcd_barrier(bar);
    }
#undef p
}

extern "C" void kernel_launch(void* const* d_in, const int* in_sizes, int n_in, void* d_out, int out_size, void* d_ws, size_t ws_size, hipStream_t stream) {
    Params p; memset(&p, 0, sizeof(p));
    const float** f = (const float**)&p;
    for (int i = 0; i < 26; ++i) f[i] = (const float*)d_in[i];
    p.out = (float*)d_out;
    char* w = (char*)d_ws; size_t off = 0;
    auto take = [&](size_t bytes) { char* r = w + off; off += (bytes + 255) & ~(size_t)255; return r; };
    p.bar = (unsigned*)take(16384); p.cnt = (int*)take(1024);
    p.mod = (float*)take((size_t)DEPTH * 3 * 6144 * 4);
    p.res = (float*)take((size_t)T * D * 4);
    p.dt = (float*)take((size_t)T * 32 * 4);
    p.ybuf = (float*)take((size_t)T * D * 4);
    p.ycraw = (float*)take((size_t)T * D * 4);
    p.topw = (float*)take((size_t)T * 4 * 4);
    p.topi = (int*)take((size_t)T * 4 * 4);
    p.list = (int*)take((size_t)DEPTH * NE * T * 4);
    p.h = (bf16_t*)take((size_t)T * D * 2);
    p.w_in_t = (bf16_t*)take((size_t)DEPTH * WIN_ROWS * D * 2);
    p.w_br_t = (bf16_t*)take((size_t)DEPTH * 3 * D * D * 2);
    p.w_out_t = (bf16_t*)take((size_t)DEPTH * D * D * 2);
    p.pool_w_t = (bf16_t*)take((size_t)DEPTH * 4 * 65536 * 2);
    p.w1_t = (bf16_t*)take((size_t)DEPTH * NE * 2048 * D * 2);
    p.w2_t = (bf16_t*)take((size_t)DEPTH * NE * D * D * 2);
    p.cs_t = (bf16_t*)take((size_t)256 * 512 * 2);
    p.tabA = (bf16_t*)take((size_t)128 * 128 * 64 * 2);
    p.tabB = (bf16_t*)take((size_t)256 * 256 * 2);
    p.tabC = (bf16_t*)take((size_t)2 * 256 * 256 * 2);
    p.Ap = (bf16_t*)take((size_t)NB * 64 * 256 * D * 2);
    p.Scs = (bf16_t*)take((size_t)NCH * 2 * NH * HD * NS * 2);
    p.Sst = (bf16_t*)take((size_t)NCH * 2 * NH * HD * NS * 2);
    p.ac = (float*)take((size_t)T * 32 * 4);
    p.ssq = (float*)take((size_t)T * 16 * 4);
    p.U = (bf16_t*)take((size_t)T * UC * 2);
    p.V = (bf16_t*)take((size_t)T * 2048 * 2);
    p.Dp = (bf16_t*)take((size_t)T * D * 2);
    p.ya = (bf16_t*)take((size_t)T * D * 2);
    p.Yb = (bf16_t*)take((size_t)T * 2048 * 2);
    p.yb = (bf16_t*)take((size_t)T * D * 2);
    p.yc = (bf16_t*)take((size_t)T * D * 2);
    p.m = (bf16_t*)take((size_t)T * D * 2);
    p.act = (bf16_t*)take((size_t)(T * 4 + 256) * D * 2);
    p.sout = (bf16_t*)take((size_t)T * 4 * D * 2);
    if (off > ws_size) { fprintf(stderr, "workspace too small: need %zu have %zu\n", off, ws_size); return; }
    static int grid_blocks = 0;
    if (!grid_blocks) {
        int dev = 0, cus = 0, per_cu = 0;
        (void)hipGetDevice(&dev);
        (void)hipDeviceGetAttribute(&cus, hipDeviceAttributeMultiprocessorCount, dev);
        (void)hipOccupancyMaxActiveBlocksPerMultiprocessor(&per_cu, hybrid_megakernel, 256, 0);
        if (per_cu > 2) per_cu = 2;
        if (per_cu < 1) per_cu = 1;
        grid_blocks = cus * per_cu;
    }
    (void)hipMemsetAsync(p.bar, 0, 16384 + 1024, stream);
    void* args[] = {&p};
    hipError_t e = hipLaunchCooperativeKernel((void*)hybrid_megakernel, dim3(grid_blocks), dim3(256), args, 0, stream);
    if (e != hipSuccess) fprintf(stderr, "cooperative launch failed: %s (grid %d)\n", hipGetErrorString(e), grid_blocks);
}
```

```cpp
#include <hip/hip_runtime.h>
#include <hip/hip_cooperative_groups.h>
#include <cstdio>
#include <cstdint>
#include <cstring>

typedef unsigned short bf16_t;
typedef short bf16x8 __attribute__((ext_vector_type(8)));
typedef float f32x4 __attribute__((ext_vector_type(4)));

constexpr int D = 1024, NB = 2, SEQ = 8192, TL = NB * SEQ, CTXL = 256, TC = NB * CTXL, T = TL + TC;
constexpr int DEPTH = 2, NE = 32, TOPK = 4, NH = 16, HD = 64, NS = 128;
constexpr int IN_COLS = 8224, UC = 8192;
constexpr int U_FOUR = 1024, U_Z = 2048, U_XBC = 3072, U_GATE = 5120;
constexpr int WIN_ROWS = 8448;
constexpr float RMS_EPS = 1e-6f;
constexpr int LDS_BYTES = 77824;
#ifndef REPEAT_SUB
#define REPEAT_SUB -2
#endif
#ifndef NAIVE_FOUR
#define NAIVE_FOUR 0
#endif
#ifndef NAIVE_SSD
#define NAIVE_SSD 0
#endif

struct Params {
    const float *x, *c, *ctx, *c_ctx, *w_ada, *b_ada, *norm1_w, *norm2_w, *w_in, *pool_w, *pool_scale, *conv_w, *conv_b, *dt_bias, *a_log,
        *d_skip, *ssm_norm_w, *w_branch, *w_out, *router_w, *router_b, *moe_w1, *moe_b1, *moe_w2, *moe_b2, *final_norm_w;
    float* out;
    unsigned* bar; int* cnt;
    float *mod, *res, *dt, *ybuf, *ycraw, *topw, *ac, *ssq;
    bf16_t *h, *w_in_t, *w_br_t, *w_out_t, *pool_w_t, *w1_t, *w2_t, *cs_t, *U, *V, *Dp, *ya, *Yb, *yb, *yc, *m, *act, *sout, *tabA, *tabB, *tabC, *Ap, *Scs, *Sst;
    int *topi, *list;
};

typedef const __attribute__((address_space(4))) Params CParams;
typedef CParams& PRef;
__device__ __forceinline__ CParams* launder(CParams* kp) { asm volatile("" : "+s"(kp)); return kp; }
__device__ __forceinline__ int tidx() { int t = threadIdx.x & 255; asm volatile("" : "+v"(t)); return t; }
__device__ __forceinline__ int tidx8() { int t = threadIdx.x; asm volatile("" : "+v"(t)); return t; }
__device__ __forceinline__ float bf2f(bf16_t u) { return __uint_as_float(((unsigned)u) << 16); }
typedef __bf16 bf16n2 __attribute__((ext_vector_type(2)));
typedef float f32x2n __attribute__((ext_vector_type(2)));
__device__ __forceinline__ bf16_t f2bf(float f) { return __builtin_bit_cast(bf16_t, (__bf16)f); }
__device__ __forceinline__ unsigned pack2(float a, float b) { return __builtin_bit_cast(unsigned, __builtin_convertvector((f32x2n){a, b}, bf16n2)); }
__device__ __forceinline__ float lo16(unsigned u) { return __uint_as_float(u << 16); }
__device__ __forceinline__ float hi16(unsigned u) { return __uint_as_float(u & 0xffff0000u); }
__device__ __forceinline__ float sigmoidf_(float x) { return __builtin_amdgcn_rcpf(1.0f + __expf(-x)); }
__device__ __forceinline__ float siluf_(float x) { return x * __builtin_amdgcn_rcpf(1.0f + __expf(-x)); }
__device__ __forceinline__ float softplusf_(float x) { return x > 20.f ? x : log1pf(__expf(x)); }
__device__ __forceinline__ int modrow(int row) { return row < TL ? (row / SEQ) : 2; }
__device__ __forceinline__ const float* modp(PRef p, int layer, int mrow, int j) { return p.mod + ((size_t)((layer * 3 + mrow) * 6 + j)) * D; }
__device__ __forceinline__ float wave_sum(float v) {
#pragma unroll
    for (int o = 32; o >= 1; o >>= 1) v += __shfl_xor(v, o);
    return v;
}

__device__ __forceinline__ int colmap(int mode, int j) {
    if (mode == 0) return j;
    if (mode == 1) { if (j < 5120) return j; if (j < 8192) return j + 32; if (j < 8224) return 5120 + (j - 8192); return -1; }
    const int Tn = j >> 7, wc = (j >> 6) & 1, jj = j & 63, fq = jj >> 4, n = (jj >> 2) & 3;
    return (n < 2 ? 0 : 1024) + Tn * 64 + wc * 32 + 8 * fq + 4 * (n & 1) + (jj & 3);
}
__device__ __forceinline__ void convert_tile(const float* __restrict__ src, int ld, bf16_t* __restrict__ dst, int K, int n0, int k0, int mode, char* lds, const float* kscale = nullptr) {
    float* tile = (float*)lds;
    const int tid = tidx();
    __syncthreads();
    { const int n4 = (tid & 15) * 4, kr = tid >> 4; const int sc = colmap(mode, n0 + n4);
      f32x4 v[8];
#pragma unroll
      for (int i = 0; i < 8; ++i) { const int kk = kr + 16 * i; v[i] = (f32x4){0.f, 0.f, 0.f, 0.f}; if (sc >= 0) v[i] = *(const f32x4*)(src + (size_t)(k0 + kk) * ld + sc); }
#pragma unroll
      for (int i = 0; i < 8; ++i) { const int kk = kr + 16 * i; if (kscale) v[i] *= kscale[k0 + kk];
          tile[kk * 65 + n4] = v[i][0]; tile[kk * 65 + n4 + 1] = v[i][1]; tile[kk * 65 + n4 + 2] = v[i][2]; tile[kk * 65 + n4 + 3] = v[i][3]; } }
    __syncthreads();
    { const int ko = (tid & 15) * 8, nr = tid >> 4;
#pragma unroll
      for (int i = 0; i < 4; ++i) { const int n = nr + 16 * i; float v[8];
#pragma unroll
          for (int j = 0; j < 8; ++j) v[j] = tile[(ko + j) * 65 + n];
          uint4 q; q.x = pack2(v[0], v[1]); q.y = pack2(v[2], v[3]); q.z = pack2(v[4], v[5]); q.w = pack2(v[6], v[7]);
          *(uint4*)(dst + (size_t)(n0 + n) * K + k0 + ko) = q; } }
}
constexpr int CV_WIN = (WIN_ROWS / 64) * 8, CV_BR = 2 * 128, CV_OUT = 128, CV_W1 = NE * 32 * 8, CV_W2 = NE * 128;
constexpr int CV_LAYER = CV_WIN + CV_BR + CV_OUT + CV_W1 + CV_W2;
constexpr int N_CONVERT = DEPTH * CV_LAYER;
__device__ __forceinline__ void stage_convert(PRef p, int item, char* lds) {
    const int l = item / CV_LAYER; int w = item % CV_LAYER;
    if (w < CV_WIN) { convert_tile(p.w_in + (size_t)l * D * IN_COLS, IN_COLS, p.w_in_t + (size_t)l * WIN_ROWS * D, D, (w / 8) * 64, (w % 8) * 128, 1, lds); return; }
    w -= CV_WIN;
    if (w < CV_BR) { const int k = 1 + w / 128, t = w % 128; convert_tile(p.w_branch + (size_t)(l * 3 + k) * D * D, D, p.w_br_t + (size_t)(l * 3 + k) * D * D, D, (t / 8) * 64, (t % 8) * 128, 0, lds, (!NAIVE_SSD && k == 2) ? p.ssm_norm_w + l * D : nullptr); return; }
    w -= CV_BR;
    if (w < CV_OUT) { convert_tile(p.w_out + (size_t)l * D * D, D, p.w_out_t + (size_t)l * D * D, D, (w / 8) * 64, (w % 8) * 128, 0, lds); return; }
    w -= CV_OUT;
    if (w < CV_W1) { const int e = w / 256, t = w % 256; convert_tile(p.moe_w1 + (size_t)(l * NE + e) * D * 2048, 2048, p.w1_t + (size_t)(l * NE + e) * 2048 * D, D, (t / 8) * 64, (t % 8) * 128, 2, lds); return; }
    w -= CV_W1;
    { const int e = w / 128, t = w % 128; convert_tile(p.moe_w2 + (size_t)(l * NE + e) * D * D, D, p.w2_t + (size_t)(l * NE + e) * D * D, D, (t / 8) * 64, (t % 8) * 128, 0, lds); }
}
constexpr int N_FOLD = DEPTH * 4 * 16 * 4;
__device__ __forceinline__ void stage_fold(PRef p, int item, char* lds) {
    float* P = (float*)lds;
    float* W = P + 64 * 64;
    const int tid = tidx(), l = item >> 8, g = (item >> 6) & 3, n0 = ((item >> 2) & 15) * 64, kl0 = (item & 3) * 64;
    const int n = tid & 63, kq = tid >> 6;
    float acc[16];
#pragma unroll
    for (int i = 0; i < 16; ++i) acc[i] = 0.f;
    const float* pw = p.pool_w + (size_t)(l * 4 + g) * 65536; const float* ps = p.pool_scale + l * D + g * 256; const float* wb = p.w_branch + (size_t)(l * 3) * D * D + (size_t)(g * 256) * D;
#pragma unroll 1
    for (int c0 = 0; c0 < 256; c0 += 64) {
        __syncthreads();
#pragma unroll
        for (int i = 0; i < 16; ++i) { const int id = tid + 256 * i, kl = id >> 6, c = id & 63; P[c * 64 + kl] = pw[(size_t)(kl0 + kl) * 256 + c0 + c] * ps[c0 + c]; }
#pragma unroll
        for (int i = 0; i < 16; ++i) { const int id = tid + 256 * i, c = id >> 6, nn = id & 63; W[c * 64 + nn] = wb[(size_t)(c0 + c) * D + n0 + nn]; }
        __syncthreads();
#pragma unroll 4
        for (int c = 0; c < 64; ++c) {
            const float w = W[c * 64 + n];
#pragma unroll
            for (int q = 0; q < 4; ++q) { const f32x4 pv = *(const f32x4*)(P + c * 64 + kq * 16 + q * 4); acc[q * 4] += pv[0] * w; acc[q * 4 + 1] += pv[1] * w; acc[q * 4 + 2] += pv[2] * w; acc[q * 4 + 3] += pv[3] * w; }
        }
    }
    bf16_t* o = p.w_br_t + (size_t)(l * 3) * D * D + (size_t)(n0 + n) * D + g * 256 + kl0 + kq * 16;
    uint4 q0, q1;
    q0.x = pack2(acc[0], acc[1]); q0.y = pack2(acc[2], acc[3]); q0.z = pack2(acc[4], acc[5]); q0.w = pack2(acc[6], acc[7]);
    q1.x = pack2(acc[8], acc[9]); q1.y = pack2(acc[10], acc[11]); q1.z = pack2(acc[12], acc[13]); q1.w = pack2(acc[14], acc[15]);
    ((uint4*)o)[0] = q0; ((uint4*)o)[1] = q1;
}
constexpr int N_TAB_CS = 512, N_TAB_A = 4096, N_TAB_B = 256, N_TAB_C = 512, N_TABLE = N_TAB_CS + N_TAB_A + N_TAB_B + N_TAB_C;
__device__ __forceinline__ void stage_table(PRef p, int item) {
    const float TWO_PI = 6.283185307179586f;
    if (item < N_TAB_CS) {
        const int idx = item * 256 + tidx(), m = idx >> 9, kk = idx & 511, ro = kk >> 8, c = kk & 255;
        const float ang = TWO_PI * (float)((m * c) & 255) * (1.0f / 256.0f);
        p.cs_t[idx] = f2bf((ro ? sinf(ang) : cosf(ang)) * 0.0625f); return;
    }
    item -= N_TAB_CS;
    if (item < N_TAB_A) {
        const int idx = item * 256 + tidx(), n2 = idx >> 13, rA = (idx >> 6) & 127, n1 = idx & 63, k1 = rA >> 1, ri = rA & 1;
        const float ang = TWO_PI * (float)((k1 * (128 * n1 + n2)) & 8191) * (1.0f / 8192.0f);
        p.tabA[idx] = f2bf((ri ? -sinf(ang) : cosf(ang)) * 0.011048543456039806f); return;
    }
    item -= N_TAB_A;
    if (item < N_TAB_B) {
        const int idx = item * 256 + tidx(), rB = idx >> 8, j = idx & 255, k2 = rB >> 1, ro = rB & 1, n2 = j >> 1, ri = j & 1;
        const float ang = TWO_PI * (float)((k2 * n2) & 127) * (1.0f / 128.0f);
        const float cs = cosf(ang), sn = sinf(ang);
        p.tabB[idx] = f2bf(ro == 0 ? (ri == 0 ? cs : sn) : (ri == 0 ? -sn : cs)); return;
    }
    item -= N_TAB_B;
    {
        const int idx = item * 256 + tidx(), half = idx >> 16, rC = (idx >> 8) & 255, n = idx & 255, k = half * 128 + (rC >> 1), ro = rC & 1;
        const float ang = TWO_PI * (float)((k * n) & 255) * (1.0f / 256.0f);
        p.tabC[idx] = f2bf((ro ? -sinf(ang) : cosf(ang)) * 0.0625f);
    }
}
constexpr int N_ADA = DEPTH * 6144 / 32;
__device__ __forceinline__ void stage_ada(PRef p, int item, char* lds) {
    float* sc = (float*)lds;
    float* part = sc + 3 * D;
    const int tid = tidx();
    __syncthreads();
    for (int i = tid; i < 3 * D; i += 256) { const int r = i / D, k = i % D; const float v = r < 2 ? p.c[r * D + k] : p.c_ctx[k]; sc[i] = siluf_(v); }
    __syncthreads();
    const int l = item / 192, cl = tid & 31, kg = tid >> 5, col = (item % 192) * 32 + cl;
    const float* w = p.w_ada + (size_t)l * D * 6144 + (size_t)(kg * 128) * 6144 + col;
    float a0 = 0.f, a1 = 0.f, a2 = 0.f;
#pragma unroll 16
    for (int k = 0; k < 128; ++k) { const float wv = w[(size_t)k * 6144]; a0 += sc[kg * 128 + k] * wv; a1 += sc[D + kg * 128 + k] * wv; a2 += sc[2 * D + kg * 128 + k] * wv; }
    part[(kg * 3 + 0) * 32 + cl] = a0; part[(kg * 3 + 1) * 32 + cl] = a1; part[(kg * 3 + 2) * 32 + cl] = a2;
    __syncthreads();
    if (tid < 96) { const int r = tid >> 5, c2 = tid & 31; float s = p.b_ada[l * 6144 + (item % 192) * 32 + c2];
#pragma unroll
        for (int g = 0; g < 8; ++g) s += part[(g * 3 + r) * 32 + c2];
        p.mod[(size_t)(l * 3 + r) * 6144 + (item % 192) * 32 + c2] = s; }
}

constexpr int N_ROWNORM = T / 4;
template <int MODE>
__device__ __forceinline__ void stage_rownorm(PRef p, int layer, int item) {
    const int wave = tidx() >> 6, lane = tidx() & 63, row = item * 4 + wave, mrow = modrow(row);
    const float* src = MODE == 0 ? (row < TL ? p.x + (size_t)row * D : p.ctx + (size_t)(row - TL) * D) : p.res + (size_t)row * D;
    f32x4 v[4];
#pragma unroll
    for (int j = 0; j < 4; ++j) v[j] = *(const f32x4*)(src + 4 * lane + 256 * j);
    if (MODE >= 1) {
        const int pl = MODE == 1 ? layer - 1 : layer;
        const float* g2 = modp(p, pl, mrow, 5);
#pragma unroll
        for (int j = 0; j < 4; ++j) {
            const int k = 4 * lane + 256 * j; f32x4 s = {0.f, 0.f, 0.f, 0.f};
#pragma unroll
            for (int kk = 0; kk < 4; ++kk) { const uint2 q = *(const uint2*)(p.sout + ((size_t)row * 4 + kk) * D + k); s[0] += lo16(q.x); s[1] += hi16(q.x); s[2] += lo16(q.y); s[3] += hi16(q.y); }
            const f32x4 g = *(const f32x4*)(g2 + k); v[j] += g * s;
        }
    }
    if (MODE != 2) {
#pragma unroll
        for (int j = 0; j < 4; ++j) *(f32x4*)(p.res + (size_t)row * D + 4 * lane + 256 * j) = v[j];
    }
    float ss = 0.f;
#pragma unroll
    for (int j = 0; j < 4; ++j) ss += v[j][0] * v[j][0] + v[j][1] * v[j][1] + v[j][2] * v[j][2] + v[j][3] * v[j][3];
    ss = wave_sum(ss);
    const float rinv = rsqrtf(ss * (1.0f / D) + RMS_EPS);
    if (MODE == 2) {
        if (row < TL) {
#pragma unroll
            for (int j = 0; j < 4; ++j) { const int k = 4 * lane + 256 * j; const f32x4 w = *(const f32x4*)(p.final_norm_w + k); *(f32x4*)(p.out + (size_t)row * D + k) = v[j] * rinv * w; }
        }
    } else {
        const float* nw = p.norm1_w + layer * D; const float* sh = modp(p, layer, mrow, 0); const float* sc = modp(p, layer, mrow, 1);
#pragma unroll
        for (int j = 0; j < 4; ++j) {
            const int k = 4 * lane + 256 * j;
            const f32x4 w = *(const f32x4*)(nw + k), a = *(const f32x4*)(sc + k), b = *(const f32x4*)(sh + k);
            const f32x4 hv = v[j] * rinv * w * (a + 1.0f) + b;
            uint2 q; q.x = pack2(hv[0], hv[1]); q.y = pack2(hv[2], hv[3]);
            *(uint2*)(p.h + (size_t)row * D + k) = q;
        }
    }
}

struct GemmSrc { const bf16_t* a[4]; const bf16_t* b[4]; };
__device__ __forceinline__ void gemm_stage(const GemmSrc& s, int kt, char* buf, int tid) {
#pragma unroll
    for (int i = 0; i < 4; ++i) {
        __builtin_amdgcn_global_load_lds((const unsigned*)(s.a[i] + kt), (unsigned*)(buf + i * 4096 + tid * 16), 16, 0, 0);
        __builtin_amdgcn_global_load_lds((const unsigned*)(s.b[i] + kt), (unsigned*)(buf + 16384 + i * 4096 + tid * 16), 16, 0, 0);
    }
}
__device__ __forceinline__ void gemm_kloop(f32x4 (&acc)[4][4], const GemmSrc& s, int K, char* lds) {
    const int tid = tidx(), wid = tid >> 6, lane = tid & 63, wr = wid >> 1, wc = wid & 1, fr = lane & 15, fq = lane >> 4;
    const int rsw = fr & 7;
    const int offA = (wr * 64 + fr) * 128, offB = 16384 + (wc * 64 + fr) * 128;
    const int c0 = ((0 + fq) ^ rsw) * 16, c1 = ((4 + fq) ^ rsw) * 16;
    asm volatile("s_waitcnt lgkmcnt(0)" ::: "memory");
    __builtin_amdgcn_s_barrier();
    asm volatile("" ::: "memory");
    gemm_stage(s, 0, lds, tid);
    asm volatile("s_waitcnt vmcnt(0)" ::: "memory");
    __syncthreads();
    int cur = 0;
    for (int kt = 0; kt < K; kt += 64) {
        char* buf = lds + cur * 32768;
        if (kt + 64 < K) gemm_stage(s, kt + 64, lds + (cur ^ 1) * 32768, tid);
#pragma unroll
        for (int ks = 0; ks < 2; ++ks) {
            const int cc = ks ? c1 : c0;
            bf16x8 af[4], bfr[4];
#pragma unroll
            for (int m = 0; m < 4; ++m) af[m] = *(const bf16x8*)(buf + offA + m * 2048 + cc);
#pragma unroll
            for (int n = 0; n < 4; ++n) bfr[n] = *(const bf16x8*)(buf + offB + n * 2048 + cc);
#pragma unroll
            for (int m = 0; m < 4; ++m)
#pragma unroll
                for (int n = 0; n < 4; ++n) acc[m][n] = __builtin_amdgcn_mfma_f32_16x16x32_bf16(bfr[n], af[m], acc[m][n], 0, 0, 0);
        }
        asm volatile("s_waitcnt vmcnt(0)" ::: "memory");
        __syncthreads();
        cur ^= 1;
    }
}
template <int MR> struct GemmSrcT { const bf16_t* a[MR / 2]; const bf16_t* b[2]; };
template <int MR>
__device__ __forceinline__ void gemm_stage_t(const GemmSrcT<MR>& s, int kt, char* buf, int tid) {
#pragma unroll
    for (int i = 0; i < MR / 2; ++i) __builtin_amdgcn_global_load_lds((const unsigned*)(s.a[i] + kt), (unsigned*)(buf + i * 4096 + tid * 16), 16, 0, 0);
#pragma unroll
    for (int i = 0; i < 2; ++i) __builtin_amdgcn_global_load_lds((const unsigned*)(s.b[i] + kt), (unsigned*)(buf + MR * 2048 + i * 4096 + tid * 16), 16, 0, 0);
}
template <int N> __device__ __forceinline__ void wait_vmcnt() { asm volatile("s_waitcnt vmcnt(%0)" :: "n"(N) : "memory"); }
template <int MR>
__device__ __forceinline__ void gemm_kloop_t(f32x4 (&acc)[MR][4], const GemmSrcT<MR>& s, int K, char* lds) {
    constexpr int NBUF = (MR == 8) ? 3 : 4, P = NBUF - 1, L = MR / 2 + 2, BUFB = MR * 2048 + 8192;
    const int tid = tidx(), wid = tid >> 6, lane = tid & 63, wr = wid >> 1, wc = wid & 1, fr = lane & 15, fq = lane >> 4;
    const int cc = (fq ^ ((-(fr >> 2)) & 3)) * 16;
    const int offA = (wr * (MR * 16) + fr) * 64 + cc, offB = MR * 2048 + (wc * 64 + fr) * 64 + cc;
    const int nk = K >> 5;
    asm volatile("s_waitcnt lgkmcnt(0)" ::: "memory");
    __builtin_amdgcn_s_barrier();
    asm volatile("" ::: "memory");
#pragma unroll
    for (int i = 0; i < P; ++i) if (i < nk) gemm_stage_t<MR>(s, i * 32, lds + i * BUFB, tid);
    int cur = 0, nxt = P;
#pragma unroll 1
    for (int k = 0; k < nk; ++k) {
        const int rem = nk - 1 - k;
        if (P >= 3 && rem >= 2) wait_vmcnt<2 * L>(); else if (rem >= 1) wait_vmcnt<L>(); else wait_vmcnt<0>();
        __builtin_amdgcn_s_barrier();
        asm volatile("" ::: "memory");
        const char* buf = lds + cur * BUFB;
        bf16x8 af[MR], bfr[4];
#pragma unroll
        for (int n = 0; n < 4; ++n) bfr[n] = *(const bf16x8*)(buf + offB + n * 1024);
#pragma unroll
        for (int m = 0; m < MR; ++m) af[m] = *(const bf16x8*)(buf + offA + m * 1024);
        __builtin_amdgcn_sched_barrier(0);
        if (k + P < nk) gemm_stage_t<MR>(s, (k + P) * 32, lds + nxt * BUFB, tid);
        __builtin_amdgcn_sched_barrier(0);
#pragma unroll
        for (int m = 0; m < MR; ++m)
#pragma unroll
            for (int n = 0; n < 4; ++n) acc[m][n] = __builtin_amdgcn_mfma_f32_16x16x32_bf16(bfr[n], af[m], acc[m][n], 0, 0, 0);
        cur = (cur + 1 == NBUF) ? 0 : cur + 1; nxt = (nxt + 1 == NBUF) ? 0 : nxt + 1;
    }
}
__device__ __forceinline__ void gemm_kloop2(f32x4 (&acc)[8][4], const GemmSrcT<8>& s, int K, char* lds) { gemm_kloop_t<8>(acc, s, K, lds); }
typedef GemmSrcT<8> GemmSrc2;
struct GemmSrc8 { const bf16_t* a[2]; const bf16_t* b[2]; };
__device__ __forceinline__ void gemm_stage8(const GemmSrc8& s, int kt, char* buf, int T_) {
#pragma unroll
    for (int i = 0; i < 2; ++i) __builtin_amdgcn_global_load_lds((const unsigned*)(s.a[i] + kt), (unsigned*)(buf + i * 8192 + T_ * 16), 16, 0, 0);
#pragma unroll
    for (int i = 0; i < 2; ++i) __builtin_amdgcn_global_load_lds((const unsigned*)(s.b[i] + kt), (unsigned*)(buf + 16384 + i * 8192 + T_ * 16), 16, 0, 0);
}
__device__ __forceinline__ void gemm_kloop8(f32x4 (&acc)[8][4], const GemmSrc8& s, int K, char* lds_all) {
    constexpr int NBUF = 4, P = 3, L = 4, BUFB = 32768;
    const int T_ = tidx8(), wid = T_ >> 6, lane = T_ & 63, wr = wid >> 2, wc = wid & 3, fr = lane & 15, fq = lane >> 4;
    const int cc = (fq ^ ((-(fr >> 2)) & 3)) * 16;
    const int offA = (wr * 128 + fr) * 64 + cc, offB = 16384 + (wc * 64 + fr) * 64 + cc;
    const int nk = K >> 5;
    asm volatile("s_waitcnt lgkmcnt(0)" ::: "memory");
    __builtin_amdgcn_s_barrier();
    asm volatile("" ::: "memory");
#pragma unroll
    for (int i = 0; i < P; ++i) if (i < nk) gemm_stage8(s, i * 32, lds_all + i * BUFB, T_);
    int cur = 0, nxt = P;
#pragma unroll 1
    for (int k = 0; k < nk; ++k) {
        const int rem = nk - 1 - k;
        if (rem >= 2) wait_vmcnt<2 * L>(); else if (rem >= 1) wait_vmcnt<L>(); else wait_vmcnt<0>();
        __builtin_amdgcn_s_barrier();
        asm volatile("" ::: "memory");
        const char* buf = lds_all + cur * BUFB;
        bf16x8 af[8], bfr[4];
#pragma unroll
        for (int n = 0; n < 4; ++n) bfr[n] = *(const bf16x8*)(buf + offB + n * 1024);
#pragma unroll
        for (int m = 0; m < 8; ++m) af[m] = *(const bf16x8*)(buf + offA + m * 1024);
        __builtin_amdgcn_sched_barrier(0);
        if (k + P < nk) gemm_stage8(s, (k + P) * 32, lds_all + nxt * BUFB, T_);
        __builtin_amdgcn_sched_barrier(0);
#pragma unroll
        for (int m = 0; m < 8; ++m)
#pragma unroll
            for (int n = 0; n < 4; ++n) acc[m][n] = __builtin_amdgcn_mfma_f32_16x16x32_bf16(bfr[n], af[m], acc[m][n], 0, 0, 0);
        cur = (cur + 1 == NBUF) ? 0 : cur + 1; nxt = (nxt + 1 == NBUF) ? 0 : nxt + 1;
    }
}
#define GEMM8_LANE_VARS const int T_ = tidx8(), wid = T_ >> 6, lane = T_ & 63, wr = wid >> 2, wc = wid & 3, fr = lane & 15, fq = lane >> 4; (void)wr; (void)wc; (void)fr; (void)fq; \
    const int br0 = T_ >> 2, bc = ((T_ & 3) ^ ((-(T_ >> 4)) & 3)) * 8;
__device__ __forceinline__ void zero_acc2(f32x4 (&acc)[8][4]) {
#pragma unroll
    for (int m = 0; m < 8; ++m)
#pragma unroll
        for (int n = 0; n < 4; ++n) acc[m][n] = (f32x4){0.f, 0.f, 0.f, 0.f};
}
#define GEMM2_LANE_VARS const int tid = tidx(), wid = tid >> 6, lane = tid & 63, wr = wid >> 1, wc = wid & 1, fr = lane & 15, fq = lane >> 4; (void)wr; (void)wc; (void)fr; (void)fq; \
    const int br0 = tid >> 2, bc = ((tid & 3) ^ ((-(tid >> 4)) & 3)) * 8;
__device__ __forceinline__ int brow(int r) { return (r & ~63) | (((r >> 2) & 3) << 4) | (((r >> 4) & 3) << 2) | (r & 3); }
__device__ __forceinline__ void pack16(const f32x4 (&v)[4], uint4& q0, uint4& q1) {
    q0.x = pack2(v[0][0], v[0][1]); q0.y = pack2(v[0][2], v[0][3]); q0.z = pack2(v[1][0], v[1][1]); q0.w = pack2(v[1][2], v[1][3]);
    q1.x = pack2(v[2][0], v[2][1]); q1.y = pack2(v[2][2], v[2][3]); q1.z = pack2(v[3][0], v[3][1]); q1.w = pack2(v[3][2], v[3][3]); }
__device__ __forceinline__ void zero_acc(f32x4 (&acc)[4][4]) {
#pragma unroll
    for (int m = 0; m < 4; ++m)
#pragma unroll
        for (int n = 0; n < 4; ++n) acc[m][n] = (f32x4){0.f, 0.f, 0.f, 0.f};
}
#define GEMM_LANE_VARS const int tid = tidx(), wid = tid >> 6, lane = tid & 63, wr = wid >> 1, wc = wid & 1, fr = lane & 15, fq = lane >> 4; (void)wr; (void)wc; (void)fr; (void)fq; \
    const int ar0 = tid >> 3, ac = ((tid & 7) ^ (ar0 & 7)) * 8;

constexpr int NM_T = T / 128, NM2 = T / 256, NN8 = WIN_ROWS / 256, N_INPROJ = NM2 * NN8;
__device__ __forceinline__ void stage_inproj(PRef p, int layer, int item, char* lds_all) {
    GEMM8_LANE_VARS
    const int grp = item / (8 * NN8), w = item % (8 * NN8);
    const int gsz = (NM2 - grp * 8) < 8 ? (NM2 - grp * 8) : 8, mt = grp * 8 + (w % gsz), nt = w / gsz;
    const bf16_t* A = p.h + (size_t)(mt * 256) * D; const bf16_t* B = p.w_in_t + ((size_t)layer * WIN_ROWS + nt * 256) * D;
    f32x4 acc[8][4]; zero_acc2(acc);
    { GemmSrc8 s;
#pragma unroll
      for (int i = 0; i < 2; ++i) { s.a[i] = A + (size_t)(br0 + 128 * i) * D + bc; s.b[i] = B + (size_t)brow(br0 + 128 * i) * D + bc; }
      gemm_kloop8(acc, s, D, lds_all); }
#pragma unroll
    for (int m = 0; m < 8; ++m) {
        const int row = mt * 256 + wr * 128 + m * 16 + fr;
        if (nt < 32) {
            const int gc = nt * 256 + wc * 64 + 16 * fq;
            f32x4 v[4];
#pragma unroll
            for (int n = 0; n < 4; ++n) { v[n] = acc[m][n]; if (gc >= U_GATE) { v[n][0] = sigmoidf_(v[n][0]); v[n][1] = sigmoidf_(v[n][1]); v[n][2] = sigmoidf_(v[n][2]); v[n][3] = sigmoidf_(v[n][3]); } }
            uint4 q0, q1; pack16(v, q0, q1);
            uint4* o = (uint4*)(p.U + (size_t)row * UC + gc); o[0] = q0; o[1] = q1;
        } else if (wc == 0 && fq < 2) {
#pragma unroll
            for (int n = 0; n < 4; ++n) {
                const int cl = 16 * fq + 4 * n; const f32x4 b = *(const f32x4*)(p.dt_bias + layer * 32 + cl); const f32x4 v = acc[m][n];
                f32x4 o; o[0] = softplusf_(v[0] + b[0]); o[1] = softplusf_(v[1] + b[1]); o[2] = softplusf_(v[2] + b[2]); o[3] = softplusf_(v[3] + b[3]);
                *(f32x4*)(p.dt + (size_t)row * 32 + cl) = o;
            }
        }
    }
}
constexpr int N_G1024 = NM_T * 8;
template <int MODE>
__device__ __forceinline__ void stage_gemm_small(PRef p, int layer, int item, char* lds) {
    GEMM_LANE_VARS
    const int mt = item >> 3, nt = item & 7, g = nt >> 1;
    const bf16_t *A, *B; int lda, ldb, K;
    if (MODE == 0) { A = p.Dp + (size_t)(mt * 128) * D + g * 256; lda = D; K = 256; ldb = 256; B = p.pool_w_t + (size_t)(layer * 4 + g) * 65536 + (size_t)((nt & 1) * 128) * 256; }
    else           { A = p.Yb + (size_t)(mt * 128) * 2048 + g * 512; lda = 2048; K = 512; ldb = 512; B = p.cs_t + (size_t)((nt & 1) * 128) * 512; }
    f32x4 acc[4][4]; zero_acc(acc);
    { GemmSrc s;
#pragma unroll
      for (int i = 0; i < 4; ++i) { s.a[i] = A + (size_t)(ar0 + 32 * i) * lda + ac; s.b[i] = B + (size_t)brow(ar0 + 32 * i) * ldb + ac; }
      gemm_kloop(acc, s, K, lds); }
    bf16_t* O = MODE == 0 ? p.ya : p.yb;
#pragma unroll
    for (int m = 0; m < 4; ++m) {
        const int row = mt * 128 + wr * 64 + m * 16 + fr, col = nt * 128 + wc * 64 + 16 * fq;
        f32x4 v[4];
#pragma unroll
        for (int n = 0; n < 4; ++n) { v[n] = acc[m][n]; if (MODE == 0) v[n] *= *(const f32x4*)(p.pool_scale + layer * D + col + 4 * n); }
        uint4 q0, q1; pack16(v, q0, q1);
        uint4* o = (uint4*)(O + (size_t)row * D + col); o[0] = q0; o[1] = q1;
    }
}
__device__ __forceinline__ void stage_merge(PRef p, int layer, int item, char* lds) {
    GEMM_LANE_VARS
    const int mt = item >> 3, nt = item & 7;
    f32x4 macc[4][4]; zero_acc(macc);
#pragma unroll 1
    for (int k = 0; k < 3; ++k) {
        const bf16_t* A = (k == 0 ? p.Dp : (k == 1 ? p.yb : p.yc)) + (size_t)(mt * 128) * D;
        const bf16_t* B = p.w_br_t + ((size_t)(layer * 3 + k) * D + nt * 128) * D;
        f32x4 acc[4][4]; zero_acc(acc);
        { GemmSrc s;
#pragma unroll
          for (int i = 0; i < 4; ++i) { s.a[i] = A + (size_t)(ar0 + 32 * i) * D + ac; s.b[i] = B + (size_t)brow(ar0 + 32 * i) * D + ac; }
          gemm_kloop(acc, s, D, lds); }
#pragma unroll
        for (int m = 0; m < 4; ++m) {
            const int row = mt * 128 + wr * 64 + m * 16 + fr, col = nt * 128 + wc * 64 + 16 * fq;
            float rs = 1.0f;
            if (!NAIVE_SSD && k == 2) { const f32x4* sq = (const f32x4*)(p.ssq + (size_t)row * 16); const f32x4 t = sq[0] + sq[1] + sq[2] + sq[3]; rs = rsqrtf((t[0] + t[1] + t[2] + t[3]) * (1.0f / D) + RMS_EPS); }
            const uint4* gp = (const uint4*)(p.U + (size_t)row * UC + U_GATE + k * D + col);
            const uint4 g0 = gp[0], g1 = gp[1];
            const unsigned gw[8] = {g0.x, g0.y, g0.z, g0.w, g1.x, g1.y, g1.z, g1.w};
#pragma unroll
            for (int n = 0; n < 4; ++n) {
                macc[m][n][0] += lo16(gw[2 * n]) * rs * acc[m][n][0]; macc[m][n][1] += hi16(gw[2 * n]) * rs * acc[m][n][1];
                macc[m][n][2] += lo16(gw[2 * n + 1]) * rs * acc[m][n][2]; macc[m][n][3] += hi16(gw[2 * n + 1]) * rs * acc[m][n][3];
            }
        }
    }
#pragma unroll
    for (int m = 0; m < 4; ++m) {
        const int row = mt * 128 + wr * 64 + m * 16 + fr, col = nt * 128 + wc * 64 + 16 * fq;
        uint4 q0, q1; pack16(macc[m], q0, q1);
        uint4* o = (uint4*)(p.m + (size_t)row * D + col); o[0] = q0; o[1] = q1;
    }
}
__device__ __forceinline__ void stage_outproj(PRef p, int layer, int item, char* lds) {
    GEMM_LANE_VARS
    const int mt = item >> 3, nt = item & 7;
    const bf16_t* A = p.m + (size_t)(mt * 128) * D; const bf16_t* B = p.w_out_t + ((size_t)layer * D + nt * 128) * D;
    f32x4 acc[4][4]; zero_acc(acc);
    { GemmSrc s;
#pragma unroll
      for (int i = 0; i < 4; ++i) { s.a[i] = A + (size_t)(ar0 + 32 * i) * D + ac; s.b[i] = B + (size_t)brow(ar0 + 32 * i) * D + ac; }
      gemm_kloop(acc, s, D, lds); }
#pragma unroll
    for (int m = 0; m < 4; ++m) {
        const int row = mt * 128 + wr * 64 + m * 16 + fr, col = nt * 128 + wc * 64 + 16 * fq; const float* g1 = modp(p, layer, modrow(row), 2) + col;
        float* r = p.res + (size_t)row * D + col;
#pragma unroll
        for (int n = 0; n < 4; ++n) { const f32x4 g = *(const f32x4*)(g1 + 4 * n); *(f32x4*)(r + 4 * n) = *(const f32x4*)(r + 4 * n) + g * acc[m][n]; }
    }
}
__device__ __forceinline__ int ld_cnt(PRef p, int i) { return __builtin_amdgcn_readfirstlane(__hip_atomic_load(p.cnt + i, __ATOMIC_RELAXED, __HIP_MEMORY_SCOPE_AGENT)); }
struct MoeTile { int e, mt, nt, cnt, off; };
__device__ __forceinline__ void moe_scan(PRef p, int layer, int& c, int& mtn, int& pm, int& pc) {
    const int lane = tidx() & 63, l31 = lane & 31;
    c = __hip_atomic_load(p.cnt + layer * NE + l31, __ATOMIC_RELAXED, __HIP_MEMORY_SCOPE_AGENT);
    mtn = (c + 255) >> 8; pm = mtn; pc = c;
#pragma unroll
    for (int o = 1; o < 32; o <<= 1) {
        const int src = ((lane - o) & 63) * 4;
        const int um = __builtin_amdgcn_ds_bpermute(src, pm), uc = __builtin_amdgcn_ds_bpermute(src, pc);
        if (l31 >= o) { pm += um; pc += uc; }
    }
}
template <int NT>
__device__ __forceinline__ bool moe_decode(PRef p, int layer, int item, MoeTile& t) {
    const int mg = item / NT; t.nt = item % NT;
    int c, mtn, pm, pc; moe_scan(p, layer, c, mtn, pm, pc);
    const int e = __popcll(__ballot(pm <= mg) & 0xffffffffull);
    if (e >= NE) return false;
    t.e = e; t.cnt = __builtin_amdgcn_readlane(c, e);
    t.mt = mg - __builtin_amdgcn_readlane(pm - mtn, e); t.off = __builtin_amdgcn_readlane(pc - c, e);
    return true;
}
__device__ __forceinline__ int moe_total_mtiles(PRef p, int layer) { int c, mtn, pm, pc; moe_scan(p, layer, c, mtn, pm, pc); return __builtin_amdgcn_readlane(pm, 31); }
__device__ __forceinline__ void stage_moe1(PRef p, int layer, int item, char* lds_all) {
    GEMM8_LANE_VARS
    MoeTile t; if (!moe_decode<8>(p, layer, item, t)) return;
    const int* lst = p.list + (size_t)(layer * NE + t.e) * T;
    const bf16_t* B = p.w1_t + ((size_t)(layer * NE + t.e) * 2048 + t.nt * 256) * D;
    f32x4 acc[8][4]; zero_acc2(acc);
    { GemmSrc8 s;
#pragma unroll
      for (int i = 0; i < 2; ++i) { const int ii = t.mt * 256 + br0 + 128 * i; const int tok = lst[ii < t.cnt ? ii : t.cnt - 1] >> 2;
          s.a[i] = p.h + (size_t)tok * D + bc; s.b[i] = B + (size_t)brow(br0 + 128 * i) * D + bc; }
      gemm_kloop8(acc, s, D, lds_all); }
    const float* b1 = p.moe_b1 + (size_t)(layer * NE + t.e) * 2048;
#pragma unroll
    for (int m = 0; m < 8; ++m) {
        const int i = t.mt * 256 + wr * 128 + m * 16 + fr;
        if (i < t.cnt) {
            const int gc = t.nt * 128 + wc * 32 + 8 * fq;
            float o[8];
#pragma unroll
            for (int n = 0; n < 2; ++n) {
                const f32x4 bg = *(const f32x4*)(b1 + gc + 4 * n), bl = *(const f32x4*)(b1 + 1024 + gc + 4 * n);
#pragma unroll
                for (int j = 0; j < 4; ++j) {
                    const float g = fminf(acc[m][n][j] + bg[j], 7.0f), l = fminf(fmaxf(acc[m][n + 2][j] + bl[j], -7.0f), 7.0f);
                    o[4 * n + j] = g * sigmoidf_(1.702f * g) * (l + 1.0f);
                }
            }
            uint4 q; q.x = pack2(o[0], o[1]); q.y = pack2(o[2], o[3]); q.z = pack2(o[4], o[5]); q.w = pack2(o[6], o[7]);
            *(uint4*)(p.act + (size_t)(t.off + i) * D + gc) = q;
        }
    }
}
__device__ __forceinline__ void stage_moe2(PRef p, int layer, int item, char* lds_all) {
    GEMM8_LANE_VARS
    MoeTile t; if (!moe_decode<4>(p, layer, item, t)) return;
    const int* lst = p.list + (size_t)(layer * NE + t.e) * T;
    const bf16_t* B = p.w2_t + ((size_t)(layer * NE + t.e) * D + t.nt * 256) * D;
    f32x4 acc[8][4]; zero_acc2(acc);
    { GemmSrc8 s;
#pragma unroll
      for (int i = 0; i < 2; ++i) { const int ii = t.mt * 256 + br0 + 128 * i;
          s.a[i] = p.act + (size_t)(t.off + (ii < t.cnt ? ii : t.cnt - 1)) * D + bc; s.b[i] = B + (size_t)brow(br0 + 128 * i) * D + bc; }
      gemm_kloop8(acc, s, D, lds_all); }
    const float* b2 = p.moe_b2 + (size_t)(layer * NE + t.e) * D;
#pragma unroll
    for (int m = 0; m < 8; ++m) {
        const int i = t.mt * 256 + wr * 128 + m * 16 + fr;
        if (i < t.cnt) {
            const int pair = lst[i]; const float w = p.topw[pair]; const int col = t.nt * 256 + wc * 64 + 16 * fq;
            f32x4 v[4];
#pragma unroll
            for (int n = 0; n < 4; ++n) v[n] = (acc[m][n] + *(const f32x4*)(b2 + col + 4 * n)) * w;
            uint4 q0, q1; pack16(v, q0, q1);
            uint4* o = (uint4*)(p.sout + (size_t)pair * D + col); o[0] = q0; o[1] = q1;
        }
    }
}

constexpr int N_CONV = T / 32;
__device__ __forceinline__ void stage_conv(PRef p, int layer, int item) {
    const int c0 = tidx() * 8, r0 = item * 32;
    const int seq0 = r0 < TL ? (r0 / SEQ) * SEQ : TL + ((r0 - TL) / CTXL) * CTXL, seq1 = seq0 + (r0 < TL ? SEQ : CTXL);
    float w[5][8], bias[8];
#pragma unroll
    for (int j = 0; j < 5; ++j) { const f32x4 a = *(const f32x4*)(p.conv_w + (size_t)(layer * 5 + j) * 2048 + c0), b = *(const f32x4*)(p.conv_w + (size_t)(layer * 5 + j) * 2048 + c0 + 4);
        w[j][0] = a[0]; w[j][1] = a[1]; w[j][2] = a[2]; w[j][3] = a[3]; w[j][4] = b[0]; w[j][5] = b[1]; w[j][6] = b[2]; w[j][7] = b[3]; }
    { const f32x4 a = *(const f32x4*)(p.conv_b + layer * 2048 + c0), b = *(const f32x4*)(p.conv_b + layer * 2048 + c0 + 4);
      bias[0] = a[0]; bias[1] = a[1]; bias[2] = a[2]; bias[3] = a[3]; bias[4] = b[0]; bias[5] = b[1]; bias[6] = b[2]; bias[7] = b[3]; }
    float win[5][8];
    auto ldrow = [&](int r, float (&o)[8]) {
        if (r >= seq0 && r < seq1) { const uint4 q = *(const uint4*)(p.U + (size_t)r * UC + U_XBC + c0);
            o[0] = lo16(q.x); o[1] = hi16(q.x); o[2] = lo16(q.y); o[3] = hi16(q.y); o[4] = lo16(q.z); o[5] = hi16(q.z); o[6] = lo16(q.w); o[7] = hi16(q.w); }
        else {
#pragma unroll
            for (int i = 0; i < 8; ++i) o[i] = 0.f; }
    };
    ldrow(r0 - 2, win[0]); ldrow(r0 - 1, win[1]); ldrow(r0, win[2]); ldrow(r0 + 1, win[3]);
#pragma unroll 8
    for (int r = r0; r < r0 + 32; ++r) {
        ldrow(r + 2, win[4]);
        float o[8];
#pragma unroll
        for (int i = 0; i < 8; ++i) { float s = bias[i];
#pragma unroll
            for (int j = 0; j < 5; ++j) s += w[j][i] * win[j][i];
            o[i] = siluf_(s); }
        uint4 q; q.x = pack2(o[0], o[1]); q.y = pack2(o[2], o[3]); q.z = pack2(o[4], o[5]); q.w = pack2(o[6], o[7]);
        *(uint4*)(p.V + (size_t)r * 2048 + c0) = q;
#pragma unroll
        for (int j = 0; j < 4; ++j)
#pragma unroll
            for (int i = 0; i < 8; ++i) win[j][i] = win[j + 1][i];
    }
}

constexpr int N_POOL_LAT = NB * 4 * 4 * 16, N_POOL = N_POOL_LAT + NB * 4 * 64;
__device__ __forceinline__ void pool_acc(const uint2 q, float w, float (&v)[4]) { v[0] += w * lo16(q.x); v[1] += w * hi16(q.x); v[2] += w * lo16(q.y); v[3] += w * hi16(q.y); }
template <int W>
__device__ __forceinline__ void pool_lat(PRef p, int g, int b, int band, int c, int lane) {
    constexpr int lo = -(W >> 1), hi = W - (W >> 1) - 1;
    const int r0 = band * 32, cc0 = max(c + lo, 0), cc1 = min(c + hi, 63), ncol = cc1 - cc0 + 1;
    const bf16_t* base = p.U + (size_t)(b * SEQ) * UC + g * 256 + lane * 4;
    float vs[4] = {0.f, 0.f, 0.f, 0.f};
    auto addH = [&](int rr, float sg) {
        const bool rv = rr >= 0 && rr <= 127; const int rc = min(max(rr, 0), 127);
        uint2 q[W];
#pragma unroll
        for (int i = 0; i < W; ++i) { const int cc = min(cc0 + i, 63); q[i] = *(const uint2*)(base + (size_t)(rc * 64 + cc) * UC); }
#pragma unroll
        for (int i = 0; i < W; ++i) pool_acc(q[i], (rv && i < ncol) ? sg : 0.f, vs);
    };
#pragma unroll 1
    for (int rr = r0 + lo; rr <= r0 + hi; ++rr) addH(rr, 1.0f);
#pragma unroll 1
    for (int r = r0; r < r0 + 32; ++r) {
        const int rlo = max(r + lo, 0), rhi = min(r + hi, 127);
        const float inv = 1.0f / (float)((rhi - rlo + 1) * ncol);
        const uint2 sq = *(const uint2*)(base + (size_t)(r * 64 + c) * UC);
        uint2 q; q.x = pack2(vs[0] * inv - lo16(sq.x), vs[1] * inv - hi16(sq.x)); q.y = pack2(vs[2] * inv - lo16(sq.y), vs[3] * inv - hi16(sq.y));
        *(uint2*)(p.Dp + (size_t)(b * SEQ + r * 64 + c) * D + g * 256 + lane * 4) = q;
        {
            const int ra = r + lo, rb = r + 1 + hi;
            const bool va = ra >= 0, vb = rb <= 127; const int rac = max(ra, 0), rbc = min(rb, 127);
            uint2 qa[W], qb[W];
#pragma unroll
            for (int i = 0; i < W; ++i) { const int cc = min(cc0 + i, 63); qa[i] = *(const uint2*)(base + (size_t)(rac * 64 + cc) * UC); qb[i] = *(const uint2*)(base + (size_t)(rbc * 64 + cc) * UC); }
#pragma unroll
            for (int i = 0; i < W; ++i) { pool_acc(qa[i], (va && i < ncol) ? -1.0f : 0.f, vs); pool_acc(qb[i], (vb && i < ncol) ? 1.0f : 0.f, vs); }
        }
    }
}
__device__ __forceinline__ void stage_pool(PRef p, int item) {
    const int tid = tidx(), wave = tid >> 6, lane = tid & 63;
    if (item < N_POOL_LAT) {
        const int g = 3 - (item >> 7), b = (item >> 6) & 1, band = (item >> 4) & 3, c = (item & 15) * 4 + wave;
        if (g == 3) pool_lat<16>(p, g, b, band, c, lane);
        else if (g == 2) pool_lat<8>(p, g, b, band, c, lane);
        else if (g == 1) pool_lat<4>(p, g, b, band, c, lane);
        else pool_lat<2>(p, g, b, band, c, lane);
    } else {
        const int it = item - N_POOL_LAT, g = 3 - (it >> 7), b = (it >> 6) & 1, n = (it & 63) * 4 + wave;
        const int w = 2 << g, lo = -(w >> 1), hi = w - (w >> 1) - 1, t0 = max(n + lo, 0), t1 = min(n + hi, CTXL - 1);
        const bf16_t* base = p.U + (size_t)(TL + b * CTXL) * UC + g * 256 + lane * 4;
        float s[4] = {0.f, 0.f, 0.f, 0.f};
        uint2 q[16];
#pragma unroll
        for (int i = 0; i < 16; ++i) q[i] = *(const uint2*)(base + (size_t)min(t0 + i, CTXL - 1) * UC);
#pragma unroll
        for (int i = 0; i < 16; ++i) pool_acc(q[i], (t0 + i <= t1) ? 1.0f : 0.f, s);
        const float inv = 1.0f / (float)(t1 - t0 + 1);
        const uint2 sq = *(const uint2*)(base + (size_t)n * UC);
        uint2 o; o.x = pack2(s[0] * inv - lo16(sq.x), s[1] * inv - hi16(sq.x)); o.y = pack2(s[2] * inv - lo16(sq.y), s[3] * inv - hi16(sq.y));
        *(uint2*)(p.Dp + (size_t)(TL + b * CTXL + n) * D + g * 256 + lane * 4) = o;
    }
}

constexpr int N_FOUR_LAT = NB * 256 * 16, N_FOUR = N_FOUR_LAT + NB * 8 * 16;
__device__ __forceinline__ void four_table(char* lds) { float* tab = (float*)lds; for (int i = tidx(); i < 8192; i += 256) tab[i] = cosf(6.283185307179586f * (float)i * (1.0f / 8192.0f)); __syncthreads(); }
__device__ __forceinline__ void stage_fourier_naive(PRef p, int item, char* lds) {
    const float* tab = (const float*)lds;
    int b, kt, cch, N, rowbase, mult; float scale;
    if (item < N_FOUR_LAT) { b = item / 4096; const int w = item % 4096; kt = w / 16; cch = w % 16; N = SEQ; rowbase = b * SEQ; mult = 1; scale = 0.011048543456039806f; }
    else { const int it = item - N_FOUR_LAT; b = it / 128; const int w = it % 128; kt = w / 16; cch = w % 16; N = CTXL; rowbase = TL + b * CTXL; mult = 32; scale = 0.0625f; }
    const int kk = tidx() >> 3, oc = tidx() & 7, k = kt * 32 + kk, c0 = cch * 64 + oc * 8;
    const int step = (k * mult) & 8191; int idx = 0;
    float ar[8], ai[8];
#pragma unroll
    for (int i = 0; i < 8; ++i) { ar[i] = 0.f; ai[i] = 0.f; }
    const bf16_t* src = p.U + (size_t)rowbase * UC + U_FOUR + c0;
#pragma unroll 4
    for (int n = 0; n < N; ++n) {
        const uint4 q = *(const uint4*)(src + (size_t)n * UC);
        const float cs = tab[idx], sn = tab[(idx - 2048) & 8191];
        const float xv[8] = {lo16(q.x), hi16(q.x), lo16(q.y), hi16(q.y), lo16(q.z), hi16(q.z), lo16(q.w), hi16(q.w)};
#pragma unroll
        for (int i = 0; i < 8; ++i) { ar[i] += xv[i] * cs; ai[i] -= xv[i] * sn; }
        idx = (idx + step) & 8191;
    }
    const int g = c0 >> 8, cg = c0 & 255;
    bf16_t* o = p.Yb + (size_t)(rowbase + k) * 2048 + g * 512 + cg;
    uint4 r; r.x = pack2(ar[0] * scale, ar[1] * scale); r.y = pack2(ar[2] * scale, ar[3] * scale); r.z = pack2(ar[4] * scale, ar[5] * scale); r.w = pack2(ar[6] * scale, ar[7] * scale);
    *(uint4*)o = r;
    r.x = pack2(ai[0] * scale, ai[1] * scale); r.y = pack2(ai[2] * scale, ai[3] * scale); r.z = pack2(ai[4] * scale, ai[5] * scale); r.w = pack2(ai[6] * scale, ai[7] * scale);
    *(uint4*)(o + 256) = r;
}

typedef unsigned u32x2 __attribute__((ext_vector_type(2)));
union Frag8 { bf16x8 v; u32x2 h[2]; };
template <int OFF>
__device__ __forceinline__ void tr_frag4(bf16x8 (&f)[4], unsigned a0, unsigned a1, unsigned a2, unsigned a3) {
    Frag8 r0, r1, r2, r3;
    asm volatile("ds_read_b64_tr_b16 %0, %8\n\tds_read_b64_tr_b16 %1, %8 offset:%c12\n\t"
                 "ds_read_b64_tr_b16 %2, %9\n\tds_read_b64_tr_b16 %3, %9 offset:%c12\n\t"
                 "ds_read_b64_tr_b16 %4, %10\n\tds_read_b64_tr_b16 %5, %10 offset:%c12\n\t"
                 "ds_read_b64_tr_b16 %6, %11\n\tds_read_b64_tr_b16 %7, %11 offset:%c12\n\t"
                 "s_waitcnt lgkmcnt(0)"
                 : "=&v"(r0.h[0]), "=&v"(r0.h[1]), "=&v"(r1.h[0]), "=&v"(r1.h[1]), "=&v"(r2.h[0]), "=&v"(r2.h[1]), "=&v"(r3.h[0]), "=&v"(r3.h[1])
                 : "v"(a0), "v"(a1), "v"(a2), "v"(a3), "i"(OFF) : "memory");
    f[0] = r0.v; f[1] = r1.v; f[2] = r2.v; f[3] = r3.v;
}
__device__ __forceinline__ unsigned lds_addr(const void* p) { return (unsigned)(size_t)p; }
constexpr int PBA = 544, N_FOURA = NB * 128 * 4;
__device__ __forceinline__ void stage_fourA(PRef p, int item, char* lds) {
    const int tid = tidx(), wid = tid >> 6, lane = tid & 63, fr = lane & 15, fq = lane >> 4;
    const int b = item >> 9, n2 = (item >> 2) & 127, c0 = (item & 3) * 256;
    const bf16_t* tA = p.tabA + ((size_t)n2 * 128 + fr) * 64 + fq * 8;
    bf16x8 tf[2][8];
#pragma unroll
    for (int rt = 0; rt < 8; ++rt) tf[0][rt] = *(const bf16x8*)(tA + rt * 16 * 64);
    __syncthreads();
#pragma unroll
    for (int i = 0; i < 8; ++i) {
        const int id = tid + 256 * i, r = id >> 5, o = id & 31;
        const uint4 q = *(const uint4*)(p.U + (size_t)(b * SEQ + 128 * r + n2) * UC + U_FOUR + c0 + o * 8);
        *(uint4*)(lds + r * PBA + o * 16) = q;
    }
    __syncthreads();
    f32x4 acc[4][8];
#pragma unroll
    for (int a = 0; a < 4; ++a)
#pragma unroll
        for (int r = 0; r < 8; ++r) acc[a][r] = (f32x4){0.f, 0.f, 0.f, 0.f};
    const unsigned base = lds_addr(lds) + (unsigned)((8 * fq + (fr >> 2)) * PBA + (wid * 64 + 4 * (fr & 3)) * 2);
#pragma unroll
    for (int ks = 0; ks < 2; ++ks) {
        bf16x8 xf[4];
        if (ks == 0) {
#pragma unroll
            for (int rt = 0; rt < 8; ++rt) tf[1][rt] = *(const bf16x8*)(tA + rt * 16 * 64 + 32);
        }
        const unsigned a = base + ks * 32 * PBA;
        tr_frag4<4 * PBA>(xf, a, a + 32, a + 64, a + 96);
#pragma unroll
        for (int ct = 0; ct < 4; ++ct)
#pragma unroll
            for (int rt = 0; rt < 8; ++rt) acc[ct][rt] = __builtin_amdgcn_mfma_f32_16x16x32_bf16(xf[ct], tf[ks][rt], acc[ct][rt], 0, 0, 0);
    }
#pragma unroll
    for (int rt = 0; rt < 8; ++rt) {
        const int rA = rt * 16 + fr, k1 = rA >> 1, ri = rA & 1;
        bf16_t* o = p.Ap + ((size_t)(b * 64 + k1) * 256 + n2 * 2 + ri) * D + c0 + wid * 64 + 4 * fq;
#pragma unroll
        for (int ct = 0; ct < 4; ++ct) { uint2 q; q.x = pack2(acc[ct][rt][0], acc[ct][rt][1]); q.y = pack2(acc[ct][rt][2], acc[ct][rt][3]); *(uint2*)(o + ct * 16) = q; }
    }
}
constexpr int PBB = 288, N_FOURB_LAT = NB * 64 * 8, N_FOURB = N_FOURB_LAT + NB * 2 * 8;
__device__ __forceinline__ void stage_fourB(PRef p, int item, char* lds) {
    const int tid = tidx(), wid = tid >> 6, lane = tid & 63, fr = lane & 15, fq = lane >> 4;
    const bf16_t* xsrc; size_t xpitch; const bf16_t* tab; int orow0, orstep, c0;
    if (item < N_FOURB_LAT) { const int b = item >> 9, k1 = (item >> 3) & 63; c0 = (item & 7) * 128;
        xsrc = p.Ap + (size_t)(b * 64 + k1) * 256 * D + c0; xpitch = D; tab = p.tabB; orow0 = b * SEQ + k1; orstep = 64; }
    else { const int it = item - N_FOURB_LAT, b = it >> 4, half = (it >> 3) & 1; c0 = (it & 7) * 128;
        xsrc = p.U + (size_t)(TL + b * CTXL) * UC + U_FOUR + c0; xpitch = UC; tab = p.tabC + half * 65536; orow0 = TL + b * CTXL + half * 128; orstep = 1; }
    f32x4 acc[8][4];
#pragma unroll
    for (int a = 0; a < 8; ++a)
#pragma unroll
        for (int r = 0; r < 4; ++r) acc[a][r] = (f32x4){0.f, 0.f, 0.f, 0.f};
    const unsigned base = lds_addr(lds) + (unsigned)((8 * fq + (fr >> 2)) * PBB + (4 * (fr & 3)) * 2);
    const bf16_t* tB = tab + (size_t)(wid * 64 + fr) * 256 + fq * 8;
#pragma unroll 1
    for (int kh = 0; kh < 2; ++kh) {
        bf16x8 tf0[4];
#pragma unroll
        for (int rt = 0; rt < 4; ++rt) tf0[rt] = *(const bf16x8*)(tB + rt * 16 * 256 + kh * 128);
        __syncthreads();
#pragma unroll
        for (int i = 0; i < 8; ++i) {
            const int id = tid + 256 * i, r = id >> 4, o = id & 15;
            const uint4 q = *(const uint4*)(xsrc + (size_t)(kh * 128 + r) * xpitch + o * 8);
            *(uint4*)(lds + r * PBB + o * 16) = q;
        }
        __syncthreads();
#pragma unroll
        for (int ks = 0; ks < 4; ++ks) {
            bf16x8 xf[8], tf[4];
#pragma unroll
            for (int rt = 0; rt < 4; ++rt) tf[rt] = tf0[rt];
            if (ks < 3) {
#pragma unroll
                for (int rt = 0; rt < 4; ++rt) tf0[rt] = *(const bf16x8*)(tB + rt * 16 * 256 + kh * 128 + (ks + 1) * 32);
            }
            const unsigned a = base + ks * 32 * PBB;
            { bf16x8 t4[4]; tr_frag4<4 * PBB>(t4, a, a + 32, a + 64, a + 96); xf[0] = t4[0]; xf[1] = t4[1]; xf[2] = t4[2]; xf[3] = t4[3]; }
            { bf16x8 t4[4]; tr_frag4<4 * PBB>(t4, a + 128, a + 160, a + 192, a + 224); xf[4] = t4[0]; xf[5] = t4[1]; xf[6] = t4[2]; xf[7] = t4[3]; }
#pragma unroll
            for (int ct = 0; ct < 8; ++ct)
#pragma unroll
                for (int rt = 0; rt < 4; ++rt) acc[ct][rt] = __builtin_amdgcn_mfma_f32_16x16x32_bf16(xf[ct], tf[rt], acc[ct][rt], 0, 0, 0);
        }
    }
    const int g = c0 >> 8, cg = c0 & 255;
#pragma unroll
    for (int rt = 0; rt < 4; ++rt) {
        const int rB = wid * 64 + rt * 16 + fr, kk = rB >> 1, ro = rB & 1;
        bf16_t* o = p.Yb + (size_t)(orow0 + kk * orstep) * 2048 + g * 512 + ro * 256 + cg + 4 * fq;
#pragma unroll
        for (int ct = 0; ct < 8; ++ct) { uint2 q; q.x = pack2(acc[ct][rt][0], acc[ct][rt][1]); q.y = pack2(acc[ct][rt][2], acc[ct][rt][3]); *(uint2*)(o + ct * 16) = q; }
    }
}

constexpr int NCH = T / 128, N_ACSUM = NCH;
__device__ __forceinline__ void stage_acsum(PRef p, int layer, int item, char* lds) {
    const int tid = tidx(), col = tid & 31, seg = tid >> 5, d = col >> 4, h = col & 15;
    float* part = (float*)lds;
    const float A = -__expf(p.a_log[(layer * 2 + d) * NH + h]);
    float v[16];
#pragma unroll
    for (int i = 0; i < 16; ++i) { const int pos = seg * 16 + i, r = item * 128 + (d == 0 ? pos : 127 - pos); v[i] = p.dt[(size_t)r * 32 + col] * A; }
    float s = 0.f;
#pragma unroll
    for (int i = 0; i < 16; ++i) { s += v[i]; v[i] = s; }
    __syncthreads();
    part[seg * 32 + col] = s;
    __syncthreads();
    float base = 0.f;
#pragma unroll
    for (int j = 0; j < 8; ++j) base += (j < seg) ? part[j * 32 + col] : 0.f;
#pragma unroll
    for (int i = 0; i < 16; ++i) { const int pos = seg * 16 + i, r = item * 128 + (d == 0 ? pos : 127 - pos); p.ac[(size_t)r * 32 + col] = base + v[i]; }
}
template <int OFF>
__device__ __forceinline__ void tr_frag4b(bf16x8 (&f)[4], unsigned a, int step) { tr_frag4<OFF>(f, a, a + step, a + 2 * step, a + 3 * step); }
constexpr int PBS = 288, PXS = 160, N_CSTATE = NCH * NH;
__device__ __forceinline__ void stage_cstate(PRef p, int item, char* lds) {
    const int tid = tidx(), wid = tid >> 6, lane = tid & 63, fr = lane & 15, fq = lane >> 4;
    const int cid = item >> 4, hh = item & 15, g = hh >> 2, row0 = cid * 128;
    char* LB = lds; char* LX = lds + 128 * PBS; float* wgt = (float*)(lds + 128 * PBS + 128 * PXS);
    __syncthreads();
#pragma unroll
    for (int i = 0; i < 8; ++i) { const int id = tid + 256 * i, r = id >> 4, o = id & 15;
        *(uint4*)(LB + r * PBS + o * 16) = *(const uint4*)(p.V + (size_t)(row0 + r) * 2048 + 1024 + g * NS + o * 8); }
#pragma unroll
    for (int i = 0; i < 4; ++i) { const int id = tid + 256 * i, r = id >> 3, o = id & 7;
        *(uint4*)(LX + r * PXS + o * 16) = *(const uint4*)(p.V + (size_t)(row0 + r) * 2048 + hh * HD + o * 8); }
    { const int d = tid >> 7, l = tid & 127; const int col = d * 16 + hh;
      const float tot = p.ac[(size_t)(row0 + (d == 0 ? 127 : 0)) * 32 + col];
      wgt[tid] = p.dt[(size_t)(row0 + l) * 32 + col] * __expf(tot - p.ac[(size_t)(row0 + l) * 32 + col]); }
    __syncthreads();
    const int d = wid >> 1, nh = wid & 1;
    f32x4 acc[4][4];
#pragma unroll
    for (int a = 0; a < 4; ++a)
#pragma unroll
        for (int b = 0; b < 4; ++b) acc[a][b] = (f32x4){0.f, 0.f, 0.f, 0.f};
    const unsigned rowoff = 8 * fq + (fr >> 2), coloff = 4 * (fr & 3);
    const unsigned baseB = lds_addr(LB) + rowoff * PBS + (nh * 64 + coloff) * 2, baseX = lds_addr(LX) + rowoff * PXS + coloff * 2;
#pragma unroll
    for (int ks = 0; ks < 4; ++ks) {
        bf16x8 bt[4], xr[4], xs[4];
        tr_frag4b<4 * PBS>(bt, baseB + ks * 32 * PBS, 32);
        tr_frag4b<4 * PXS>(xr, baseX + ks * 32 * PXS, 32);
        const f32x4 w0 = *(const f32x4*)(wgt + d * 128 + ks * 32 + 8 * fq), w1 = *(const f32x4*)(wgt + d * 128 + ks * 32 + 8 * fq + 4);
#pragma unroll
        for (int pt = 0; pt < 4; ++pt)
#pragma unroll
            for (int e = 0; e < 8; ++e) xs[pt][e] = (short)f2bf(bf2f((bf16_t)xr[pt][e]) * (e < 4 ? w0[e & 3] : w1[e & 3]));
#pragma unroll
        for (int nt = 0; nt < 4; ++nt)
#pragma unroll
            for (int pt = 0; pt < 4; ++pt) acc[nt][pt] = __builtin_amdgcn_mfma_f32_16x16x32_bf16(bt[nt], xs[pt], acc[nt][pt], 0, 0, 0);
    }
    bf16_t* o = p.Scs + ((size_t)((cid * 2 + d) * 16 + hh) * 64) * NS + nh * 64 + 4 * fq;
#pragma unroll
    for (int pt = 0; pt < 4; ++pt)
#pragma unroll
        for (int nt = 0; nt < 4; ++nt) { uint2 q; q.x = pack2(acc[nt][pt][0], acc[nt][pt][1]); q.y = pack2(acc[nt][pt][2], acc[nt][pt][3]);
            *(uint2*)(o + (size_t)(pt * 16 + fr) * NS + nt * 16) = q; }
}
constexpr int N_SCAN = NB * 2 * NH * HD * 16 / 256;
__device__ __forceinline__ void stage_scan(PRef p, int item) {
    const int idx = item * 256 + tidx(), n8 = idx & 15, pp = (idx >> 4) & 63, hh = (idx >> 10) & 15, d = (idx >> 14) & 1, b = idx >> 15;
    float s[8];
#pragma unroll
    for (int i = 0; i < 8; ++i) s[i] = 0.f;
#pragma unroll 4
    for (int t = 0; t < 66; ++t) {
        const int cid = t < 2 ? 128 + b * 2 + (d == 0 ? t : 1 - t) : b * 64 + (d == 0 ? t - 2 : 65 - t);
        const size_t o = ((size_t)((cid * 2 + d) * 16 + hh) * 64 + pp) * NS + n8 * 8;
        uint4 q; q.x = pack2(s[0], s[1]); q.y = pack2(s[2], s[3]); q.z = pack2(s[4], s[5]); q.w = pack2(s[6], s[7]);
        *(uint4*)(p.Sst + o) = q;
        const uint4 c = *(const uint4*)(p.Scs + o);
        const float dec = __expf(p.ac[(size_t)(cid * 128 + (d == 0 ? 127 : 0)) * 32 + d * 16 + hh]);
        s[0] = s[0] * dec + lo16(c.x); s[1] = s[1] * dec + hi16(c.x); s[2] = s[2] * dec + lo16(c.y); s[3] = s[3] * dec + hi16(c.y);
        s[4] = s[4] * dec + lo16(c.z); s[5] = s[5] * dec + hi16(c.z); s[6] = s[6] * dec + lo16(c.w); s[7] = s[7] * dec + hi16(c.w);
    }
}
constexpr int N_SSDOUT = 128 * 4 + 4 * 4 * 4;
__device__ __forceinline__ void stage_ssdout(PRef p, int layer, int item, char* lds) {
    const int tid = tidx(), wid = tid >> 6, lane = tid & 63, fr = lane & 15, fq = lane >> 4;
    int cid, g, h0, nh;
    if (item < 512) { cid = item >> 2; g = item & 3; h0 = 0; nh = 4; } else { const int it = item - 512; cid = 128 + (it >> 4); g = (it >> 2) & 3; h0 = it & 3; nh = 1; }
    const int row0 = cid * 128;
    char* LX = lds; float* acd = (float*)(lds + 128 * PXS); float* dtd = acd + 256;
    char* SB = lds + 128 * PXS + 2048;
    const int srow = tid >> 4, sslot = tid & 15, schunk = (sslot ^ (srow & 15)) * 8;
    __syncthreads();
#pragma unroll
    for (int i = 0; i < 8; ++i) __builtin_amdgcn_global_load_lds((const unsigned*)(p.V + (size_t)(row0 + srow + 16 * i) * 2048 + 1024 + g * NS + schunk), (unsigned*)(SB + i * 4096 + tid * 16), 16, 0, 0);
    bf16x8 cf[2][4];
#pragma unroll
    for (int lt = 0; lt < 2; ++lt)
#pragma unroll
        for (int ks = 0; ks < 4; ++ks) cf[lt][ks] = *(const bf16x8*)(p.V + (size_t)(row0 + wid * 32 + lt * 16 + fr) * 2048 + 1536 + g * NS + ks * 32 + fq * 8);
    asm volatile("s_waitcnt vmcnt(0)" ::: "memory");
    __syncthreads();
    f32x4 cbt[8][2];
#pragma unroll
    for (int st = 0; st < 8; ++st) {
        bf16x8 bfA[4];
#pragma unroll
        for (int ks = 0; ks < 4; ++ks) bfA[ks] = *(const bf16x8*)(SB + (st * 16 + fr) * 256 + (((ks * 4 + fq) ^ fr) * 16));
#pragma unroll
        for (int lt = 0; lt < 2; ++lt) { f32x4 a = {0.f, 0.f, 0.f, 0.f};
#pragma unroll
            for (int ks = 0; ks < 4; ++ks) a = __builtin_amdgcn_mfma_f32_16x16x32_bf16(bfA[ks], cf[lt][ks], a, 0, 0, 0);
            cbt[st][lt] = a; }
    }
    const unsigned baseX = lds_addr(LX) + (4 * fq + (fr >> 2)) * PXS + 4 * (fr & 3) * 2;
#pragma unroll 1
    for (int hi = h0; hi < h0 + nh; ++hi) {
        const int hh = g * 4 + hi;
        float ssq[2] = {0.f, 0.f};
        __syncthreads();
        { const int t2 = tidx(), srow2 = t2 >> 4, schunk2 = ((t2 & 15) ^ (srow2 & 15)) * 8;
#pragma unroll
        for (int d = 0; d < 2; ++d) { const bf16_t* S = p.Sst + ((size_t)((cid * 2 + d) * 16 + hh) * 64) * NS;
#pragma unroll
            for (int i = 0; i < 4; ++i) __builtin_amdgcn_global_load_lds((const unsigned*)(S + (size_t)(srow2 + 16 * i) * NS + schunk2), (unsigned*)(SB + d * 16384 + i * 4096 + t2 * 16), 16, 0, 0); } }
#pragma unroll
        for (int i = 0; i < 4; ++i) { const int id = tid + 256 * i, r = id >> 3, o = id & 7;
            *(uint4*)(LX + r * PXS + o * 16) = *(const uint4*)(p.V + (size_t)(row0 + r) * 2048 + hh * HD + o * 8); }
        { const int d = tid >> 7, l = tid & 127; acd[tid] = p.ac[(size_t)(row0 + l) * 32 + d * 16 + hh]; dtd[tid] = p.dt[(size_t)(row0 + l) * 32 + d * 16 + hh]; }
        asm volatile("s_waitcnt vmcnt(0)" ::: "memory");
        __syncthreads();
        f32x4 yacc[4][2];
#pragma unroll
        for (int pt = 0; pt < 4; ++pt) { yacc[pt][0] = (f32x4){0.f, 0.f, 0.f, 0.f}; yacc[pt][1] = (f32x4){0.f, 0.f, 0.f, 0.f}; }
#pragma unroll
        for (int d = 0; d < 2; ++d) {
            const float el0 = acd[d * 128 + wid * 32 + fr], el1 = acd[d * 128 + wid * 32 + 16 + fr];
#pragma unroll
            for (int ks = 0; ks < 4; ++ks) {
                if (d == 0 ? ks > wid : ks < wid) continue;
                const int s0 = 32 * ks + 4 * fq;
                const f32x4 as0 = *(const f32x4*)(acd + d * 128 + s0), as1 = *(const f32x4*)(acd + d * 128 + s0 + 16);
                const f32x4 ds0 = *(const f32x4*)(dtd + d * 128 + s0), ds1 = *(const f32x4*)(dtd + d * 128 + s0 + 16);
                bf16x8 gf[2];
#pragma unroll
                for (int lt = 0; lt < 2; ++lt) {
                    const int l = wid * 32 + lt * 16 + fr; const float el = lt ? el1 : el0;
#pragma unroll
                    for (int e = 0; e < 4; ++e) {
                        const int sa = s0 + e, sb = s0 + 16 + e;
                        const bool ma = d == 0 ? (sa <= l) : (sa >= l), mb = d == 0 ? (sb <= l) : (sb >= l);
                        const float va = ma ? cbt[2 * ks][lt][e] * __expf(fminf(el - as0[e], 0.f)) * ds0[e] : 0.f;
                        const float vb = mb ? cbt[2 * ks + 1][lt][e] * __expf(fminf(el - as1[e], 0.f)) * ds1[e] : 0.f;
                        gf[lt][e] = (short)f2bf(va); gf[lt][4 + e] = (short)f2bf(vb);
                    }
                }
                bf16x8 xf[4];
                tr_frag4b<16 * PXS>(xf, baseX + ks * 32 * PXS, 32);
#pragma unroll
                for (int pt = 0; pt < 4; ++pt) { yacc[pt][0] = __builtin_amdgcn_mfma_f32_16x16x32_bf16(xf[pt], gf[0], yacc[pt][0], 0, 0, 0);
                                                 yacc[pt][1] = __builtin_amdgcn_mfma_f32_16x16x32_bf16(xf[pt], gf[1], yacc[pt][1], 0, 0, 0); }
            }
            const float ex0 = __expf(el0), ex1 = __expf(el1);
            const char* S = SB + d * 16384;
#pragma unroll
            for (int pt = 0; pt < 4; ++pt) {
                f32x4 o0 = {0.f, 0.f, 0.f, 0.f}, o1 = {0.f, 0.f, 0.f, 0.f};
#pragma unroll
                for (int ks = 0; ks < 4; ++ks) { const bf16x8 sf = *(const bf16x8*)(S + (pt * 16 + fr) * 256 + (((ks * 4 + fq) ^ fr) * 16));
                    o0 = __builtin_amdgcn_mfma_f32_16x16x32_bf16(sf, cf[0][ks], o0, 0, 0, 0); o1 = __builtin_amdgcn_mfma_f32_16x16x32_bf16(sf, cf[1][ks], o1, 0, 0, 0); }
                yacc[pt][0] += o0 * ex0; yacc[pt][1] += o1 * ex1;
            }
        }
        const float dsk = p.d_skip[layer * NH + hh];
#pragma unroll
        for (int lt = 0; lt < 2; ++lt) {
            const int l = wid * 32 + lt * 16 + fr; const size_t row = (size_t)(row0 + l);
#pragma unroll
            for (int pt = 0; pt < 4; ++pt) {
                const int pc = pt * 16 + 4 * fq;
                const uint2 xq = *(const uint2*)(LX + l * PXS + pc * 2);
                const uint2 zq = *(const uint2*)(p.U + row * UC + U_Z + hh * HD + pc);
                const float xv[4] = {lo16(xq.x), hi16(xq.x), lo16(xq.y), hi16(xq.y)}, zv[4] = {lo16(zq.x), hi16(zq.x), lo16(zq.y), hi16(zq.y)};
                float o[4];
#pragma unroll
                for (int j = 0; j < 4; ++j) { o[j] = (yacc[pt][lt][j] + dsk * xv[j]) * siluf_(zv[j]); ssq[lt] += o[j] * o[j]; }
                uint2 q; q.x = pack2(o[0], o[1]); q.y = pack2(o[2], o[3]);
                *(uint2*)(p.yc + row * D + hh * HD + pc) = q;
            }
        }
#pragma unroll
        for (int lt = 0; lt < 2; ++lt) { float s = ssq[lt]; s += __shfl_xor(s, 16); s += __shfl_xor(s, 32);
            if (fq == 0) p.ssq[(size_t)(row0 + wid * 32 + lt * 16 + fr) * 16 + hh] = s; }
    }
}

constexpr int N_SSD = NB * NH * 16;
__device__ __forceinline__ void stage_ssd_naive(PRef p, int layer, int item) {
    const int wave = tidx() >> 6, lane = tidx() & 63;
    const int b = item / 256, h = (item % 256) / 16, pp = (item % 16) * 4 + wave, g = h >> 2;
    const float dsk = p.d_skip[layer * NH + h];
#pragma unroll 1
    for (int d = 0; d < 2; ++d) {
        const float Ad = -__expf(p.a_log[(layer * 2 + d) * NH + h]);
        float s0 = 0.f, s1 = 0.f;
#pragma unroll 4
        for (int t = 0; t < CTXL + SEQ; ++t) {
            int row;
            if (d == 0) row = t < CTXL ? TL + b * CTXL + t : b * SEQ + (t - CTXL);
            else        row = t < CTXL ? TL + b * CTXL + (CTXL - 1 - t) : b * SEQ + (SEQ - 1 - (t - CTXL));
            const float dtv = p.dt[(size_t)row * 32 + d * 16 + h];
            const bf16_t* vr = p.V + (size_t)row * 2048;
            const float xv = bf2f(vr[h * HD + pp]);
            const unsigned Bq = *(const unsigned*)(vr + 1024 + g * NS + 2 * lane), Cq = *(const unsigned*)(vr + 1536 + g * NS + 2 * lane);
            const float dec = __expf(dtv * Ad), dx = dtv * xv;
            s0 = s0 * dec + dx * lo16(Bq); s1 = s1 * dec + dx * hi16(Bq);
            float y = wave_sum(s0 * lo16(Cq) + s1 * hi16(Cq));
            if (lane == 0) {
                const size_t o = (size_t)row * D + h * HD + pp;
                if (d == 0) p.ybuf[o] = y;
                else { const float tot = p.ybuf[o] + y + dsk * xv; const float z = bf2f(p.U[(size_t)row * UC + U_Z + h * HD + pp]); p.ycraw[o] = tot * siluf_(z); }
            }
        }
    }
}
__device__ __forceinline__ void stage_ycnorm(PRef p, int layer, int item) {
    const int wave = tidx() >> 6, lane = tidx() & 63, row = item * 4 + wave;
    f32x4 v[4]; float ss = 0.f;
#pragma unroll
    for (int j = 0; j < 4; ++j) { v[j] = *(const f32x4*)(p.ycraw + (size_t)row * D + 4 * lane + 256 * j); ss += v[j][0] * v[j][0] + v[j][1] * v[j][1] + v[j][2] * v[j][2] + v[j][3] * v[j][3]; }
    ss = wave_sum(ss); const float rinv = rsqrtf(ss * (1.0f / D) + RMS_EPS);
#pragma unroll
    for (int j = 0; j < 4; ++j) { const int k = 4 * lane + 256 * j; const f32x4 w = *(const f32x4*)(p.ssm_norm_w + layer * D + k); const f32x4 o = v[j] * rinv * w;
        uint2 q; q.x = pack2(o[0], o[1]); q.y = pack2(o[2], o[3]); *(uint2*)(p.yc + (size_t)row * D + k) = q; }
}

constexpr int N_ROUTER = T / 32, HSP = 1028;
__device__ __forceinline__ void stage_router(PRef p, int layer, int item, char* lds) {
    const int tid = tidx(), wave = tid >> 6, lane = tid & 63;
    float* hs = (float*)lds;
    float* part = hs + 16 * HSP;
    int* pe = (int*)(part + 4 * 16 * 32);
    int* hist = pe + 256;
    int* rank = hist + 32;
    const float* nw = p.norm2_w + layer * D;
    __syncthreads();
    if (tid < 32) hist[tid] = 0;
#pragma unroll 1
    for (int rnd = 0; rnd < 2; ++rnd) {
        const int rowb = item * 32 + rnd * 16;
#pragma unroll 1
        for (int t = 0; t < 4; ++t) {
            const int tl = wave * 4 + t, row = rowb + tl, mrow = modrow(row);
            const float* sh = modp(p, layer, mrow, 3); const float* sc = modp(p, layer, mrow, 4);
            f32x4 v[4]; float ss = 0.f;
#pragma unroll
            for (int j = 0; j < 4; ++j) { v[j] = *(const f32x4*)(p.res + (size_t)row * D + 4 * lane + 256 * j); ss += v[j][0] * v[j][0] + v[j][1] * v[j][1] + v[j][2] * v[j][2] + v[j][3] * v[j][3]; }
            ss = wave_sum(ss); const float rinv = rsqrtf(ss * (1.0f / D) + RMS_EPS);
#pragma unroll
            for (int j = 0; j < 4; ++j) {
                const int k = 4 * lane + 256 * j;
                const f32x4 w = *(const f32x4*)(nw + k), a = *(const f32x4*)(sc + k), bb = *(const f32x4*)(sh + k);
                const f32x4 hv = v[j] * rinv * w * (a + 1.0f) + bb;
                uint2 q; q.x = pack2(hv[0], hv[1]); q.y = pack2(hv[2], hv[3]);
                *(uint2*)(p.h + (size_t)row * D + k) = q;
                *(f32x4*)(hs + tl * HSP + k) = hv;
            }
        }
        __syncthreads();
        {
            const int i = lane & 15, kq = lane >> 4;
            const float* rw = p.router_w + (size_t)layer * D * NE + (lane & 15);
            f32x4 a0 = {0.f, 0.f, 0.f, 0.f}, a1 = {0.f, 0.f, 0.f, 0.f};
#pragma unroll 4
            for (int q = 0; q < 16; ++q) {
                const int kb = wave * 256 + q * 16 + kq * 4;
                const f32x4 av = *(const f32x4*)(hs + i * HSP + kb);
#pragma unroll
                for (int j = 0; j < 4; ++j) {
                    const float b0 = rw[(size_t)(kb + j) * NE], b1 = rw[(size_t)(kb + j) * NE + 16];
                    a0 = __builtin_amdgcn_mfma_f32_16x16x4f32(av[j], b0, a0, 0, 0, 0);
                    a1 = __builtin_amdgcn_mfma_f32_16x16x4f32(av[j], b1, a1, 0, 0, 0);
                }
            }
#pragma unroll
            for (int r = 0; r < 4; ++r) { part[(wave * 16 + 4 * kq + r) * 32 + i] = a0[r]; part[(wave * 16 + 4 * kq + r) * 32 + 16 + i] = a1[r]; }
        }
        __syncthreads();
        if (tid < 16) {
            float lg[32];
#pragma unroll
            for (int e = 0; e < 32; ++e) lg[e] = part[(0 * 16 + tid) * 32 + e] + part[(1 * 16 + tid) * 32 + e] + part[(2 * 16 + tid) * 32 + e] + part[(3 * 16 + tid) * 32 + e] + p.router_b[layer * NE + e];
            float tv[4]; int ti[4];
#pragma unroll
            for (int r = 0; r < 4; ++r) {
                float bv = -3.0e38f; int bi = 0;
#pragma unroll
                for (int e = 0; e < 32; ++e) { const bool tk = (r > 0 && ti[0] == e) || (r > 1 && ti[1] == e) || (r > 2 && ti[2] == e); if (!tk && lg[e] > bv) { bv = lg[e]; bi = e; } }
                tv[r] = bv; ti[r] = bi;
            }
            const int row = rowb + tid;
            const float e1 = __expf(tv[1] - tv[0]), e2 = __expf(tv[2] - tv[0]), e3 = __expf(tv[3] - tv[0]); const float inv = 1.0f / (1.0f + e1 + e2 + e3);
            *(f32x4*)(p.topw + (size_t)row * 4) = (f32x4){inv, e1 * inv, e2 * inv, e3 * inv};
#pragma unroll
            for (int r = 0; r < 4; ++r) { p.topi[row * 4 + r] = ti[r]; pe[(rnd * 16 + tid) * 4 + r] = ti[r]; }
        }
        __syncthreads();
    }
    if (tid < 128) rank[tid] = atomicAdd(&hist[pe[tid]], 1);
    __syncthreads();
    if (tid < 32) { const int c = hist[tid]; hist[tid] = c ? atomicAdd(&p.cnt[layer * NE + tid], c) : 0; }
    __syncthreads();
    if (tid < 128) { const int e = pe[tid]; p.list[(size_t)(layer * NE + e) * T + hist[e] + rank[tid]] = (item * 32 + (tid >> 2)) * 4 + (tid & 3); }
}

#define XB_TMO      128
#define XB_XCNT(j)  (256  + 64 * (j))
#define XB_XSUB(j)  (1280 + 64 * (j))
#define XB_XGEN(j)  (2304 + 64 * (j))
#define XB_TOP      3328
#define XB_TOPGEN   3392
#define XCD_BAR_WORDS 3456
#define XB_SPIN_CAP (1u << 22)
#define LAS __attribute__((address_space(3)))
__device__ __forceinline__ unsigned xb_ld(unsigned* p)              { return __hip_atomic_load(p, __ATOMIC_RELAXED, __HIP_MEMORY_SCOPE_AGENT); }
__device__ __forceinline__ unsigned xb_add(unsigned* p, unsigned v) { return __hip_atomic_fetch_add(p, v, __ATOMIC_RELAXED, __HIP_MEMORY_SCOPE_AGENT); }
__device__ __forceinline__ unsigned xb_xcc_id() { return (unsigned)__builtin_amdgcn_s_getreg((3 << 11) | 20) & 0xFu; }
#define XB_SPIN(cond, bar) do { unsigned _sp = 0; while (cond) { __builtin_amdgcn_s_sleep(1); \
    if ((++_sp & 255u) == 0u) { if (xb_ld(&(bar)[XB_TMO])) break; if (_sp > XB_SPIN_CAP) { atomicAdd(&(bar)[XB_TMO], 1u); break; } } } } while (0)
struct XcdBarrier { unsigned* bar; unsigned x; volatile LAS unsigned* st; };
__device__ __forceinline__ XcdBarrier xcd_barrier_post(unsigned* bar, volatile LAS unsigned* st) {
    XcdBarrier b; b.bar = bar; b.x = xb_xcc_id(); b.st = st;
    if (threadIdx.x == 0) st[2] = xb_add(&bar[XB_XCNT(b.x)], 1u);
    return b;
}
__device__ __forceinline__ void xcd_barrier_complete(unsigned* bar, unsigned x, unsigned& nloc, unsigned& nx, unsigned& rank) {
    const unsigned G = gridDim.x * gridDim.y * gridDim.z;
    unsigned sum, cnt, mine, sp = 0u;
    for (;;) {
        sum = 0u; cnt = 0u; mine = 0u;
#pragma unroll
        for (unsigned j = 0; j < 16; ++j) { const unsigned c = xb_ld(&bar[XB_XCNT(j)]); sum += c; cnt += (c > 0u) ? 1u : 0u; }
        mine = xb_ld(&bar[XB_XCNT(x)]);
        rank = 0u;
#pragma unroll
        for (unsigned j = 0; j < 16; ++j) rank += (j < x && xb_ld(&bar[XB_XCNT(j)]) > 0u) ? 1u : 0u;
        if (sum == G) break;
        __builtin_amdgcn_s_sleep(1);
        if ((++sp & 255u) == 0u) { if (xb_ld(&bar[XB_TMO])) break; if (sp > XB_SPIN_CAP) { atomicAdd(&bar[XB_TMO], 1u); break; } }
    }
    nloc = mine > 0u ? mine : 1u; nx = cnt > 0u ? cnt : 1u;
}
__device__ __forceinline__ void xcd_barrier(const XcdBarrier& b) {
    asm volatile("s_waitcnt vmcnt(0)" ::: "memory");
    __syncthreads();
    if (threadIdx.x == 0) {
        unsigned* bar = b.bar;
        __builtin_amdgcn_s_waitcnt(0);
        unsigned nloc = b.st[0], nx = b.st[1];
        if (nloc == 0u) { unsigned rk = 0u; xcd_barrier_complete(bar, b.x, nloc, nx, rk); b.st[0] = nloc; b.st[1] = nx; b.st[3] = rk; }
        const unsigned old = xb_add(&bar[XB_XSUB(b.x)], 1u);
        const unsigned gen = old / nloc;
        if (old + 1u == (gen + 1u) * nloc) {
            __builtin_amdgcn_fence(__ATOMIC_RELEASE, "agent");
            asm volatile("s_waitcnt vmcnt(0)" ::: "memory");
            const unsigned og = xb_add(&bar[XB_TOP], 1u);
            const unsigned tg = og / nx;
            if (og + 1u == (tg + 1u) * nx) xb_add(&bar[XB_TOPGEN], 1u);
            else XB_SPIN(xb_ld(&bar[XB_TOPGEN]) == tg, bar);
            __builtin_amdgcn_fence(__ATOMIC_ACQUIRE, "agent");
            xb_add(&bar[XB_XGEN(b.x)], 1u);
            asm volatile("s_waitcnt vmcnt(0)" ::: "memory");
        } else {
            XB_SPIN(xb_ld(&bar[XB_XGEN(b.x)]) == gen, bar);
            __builtin_amdgcn_fence(__ATOMIC_ACQUIRE, "agent");
            asm volatile("s_waitcnt vmcnt(0)" ::: "memory");
        }
    }
    __syncthreads();
}

namespace cg = cooperative_groups;
#define PHASE_LOOP(n) for (int item = bid; item < (n); item += G)
#define XSHARE(n, r) ((int)(((long)(n) * (r)) >> xsh))
#define XPHASE_LOOP(n, base) for (int pr_ = XSHARE((n) >> 1, xrank) + xslot, pe_ = XSHARE((n) >> 1, xrank + 1); pr_ < pe_; pr_ += xper) if (const int item = (base) + 2 * pr_ + hf; true)
#define XPHASE8_LOOP(n) for (int item = XSHARE(n, xrank) + xslot, item_end = XSHARE(n, xrank + 1); item < item_end; item += xper)
__global__ void __launch_bounds__(512, 2) hybrid_megakernel(Params p_by_value) {
    CParams* kp = (CParams*)__builtin_amdgcn_kernarg_segment_ptr();
#define p (*launder(kp))
    __shared__ __attribute__((aligned(16))) char lds_all[2 * LDS_BYTES + 16];
#define xb_words (*(uint4*)(lds_all + 2 * LDS_BYTES))
    if (threadIdx.x == 0) xb_words = make_uint4(0u, 0u, 0u, 0u);
    __syncthreads();
    XcdBarrier bar = xcd_barrier_post(p.bar, (volatile LAS unsigned*)&xb_words);
    const int half = __builtin_amdgcn_readfirstlane((int)(threadIdx.x >> 8));
    const int GB0 = gridDim.x, half0 = half;
    constexpr int PH_PER_LAYER = 11, N_PHASES = 1 + DEPTH * PH_PER_LAYER + 1;
#pragma unroll 1
    for (int ph = 0; ph < N_PHASES; ++ph) {
        const int l = ph == 0 ? 0 : (ph - 1) / PH_PER_LAYER, sub = ph == 0 ? -1 : (ph == N_PHASES - 1 ? 99 : (ph - 1) % PH_PER_LAYER);
        int GB = GB0, bb = (int)blockIdx.x, hf = half0; asm volatile("" : "+s"(GB), "+s"(bb), "+s"(hf));
        const int G = 2 * GB, bid = 2 * bb + hf; char* lds = lds_all + hf * LDS_BYTES;
        const int xsh = GB >= 8 ? 3 : 0, xrank = GB >= 8 ? (bb & 7) : 0, xslot = GB >= 8 ? (bb >> 3) : bb, xper = GB >= 8 ? ((GB - xrank + 7) >> 3) : GB;
        for (int rep = 0; rep < ((sub == REPEAT_SUB) ? 2 : 1); ++rep) {
        if (rep) xcd_barrier(bar);
        switch (sub) {
        case -1: {
            PHASE_LOOP(N_TABLE) stage_table(p, item);
            static_assert(((N_FOLD + N_ADA) / 2) * 32 * 2 >= N_CONVERT && (N_FOLD % 2) == 0 && (N_ADA % 2) == 0 && (N_CONVERT % 2) == 0, "prep pairing");
            for (int pi = bb; pi < ((N_FOLD + N_ADA) / 2) * 33; pi += GB) {
                const int q = pi / 33, r = pi % 33;
                if (r == 0) { const int it = 2 * q + hf; if (it < N_FOLD) stage_fold(p, it, lds); else stage_ada(p, it - N_FOLD, lds); }
                else { const int cv = 2 * (q * 32 + (r - 1)) + hf; if (cv < N_CONVERT) stage_convert(p, cv, lds); }
            }
        } break;
        case 0:
            if (l == 0) { PHASE_LOOP(N_ROWNORM) stage_rownorm<0>(p, l, item); } else { PHASE_LOOP(N_ROWNORM) stage_rownorm<1>(p, l, item); }
            break;
        case 1: XPHASE8_LOOP(N_INPROJ) stage_inproj(p, l, item, lds_all); break;
        case 2:
            PHASE_LOOP(N_POOL) stage_pool(p, item);
            PHASE_LOOP(N_FOURA) stage_fourA(p, item, lds);
            PHASE_LOOP(N_CONV) stage_conv(p, l, item);
            PHASE_LOOP(N_ACSUM) stage_acsum(p, l, item, lds);
            break;
        case 3:
            PHASE_LOOP(N_FOURB) stage_fourB(p, item, lds);
            PHASE_LOOP(N_CSTATE) stage_cstate(p, item, lds);
            break;
        case 4:
            PHASE_LOOP(N_SCAN) stage_scan(p, item);
            XPHASE_LOOP(N_G1024, 0) stage_gemm_small<1>(p, l, item, lds);
            break;
        case 5:
            PHASE_LOOP(512) stage_ssdout(p, l, item, lds);
            if (l != DEPTH - 1) { for (int item = 512 + bid; item < N_SSDOUT; item += G) stage_ssdout(p, l, item, lds); }
            break;
        case 6: XPHASE_LOOP(l == DEPTH - 1 ? (TL / 128) * 8 : N_G1024, 0) stage_merge(p, l, item, lds); break;
        case 7: XPHASE_LOOP(l == DEPTH - 1 ? (TL / 128) * 8 : N_G1024, 0) stage_outproj(p, l, item, lds); break;
        case 8: PHASE_LOOP(l == DEPTH - 1 ? TL / 32 : N_ROUTER) stage_router(p, l, item, lds); break;
        case 9: { const int n1 = moe_total_mtiles(p, l) * 8; XPHASE8_LOOP(n1) stage_moe1(p, l, item, lds_all); } break;
        case 10: { const int n2 = moe_total_mtiles(p, l) * 4; XPHASE8_LOOP(n2) stage_moe2(p, l, item, lds_all); } break;
        default: PHASE_LOOP(TL / 4) stage_rownorm<2>(p, DEPTH - 1, item); break;
        }
        }
        if (ph == 0) cg::this_grid().sync();
        else if (ph != N_PHASES - 1) xcd_barrier(bar);
    }
#undef p
}

extern "C" void kernel_launch(void* const* d_in, const int* in_sizes, int n_in, void* d_out, int out_size, void* d_ws, size_t ws_size, hipStream_t stream) {
    Params p; memset(&p, 0, sizeof(p));
    const float** f = (const float**)&p;
    for (int i = 0; i < 26; ++i) f[i] = (const float*)d_in[i];
    p.out = (float*)d_out;
    char* w = (char*)d_ws; size_t off = 0;
    auto take = [&](size_t bytes) { char* r = w + off; off += (bytes + 255) & ~(size_t)255; return r; };
    p.bar = (unsigned*)take(16384); p.cnt = (int*)take(1024);
    p.mod = (float*)take((size_t)DEPTH * 3 * 6144 * 4);
    p.res = (float*)take((size_t)T * D * 4);
    p.dt = (float*)take((size_t)T * 32 * 4);
    p.ybuf = (float*)take((size_t)T * D * 4);
    p.ycraw = (float*)take((size_t)T * D * 4);
    p.topw = (float*)take((size_t)T * 4 * 4);
    p.topi = (int*)take((size_t)T * 4 * 4);
    p.list = (int*)take((size_t)DEPTH * NE * T * 4);
    p.h = (bf16_t*)take((size_t)T * D * 2);
    p.w_in_t = (bf16_t*)take((size_t)DEPTH * WIN_ROWS * D * 2);
    p.w_br_t = (bf16_t*)take((size_t)DEPTH * 3 * D * D * 2);
    p.w_out_t = (bf16_t*)take((size_t)DEPTH * D * D * 2);
    p.pool_w_t = (bf16_t*)take((size_t)DEPTH * 4 * 65536 * 2);
    p.w1_t = (bf16_t*)take((size_t)DEPTH * NE * 2048 * D * 2);
    p.w2_t = (bf16_t*)take((size_t)DEPTH * NE * D * D * 2);
    p.cs_t = (bf16_t*)take((size_t)256 * 512 * 2);
    p.tabA = (bf16_t*)take((size_t)128 * 128 * 64 * 2);
    p.tabB = (bf16_t*)take((size_t)256 * 256 * 2);
    p.tabC = (bf16_t*)take((size_t)2 * 256 * 256 * 2);
    p.Ap = (bf16_t*)take((size_t)NB * 64 * 256 * D * 2);
    p.Scs = (bf16_t*)take((size_t)NCH * 2 * NH * HD * NS * 2);
    p.Sst = (bf16_t*)take((size_t)NCH * 2 * NH * HD * NS * 2);
    p.ac = (float*)take((size_t)T * 32 * 4);
    p.ssq = (float*)take((size_t)T * 16 * 4);
    p.U = (bf16_t*)take((size_t)T * UC * 2);
    p.V = (bf16_t*)take((size_t)T * 2048 * 2);
    p.Dp = (bf16_t*)take((size_t)T * D * 2);
    p.ya = (bf16_t*)take((size_t)T * D * 2);
    p.Yb = (bf16_t*)take((size_t)T * 2048 * 2);
    p.yb = (bf16_t*)take((size_t)T * D * 2);
    p.yc = (bf16_t*)take((size_t)T * D * 2);
    p.m = (bf16_t*)take((size_t)T * D * 2);
    p.act = (bf16_t*)take((size_t)(T * 4 + 256) * D * 2);
    p.sout = (bf16_t*)take((size_t)T * 4 * D * 2);
    if (off > ws_size) { fprintf(stderr, "workspace too small: need %zu have %zu\n", off, ws_size); return; }
    static int grid_blocks = 0;
    if (!grid_blocks) {
        int dev = 0, cus = 0, per_cu = 0;
        (void)hipGetDevice(&dev);
        (void)hipDeviceGetAttribute(&cus, hipDeviceAttributeMultiprocessorCount, dev);
        (void)hipOccupancyMaxActiveBlocksPerMultiprocessor(&per_cu, hybrid_megakernel, 512, 0);
        if (per_cu > 1) per_cu = 1;
        if (per_cu < 1) per_cu = 1;
        grid_blocks = cus * per_cu;
    }
    (void)hipMemsetAsync(p.bar, 0, 16384 + 1024, stream);
    void* args[] = {&p};
    hipError_t e = hipLaunchCooperativeKernel((void*)hybrid_megakernel, dim3(grid_blocks), dim3(512), args, 0, stream);
    if (e != hipSuccess) fprintf(stderr, "cooperative launch failed: %s (grid %d)\n", hipGetErrorString(e), grid_blocks);
}
```

```cpp
#include <hip/hip_runtime.h>
#include <hip/hip_cooperative_groups.h>
#include <cstdio>
#include <cstdint>
#include <cstring>

typedef unsigned short bf16_t;
typedef short bf16x8 __attribute__((ext_vector_type(8)));
typedef float f32x4 __attribute__((ext_vector_type(4)));

constexpr int D = 1024, NB = 2, SEQ = 8192, TL = NB * SEQ, CTXL = 256, TC = NB * CTXL, T = TL + TC;
constexpr int DEPTH = 2, NE = 32, TOPK = 4, NH = 16, HD = 64, NS = 128;
constexpr int IN_COLS = 8224, UC = 8192;
constexpr int U_FOUR = 1024, U_Z = 2048, U_XBC = 3072, U_GATE = 5120;
constexpr int WIN_ROWS = 8448;
constexpr float RMS_EPS = 1e-6f;
constexpr int LDS_BYTES = 77824;
#ifndef REPEAT_SUB
#define REPEAT_SUB -2
#endif
#ifndef NAIVE_FOUR
#define NAIVE_FOUR 0
#endif
#ifndef NAIVE_SSD
#define NAIVE_SSD 0
#endif

struct Params {
    const float *x, *c, *ctx, *c_ctx, *w_ada, *b_ada, *norm1_w, *norm2_w, *w_in, *pool_w, *pool_scale, *conv_w, *conv_b, *dt_bias, *a_log,
        *d_skip, *ssm_norm_w, *w_branch, *w_out, *router_w, *router_b, *moe_w1, *moe_b1, *moe_w2, *moe_b2, *final_norm_w;
    float* out;
    unsigned* bar; int* cnt;
    float *mod, *res, *dt, *ybuf, *ycraw, *topw, *ac, *ssq;
    bf16_t *h, *w_in_t, *w_br_t, *w_out_t, *pool_w_t, *w1_t, *w2_t, *cs_t, *U, *V, *Dp, *ya, *Yb, *yb, *yc, *m, *act, *sout, *tabA, *tabB, *tabC, *Ap, *Scs, *Sst;
    int *topi, *list;
};

typedef const __attribute__((address_space(4))) Params CParams;
typedef CParams& PRef;
__device__ __forceinline__ CParams* launder(CParams* kp) { asm volatile("" : "+s"(kp)); return kp; }
typedef unsigned u32x4v __attribute__((ext_vector_type(4)));
__device__ __forceinline__ int lane_id_() { int l; asm volatile("v_mbcnt_lo_u32_b32 %0, -1, 0\n\tv_mbcnt_hi_u32_b32 %0, -1, %0" : "=&v"(l)); return l; }
__device__ __forceinline__ int tid_lo_(int wv) { int t = ((wv & 3) << 6) | lane_id_(); asm volatile("" : "+v"(t)); return t; }
__device__ __forceinline__ int tid_all_(int wv) { int t = (wv << 6) | lane_id_(); asm volatile("" : "+v"(t)); return t; }
#define tidx() tid_lo_(wv__)
#define tidx8() tid_all_(wv__)
__device__ __forceinline__ float bf2f(bf16_t u) { return __uint_as_float(((unsigned)u) << 16); }
typedef __bf16 bf16n2 __attribute__((ext_vector_type(2)));
typedef float f32x2n __attribute__((ext_vector_type(2)));
__device__ __forceinline__ bf16_t f2bf(float f) { return __builtin_bit_cast(bf16_t, (__bf16)f); }
__device__ __forceinline__ unsigned pack2(float a, float b) { return __builtin_bit_cast(unsigned, __builtin_convertvector((f32x2n){a, b}, bf16n2)); }
__device__ __forceinline__ float lo16(unsigned u) { return __uint_as_float(u << 16); }
#define RESB(p_) ((bf16_t*)(p_).res)
__device__ __forceinline__ float hi16(unsigned u) { return __uint_as_float(u & 0xffff0000u); }
__device__ __forceinline__ float sigmoidf_(float x) { return __builtin_amdgcn_rcpf(1.0f + __expf(-x)); }
__device__ __forceinline__ float siluf_(float x) { return x * __builtin_amdgcn_rcpf(1.0f + __expf(-x)); }
__device__ __forceinline__ float softplusf_(float x) { return x > 20.f ? x : log1pf(__expf(x)); }
__device__ __forceinline__ int modrow(int row) { return row < TL ? (row / SEQ) : 2; }
__device__ __forceinline__ const float* modp(PRef p, int layer, int mrow, int j) { return p.mod + ((size_t)((layer * 3 + mrow) * 6 + j)) * D; }
__device__ __forceinline__ float wave_sum(float v) {
#pragma unroll
    for (int o = 32; o >= 1; o >>= 1) v += __shfl_xor(v, o);
    return v;
}

__device__ __forceinline__ int colmap(int mode, int j) {
    if (mode == 0) return j;
    if (mode == 1) { if (j < 5120) return j; if (j < 8192) return j + 32; if (j < 8224) return 5120 + (j - 8192); return -1; }
    const int Tn = j >> 7, wc = (j >> 6) & 1, jj = j & 63, fq = jj >> 4, n = (jj >> 2) & 3;
    return (n < 2 ? 0 : 1024) + Tn * 64 + wc * 32 + 8 * fq + 4 * (n & 1) + (jj & 3);
}
__device__ __forceinline__ void convert_tile(const int wv__, const float* __restrict__ src, int ld, bf16_t* __restrict__ dst, int K, int n0, int k0, int mode, char* lds, const float* kscale = nullptr) {
    const int tid = tidx(), w = tid >> 6, lane = tid & 63;
    float* tile = (float*)lds + w * (64 * 65);
    const int kb = k0 + 64 * w;
    { const int n4 = (lane & 15) * 4, kr = lane >> 4; const int sc = colmap(mode, n0 + n4);
      f32x4 v[16];
#pragma unroll
      for (int i = 0; i < 16; ++i) { const int kk = kr + 4 * i; v[i] = (f32x4){0.f, 0.f, 0.f, 0.f}; if (sc >= 0) v[i] = *(const f32x4*)(src + (size_t)(kb + kk) * ld + sc); }
      if (kscale) {
#pragma unroll
          for (int i = 0; i < 16; ++i) v[i] *= kscale[kb + kr + 4 * i]; }
      asm volatile("" : "+v"(v[0]), "+v"(v[1]), "+v"(v[2]), "+v"(v[3]), "+v"(v[4]), "+v"(v[5]), "+v"(v[6]), "+v"(v[7]), "+v"(v[8]), "+v"(v[9]), "+v"(v[10]), "+v"(v[11]), "+v"(v[12]), "+v"(v[13]), "+v"(v[14]), "+v"(v[15]));
#pragma unroll
      for (int i = 0; i < 16; ++i) { const int kk = kr + 4 * i;
          tile[kk * 65 + n4] = v[i][0]; tile[kk * 65 + n4 + 1] = v[i][1]; tile[kk * 65 + n4 + 2] = v[i][2]; tile[kk * 65 + n4 + 3] = v[i][3]; } }
    asm volatile("s_waitcnt lgkmcnt(0)" ::: "memory");
    { const int ko = (lane & 7) * 8, nr = lane >> 3;
#pragma unroll
      for (int i = 0; i < 8; ++i) { const int n = nr + 8 * i; float v[8];
#pragma unroll
          for (int j = 0; j < 8; ++j) v[j] = tile[(ko + j) * 65 + n];
          uint4 q; q.x = pack2(v[0], v[1]); q.y = pack2(v[2], v[3]); q.z = pack2(v[4], v[5]); q.w = pack2(v[6], v[7]);
          *(uint4*)(dst + (size_t)(n0 + n) * K + kb + ko) = q; } }
    asm volatile("s_waitcnt lgkmcnt(0)" ::: "memory");
}
constexpr int CV_WIN = (WIN_ROWS / 64) * 4, CV_BR = 2 * 64, CV_OUT = 64, CV_W1 = NE * 32 * 4, CV_W2 = NE * 64;
constexpr int CV_LAYER = CV_WIN + CV_BR + CV_OUT + CV_W1 + CV_W2;
constexpr int N_CONVERT = DEPTH * CV_LAYER;
__device__ __forceinline__ void stage_convert(const int wv__, PRef p, int item, char* lds) {
    const int l = item / CV_LAYER; int w = item % CV_LAYER;
    if (w < CV_WIN) { convert_tile(wv__, p.w_in + (size_t)l * D * IN_COLS, IN_COLS, p.w_in_t + (size_t)l * WIN_ROWS * D, D, (w / 4) * 64, (w % 4) * 256, 1, lds); return; }
    w -= CV_WIN;
    if (w < CV_BR) { const int k = 1 + w / 64, t = w % 64; convert_tile(wv__, p.w_branch + (size_t)(l * 3 + k) * D * D, D, p.w_br_t + (size_t)(l * 3 + k) * D * D, D, (t / 4) * 64, (t % 4) * 256, 0, lds, (!NAIVE_SSD && k == 2) ? p.ssm_norm_w + l * D : nullptr); return; }
    w -= CV_BR;
    if (w < CV_OUT) { convert_tile(wv__, p.w_out + (size_t)l * D * D, D, p.w_out_t + (size_t)l * D * D, D, (w / 4) * 64, (w % 4) * 256, 0, lds); return; }
    w -= CV_OUT;
    if (w < CV_W1) { const int e = w / 128, t = w % 128; convert_tile(wv__, p.moe_w1 + (size_t)(l * NE + e) * D * 2048, 2048, p.w1_t + (size_t)(l * NE + e) * 2048 * D, D, (t / 4) * 64, (t % 4) * 256, 0, lds); return; }
    w -= CV_W1;
    { const int e = w / 64, t = w % 64; convert_tile(wv__, p.moe_w2 + (size_t)(l * NE + e) * D * D, D, p.w2_t + (size_t)(l * NE + e) * D * D, D, (t / 4) * 64, (t % 4) * 256, 0, lds); }
}
constexpr int N_FOLD = DEPTH * 4 * 16 * 4;
__device__ __forceinline__ void stage_fold(const int wv__, PRef p, int item, char* lds) {
    float* P = (float*)lds;
    float* W = P + 64 * 64;
    const int tid = tidx(), l = item >> 8, g = (item >> 6) & 3, n0 = ((item >> 2) & 15) * 64, kl0 = (item & 3) * 64;
    const int n = tid & 63, kq = tid >> 6;
    float acc[16];
#pragma unroll
    for (int i = 0; i < 16; ++i) acc[i] = 0.f;
    const float* pw = p.pool_w + (size_t)(l * 4 + g) * 65536; const float* ps = p.pool_scale + l * D + g * 256; const float* wb = p.w_branch + (size_t)(l * 3) * D * D + (size_t)(g * 256) * D;
#pragma unroll 1
    for (int c0 = 0; c0 < 256; c0 += 64) {
        __syncthreads();
        { float pv[16], wv[16];
          const float psc = ps[c0 + (tid & 63)];
#pragma unroll
          for (int i = 0; i < 16; ++i) { const int id = tid + 256 * i, kl = id >> 6, c = id & 63; pv[i] = pw[(size_t)(kl0 + kl) * 256 + c0 + c]; }
#pragma unroll
          for (int i = 0; i < 16; ++i) { const int id = tid + 256 * i, c = id >> 6, nn = id & 63; wv[i] = wb[(size_t)(c0 + c) * D + n0 + nn]; }
#pragma unroll
          for (int i = 0; i < 16; ++i) { const int id = tid + 256 * i, kl = id >> 6, c = id & 63; P[c * 64 + kl] = pv[i] * psc; }
#pragma unroll
          for (int i = 0; i < 16; ++i) { const int id = tid + 256 * i, c = id >> 6, nn = id & 63; W[c * 64 + nn] = wv[i]; } }
        __syncthreads();
#pragma unroll 4
        for (int c = 0; c < 64; ++c) {
            const float w = W[c * 64 + n];
#pragma unroll
            for (int q = 0; q < 4; ++q) { const f32x4 pv = *(const f32x4*)(P + c * 64 + kq * 16 + q * 4); acc[q * 4] += pv[0] * w; acc[q * 4 + 1] += pv[1] * w; acc[q * 4 + 2] += pv[2] * w; acc[q * 4 + 3] += pv[3] * w; }
        }
    }
    bf16_t* o = p.w_br_t + (size_t)(l * 3) * D * D + (size_t)(n0 + n) * D + g * 256 + kl0 + kq * 16;
    uint4 q0, q1;
    q0.x = pack2(acc[0], acc[1]); q0.y = pack2(acc[2], acc[3]); q0.z = pack2(acc[4], acc[5]); q0.w = pack2(acc[6], acc[7]);
    q1.x = pack2(acc[8], acc[9]); q1.y = pack2(acc[10], acc[11]); q1.z = pack2(acc[12], acc[13]); q1.w = pack2(acc[14], acc[15]);
    ((uint4*)o)[0] = q0; ((uint4*)o)[1] = q1;
    __syncthreads();
}
constexpr int N_TAB_CS = 512, N_TAB_A = 4096, N_TAB_B = 256, N_TAB_C = 512, N_TABLE = N_TAB_CS + N_TAB_A + N_TAB_B + N_TAB_C;
__device__ __forceinline__ void stage_table(const int wv__, PRef p, int item) {
    const float TWO_PI = 6.283185307179586f;
    if (item < N_TAB_CS) {
        const int idx = item * 256 + tidx(), m = idx >> 9, kk = idx & 511, ro = kk >> 8, c = kk & 255;
        const float ang = TWO_PI * (float)((m * c) & 255) * (1.0f / 256.0f);
        p.cs_t[idx] = f2bf((ro ? sinf(ang) : cosf(ang)) * 0.0625f); return;
    }
    item -= N_TAB_CS;
    if (item < N_TAB_A) {
        const int idx = item * 256 + tidx(), n2 = idx >> 13, rA = (idx >> 6) & 127, n1 = idx & 63, k1 = rA >> 1, ri = rA & 1;
        const float ang = TWO_PI * (float)((k1 * (128 * n1 + n2)) & 8191) * (1.0f / 8192.0f);
        p.tabA[idx] = f2bf((ri ? -sinf(ang) : cosf(ang)) * 0.011048543456039806f); return;
    }
    item -= N_TAB_A;
    if (item < N_TAB_B) {
        const int idx = item * 256 + tidx(), rB = idx >> 8, j = idx & 255, k2 = rB >> 1, ro = rB & 1, n2 = j >> 1, ri = j & 1;
        const float ang = TWO_PI * (float)((k2 * n2) & 127) * (1.0f / 128.0f);
        const float cs = cosf(ang), sn = sinf(ang);
        p.tabB[idx] = f2bf(ro == 0 ? (ri == 0 ? cs : sn) : (ri == 0 ? -sn : cs)); return;
    }
    item -= N_TAB_B;
    {
        const int idx = item * 256 + tidx(), half = idx >> 16, rC = (idx >> 8) & 255, n = idx & 255, k = half * 128 + (rC >> 1), ro = rC & 1;
        const float ang = TWO_PI * (float)((k * n) & 255) * (1.0f / 256.0f);
        p.tabC[idx] = f2bf((ro ? -sinf(ang) : cosf(ang)) * 0.0625f);
    }
}
constexpr int N_ADA = DEPTH * 6144 / 32;
__device__ __forceinline__ void stage_ada(const int wv__, PRef p, int item, char* lds) {
    float* sc = (float*)lds;
    float* part = sc + 3 * D;
    const int tid = tidx();
    __syncthreads();
    for (int i = tid; i < 3 * D; i += 256) { const int r = i / D, k = i % D; const float v = r < 2 ? p.c[r * D + k] : p.c_ctx[k]; sc[i] = siluf_(v); }
    __syncthreads();
    const int l = item / 192, cl = tid & 31, kg = tid >> 5, col = (item % 192) * 32 + cl;
    const float* w = p.w_ada + (size_t)l * D * 6144 + (size_t)(kg * 128) * 6144 + col;
    float a0 = 0.f, a1 = 0.f, a2 = 0.f;
#pragma unroll 1
    for (int k0 = 0; k0 < 128; k0 += 32) {
        float wv[32];
#pragma unroll
        for (int j = 0; j < 32; ++j) wv[j] = w[(size_t)(k0 + j) * 6144];
#pragma unroll
        for (int j = 0; j < 32; ++j) { a0 += sc[kg * 128 + k0 + j] * wv[j]; a1 += sc[D + kg * 128 + k0 + j] * wv[j]; a2 += sc[2 * D + kg * 128 + k0 + j] * wv[j]; }
    }
    part[(kg * 3 + 0) * 32 + cl] = a0; part[(kg * 3 + 1) * 32 + cl] = a1; part[(kg * 3 + 2) * 32 + cl] = a2;
    __syncthreads();
    if (tid < 96) { const int r = tid >> 5, c2 = tid & 31; float s = p.b_ada[l * 6144 + (item % 192) * 32 + c2];
#pragma unroll
        for (int g = 0; g < 8; ++g) s += part[(g * 3 + r) * 32 + c2];
        p.mod[(size_t)(l * 3 + r) * 6144 + (item % 192) * 32 + c2] = s; }
    __syncthreads();
}

constexpr int N_ROWNORM = T / 4;
template <int MODE>
__device__ __forceinline__ void stage_rownorm(const int wv__, PRef p, int layer, int item) {
    typedef unsigned u32x2v __attribute__((ext_vector_type(2)));
    const int wave = tidx() >> 6, lane = tidx() & 63, row = item * 4 + wave, mrow = modrow(row);
    const float* src = row < TL ? p.x + (size_t)row * D : p.ctx + (size_t)(row - TL) * D;
    f32x4 v[4], g[4], w4[4], a4[4], b4[4], tw = {0.f, 0.f, 0.f, 0.f};
    u32x2v sq[4][4], rq[4];
#pragma unroll
    for (int j = 0; j < 4; ++j) { if (MODE == 0) v[j] = *(const f32x4*)(src + 4 * lane + 256 * j); else rq[j] = *(const u32x2v*)(RESB(p) + (size_t)row * D + 4 * lane + 256 * j); }
    if (MODE >= 1) {
        const int pl = MODE == 1 ? layer - 1 : layer;
        const float* g2 = modp(p, pl, mrow, 5);
        tw = *(const f32x4*)(p.topw + (size_t)row * 4);
#pragma unroll
        for (int j = 0; j < 4; ++j) {
#pragma unroll
            for (int kk = 0; kk < 4; ++kk) sq[j][kk] = __builtin_nontemporal_load((const u32x2v*)(p.sout + ((size_t)row * 4 + kk) * D + 4 * lane + 256 * j));
            g[j] = *(const f32x4*)(g2 + 4 * lane + 256 * j);
        }
    }
    if (MODE == 2) {
#pragma unroll
        for (int j = 0; j < 4; ++j) w4[j] = *(const f32x4*)(p.final_norm_w + 4 * lane + 256 * j);
    } else {
        const float* nw = p.norm1_w + layer * D; const float* sh = modp(p, layer, mrow, 0); const float* sc = modp(p, layer, mrow, 1);
#pragma unroll
        for (int j = 0; j < 4; ++j) { const int k = 4 * lane + 256 * j; w4[j] = *(const f32x4*)(nw + k); a4[j] = *(const f32x4*)(sc + k); b4[j] = *(const f32x4*)(sh + k); }
    }
    if (MODE >= 1) {
#pragma unroll
        for (int j = 0; j < 4; ++j) v[j] = (f32x4){lo16(rq[j].x), hi16(rq[j].x), lo16(rq[j].y), hi16(rq[j].y)}; }
    asm volatile("" : "+v"(v[0]), "+v"(v[1]), "+v"(v[2]), "+v"(v[3]), "+v"(w4[0]), "+v"(w4[1]), "+v"(w4[2]), "+v"(w4[3]));
    if (MODE != 2) asm volatile("" : "+v"(a4[0]), "+v"(a4[1]), "+v"(a4[2]), "+v"(a4[3]), "+v"(b4[0]), "+v"(b4[1]), "+v"(b4[2]), "+v"(b4[3]));
    if (MODE >= 1) {
        asm volatile("" : "+v"(sq[0][0]), "+v"(sq[0][1]), "+v"(sq[0][2]), "+v"(sq[0][3]), "+v"(sq[1][0]), "+v"(sq[1][1]), "+v"(sq[1][2]), "+v"(sq[1][3]),
                          "+v"(sq[2][0]), "+v"(sq[2][1]), "+v"(sq[2][2]), "+v"(sq[2][3]), "+v"(sq[3][0]), "+v"(sq[3][1]), "+v"(sq[3][2]), "+v"(sq[3][3]),
                          "+v"(g[0]), "+v"(g[1]), "+v"(g[2]), "+v"(g[3]), "+v"(tw));
#pragma unroll
        for (int j = 0; j < 4; ++j) {
            f32x4 s = {0.f, 0.f, 0.f, 0.f};
#pragma unroll
            for (int kk = 0; kk < 4; ++kk) { const u32x2v q = sq[j][kk]; s[0] += tw[kk] * lo16(q.x); s[1] += tw[kk] * hi16(q.x); s[2] += tw[kk] * lo16(q.y); s[3] += tw[kk] * hi16(q.y); }
            v[j] += g[j] * s;
        }
    }
    if (MODE != 2) {
#pragma unroll
        for (int j = 0; j < 4; ++j) { u32x2v q; q.x = pack2(v[j][0], v[j][1]); q.y = pack2(v[j][2], v[j][3]); *(u32x2v*)(RESB(p) + (size_t)row * D + 4 * lane + 256 * j) = q; }
    }
    float ss = 0.f;
#pragma unroll
    for (int j = 0; j < 4; ++j) ss += v[j][0] * v[j][0] + v[j][1] * v[j][1] + v[j][2] * v[j][2] + v[j][3] * v[j][3];
    ss = wave_sum(ss);
    const float rinv = rsqrtf(ss * (1.0f / D) + RMS_EPS);
    if (MODE == 2) {
        if (row < TL) {
#pragma unroll
            for (int j = 0; j < 4; ++j) __builtin_nontemporal_store(v[j] * rinv * w4[j], (f32x4*)(p.out + (size_t)row * D + 4 * lane + 256 * j));
        }
    } else {
#pragma unroll
        for (int j = 0; j < 4; ++j) {
            const f32x4 hv = v[j] * rinv * w4[j] * (a4[j] + 1.0f) + b4[j];
            uint2 q; q.x = pack2(hv[0], hv[1]); q.y = pack2(hv[2], hv[3]);
            *(uint2*)(p.h + (size_t)row * D + 4 * lane + 256 * j) = q;
        }
    }
}

struct GemmSrc { const bf16_t* a[4]; const bf16_t* b[4]; };
__device__ __forceinline__ void gemm_stage(const GemmSrc& s, int kt, char* buf, int tid) {
#pragma unroll
    for (int i = 0; i < 4; ++i) {
        __builtin_amdgcn_global_load_lds((const unsigned*)(s.a[i] + kt), (unsigned*)(buf + i * 4096 + tid * 16), 16, 0, 0);
        __builtin_amdgcn_global_load_lds((const unsigned*)(s.b[i] + kt), (unsigned*)(buf + 16384 + i * 4096 + tid * 16), 16, 0, 0);
    }
}
__device__ __forceinline__ void gemm_kloop(const int wv__, f32x4 (&acc)[4][4], const GemmSrc& s, int K, char* lds) {
    const int tid = tidx(), wid = tid >> 6, lane = tid & 63, wr = wid >> 1, wc = wid & 1, fr = lane & 15, fq = lane >> 4;
    const int rsw = fr & 7;
    const int offA = (wr * 64 + fr) * 128, offB = 16384 + (wc * 64 + fr) * 128;
    const int c0 = ((0 + fq) ^ rsw) * 16, c1 = ((4 + fq) ^ rsw) * 16;
    asm volatile("s_waitcnt lgkmcnt(0)" ::: "memory");
    __builtin_amdgcn_s_barrier();
    asm volatile("" ::: "memory");
    gemm_stage(s, 0, lds, tid);
    asm volatile("s_waitcnt vmcnt(0)" ::: "memory");
    __syncthreads();
    int cur = 0;
    for (int kt = 0; kt < K; kt += 64) {
        char* buf = lds + cur * 32768;
        if (kt + 64 < K) gemm_stage(s, kt + 64, lds + (cur ^ 1) * 32768, tid);
#pragma unroll
        for (int ks = 0; ks < 2; ++ks) {
            const int cc = ks ? c1 : c0;
            bf16x8 af[4], bfr[4];
#pragma unroll
            for (int m = 0; m < 4; ++m) af[m] = *(const bf16x8*)(buf + offA + m * 2048 + cc);
#pragma unroll
            for (int n = 0; n < 4; ++n) bfr[n] = *(const bf16x8*)(buf + offB + n * 2048 + cc);
#pragma unroll
            for (int m = 0; m < 4; ++m)
#pragma unroll
                for (int n = 0; n < 4; ++n) acc[m][n] = __builtin_amdgcn_mfma_f32_16x16x32_bf16(bfr[n], af[m], acc[m][n], 0, 0, 0);
        }
        asm volatile("s_waitcnt vmcnt(0)" ::: "memory");
        __syncthreads();
        cur ^= 1;
    }
}
template <int MR> struct GemmSrcT { const bf16_t* a[MR / 2]; const bf16_t* b[2]; };
template <int MR>
__device__ __forceinline__ void gemm_stage_t(const GemmSrcT<MR>& s, int kt, char* buf, int tid) {
#pragma unroll
    for (int i = 0; i < MR / 2; ++i) __builtin_amdgcn_global_load_lds((const unsigned*)(s.a[i] + kt), (unsigned*)(buf + i * 4096 + tid * 16), 16, 0, 0);
#pragma unroll
    for (int i = 0; i < 2; ++i) __builtin_amdgcn_global_load_lds((const unsigned*)(s.b[i] + kt), (unsigned*)(buf + MR * 2048 + i * 4096 + tid * 16), 16, 0, 0);
}
template <int N> __device__ __forceinline__ void wait_vmcnt() { asm volatile("s_waitcnt vmcnt(%0)" :: "n"(N) : "memory"); }
template <int MR>
__device__ __forceinline__ void gemm_kloop_t(const int wv__, f32x4 (&acc)[MR][4], const GemmSrcT<MR>& s, int K, char* lds) {
    constexpr int NBUF = (MR == 8) ? 3 : 4, P = NBUF - 1, L = MR / 2 + 2, BUFB = MR * 2048 + 8192;
    const int tid = tidx(), wid = tid >> 6, lane = tid & 63, wr = wid >> 1, wc = wid & 1, fr = lane & 15, fq = lane >> 4;
    const int cc = (fq ^ ((-(fr >> 2)) & 3)) * 16;
    const int offA = (wr * (MR * 16) + fr) * 64 + cc, offB = MR * 2048 + (wc * 64 + fr) * 64 + cc;
    const int nk = K >> 5;
    asm volatile("s_waitcnt lgkmcnt(0)" ::: "memory");
    __builtin_amdgcn_s_barrier();
    asm volatile("" ::: "memory");
#pragma unroll
    for (int i = 0; i < P; ++i) if (i < nk) gemm_stage_t<MR>(s, i * 32, lds + i * BUFB, tid);
    int cur = 0, nxt = P;
#pragma unroll 1
    for (int k = 0; k < nk; ++k) {
        const int rem = nk - 1 - k;
        if (P >= 3 && rem >= 2) wait_vmcnt<2 * L>(); else if (rem >= 1) wait_vmcnt<L>(); else wait_vmcnt<0>();
        __builtin_amdgcn_s_barrier();
        asm volatile("" ::: "memory");
        const char* buf = lds + cur * BUFB;
        bf16x8 af[MR], bfr[4];
#pragma unroll
        for (int n = 0; n < 4; ++n) bfr[n] = *(const bf16x8*)(buf + offB + n * 1024);
#pragma unroll
        for (int m = 0; m < MR; ++m) af[m] = *(const bf16x8*)(buf + offA + m * 1024);
        __builtin_amdgcn_sched_barrier(0);
        if (k + P < nk) gemm_stage_t<MR>(s, (k + P) * 32, lds + nxt * BUFB, tid);
        __builtin_amdgcn_sched_barrier(0);
#pragma unroll
        for (int m = 0; m < MR; ++m)
#pragma unroll
            for (int n = 0; n < 4; ++n) acc[m][n] = __builtin_amdgcn_mfma_f32_16x16x32_bf16(bfr[n], af[m], acc[m][n], 0, 0, 0);
        cur = (cur + 1 == NBUF) ? 0 : cur + 1; nxt = (nxt + 1 == NBUF) ? 0 : nxt + 1;
    }
}
__device__ __forceinline__ void gemm_kloop2(const int wv__, f32x4 (&acc)[8][4], const GemmSrcT<8>& s, int K, char* lds) { gemm_kloop_t<8>(wv__, acc, s, K, lds); }
typedef GemmSrcT<8> GemmSrc2;
struct GemmSrc8 { const bf16_t* a[2]; const bf16_t* b[2]; };
__device__ __forceinline__ void gemm_stage8(const GemmSrc8& s, int kt, char* buf, int T_) {
#pragma unroll
    for (int i = 0; i < 2; ++i) __builtin_amdgcn_global_load_lds((const unsigned*)(s.a[i] + kt), (unsigned*)(buf + i * 8192 + T_ * 16), 16, 0, 0);
#pragma unroll
    for (int i = 0; i < 2; ++i) __builtin_amdgcn_global_load_lds((const unsigned*)(s.b[i] + kt), (unsigned*)(buf + 16384 + i * 8192 + T_ * 16), 16, 0, 0);
}
__device__ __forceinline__ void gemm_kloop8(const int wv__, f32x4 (&acc)[8][4], const GemmSrc8& s, int K, char* lds_all) {
    constexpr int NBUF = 4, P = 3, L = 4, BUFB = 32768;
    const int T_ = tidx8(), wid = T_ >> 6, lane = T_ & 63, wr = wid >> 2, wc = wid & 3, fr = lane & 15, fq = lane >> 4;
    const int cc = (fq ^ ((-(fr >> 2)) & 3)) * 16;
    const int offA = (wr * 128 + fr) * 64 + cc, offB = 16384 + (wc * 64 + fr) * 64 + cc;
    const int nk = K >> 5;
    asm volatile("s_waitcnt lgkmcnt(0)" ::: "memory");
    __builtin_amdgcn_s_barrier();
    asm volatile("" ::: "memory");
#pragma unroll
    for (int i = 0; i < P; ++i) if (i < nk) gemm_stage8(s, i * 32, lds_all + i * BUFB, T_);
    int cur = 0, nxt = P;
#pragma unroll 1
    for (int k = 0; k < nk; ++k) {
        const int rem = nk - 1 - k;
        if (rem >= 2) wait_vmcnt<2 * L>(); else if (rem >= 1) wait_vmcnt<L>(); else wait_vmcnt<0>();
        __builtin_amdgcn_s_barrier();
        asm volatile("" ::: "memory");
        const char* buf = lds_all + cur * BUFB;
        bf16x8 af[8], bfr[4];
#pragma unroll
        for (int n = 0; n < 4; ++n) bfr[n] = *(const bf16x8*)(buf + offB + n * 1024);
#pragma unroll
        for (int m = 0; m < 8; ++m) af[m] = *(const bf16x8*)(buf + offA + m * 1024);
        __builtin_amdgcn_sched_barrier(0);
        if (k + P < nk) gemm_stage8(s, (k + P) * 32, lds_all + nxt * BUFB, T_);
        __builtin_amdgcn_sched_barrier(0);
#pragma unroll
        for (int m = 0; m < 8; ++m)
#pragma unroll
            for (int n = 0; n < 4; ++n) acc[m][n] = __builtin_amdgcn_mfma_f32_16x16x32_bf16(bfr[n], af[m], acc[m][n], 0, 0, 0);
        cur = (cur + 1 == NBUF) ? 0 : cur + 1; nxt = (nxt + 1 == NBUF) ? 0 : nxt + 1;
    }
}
#define G8LAS __attribute__((address_space(3)))
constexpr int G8_HTB = 128 * 64 * 2;
__device__ __forceinline__ int g8_lds_byte(int r, int c) { const int st = (r >> 4) * 2 + (c >> 5), rr = r & 15, cc = c & 31, ob = rr * 64 + cc * 2; return st * 1024 + (ob ^ (((ob >> 9) & 1) << 5)); }
__device__ __forceinline__ void g8_stage_rc(int b, int& R, int& C) { const int st = b / 1024, sb = b % 1024, swz = sb ^ (((sb >> 9) & 1) << 5); R = (st >> 1) * 16 + swz / 64; C = (st & 1) * 32 + (swz % 64) / 2; }
__device__ __forceinline__ int g8_perm32(int rho) { const int n = rho >> 4, i = rho & 15; return 8 * (i >> 2) + 4 * n + (i & 3); }
struct G8Unit { const char* a; const char* b; int x0, x1, x2, x3, x4; };
typedef f32x4 G8Acc[2][2][4][2];
__device__ __forceinline__ void g8_zero(G8Acc& acc) {
#pragma unroll
    for (int a = 0; a < 2; ++a)
#pragma unroll
        for (int b = 0; b < 2; ++b)
#pragma unroll
            for (int m = 0; m < 4; ++m)
#pragma unroll
                for (int n = 0; n < 2; ++n) acc[a][b][m][n] = (f32x4){0.f, 0.f, 0.f, 0.f};
}
template <bool GATHER, int KK, int LDA, int LDB, class GetF, class FinF, class EpiF>
__device__ __forceinline__ void gemm_phase8(const int wv__, char* lds_generic, int item, int item_end, int stride, size_t hstepA, size_t hstepB, GetF getf, FinF finf, EpiF epif) {
    if (item >= item_end) return;
    G8LAS unsigned char* lds = (G8LAS unsigned char*)lds_generic;
    const int tid = tidx8(), wid = __builtin_amdgcn_readfirstlane(tid >> 6), lane = tid & 63, wr = wid >> 2, wc = wid & 3, fr = lane & 15, fq = lane >> 4;
    constexpr int nt = KK / 64;
    static_assert(KK % 128 == 0 && KK >= 256, "K-tile stream");
    unsigned voffA[2], voffB[2], vA[2][2], vAn[2][2];
#pragma unroll
    for (int i = 0; i < 2; ++i) { int R, C; g8_stage_rc(tid * 16 + i * 8192, R, C); const int Rb = (R & ~31) + g8_perm32(R & 31);
        voffA[i] = (unsigned)(R * LDA + C) * 2u; voffB[i] = (unsigned)(Rb * LDB + C) * 2u; vA[0][i] = vA[1][i] = vAn[0][i] = vAn[1][i] = 0u; }
    constexpr size_t kstep = 128;
    const unsigned ldsw = (unsigned)wid * 1024u;
    const int aoff = g8_lds_byte(wr * 64 + fr, fq * 8), boff = g8_lds_byte(wc * 32 + fr, fq * 8);
#define G8_SA(b, h) (((b) * 2 + (h)) * G8_HTB)
#define G8_SB(b, h) ((4 + (b) * 2 + (h)) * G8_HTB)
#define G8_STAGE(bufoff, gbase, voff) do { _Pragma("unroll") for (int _i = 0; _i < 2; ++_i) \
        __builtin_amdgcn_global_load_lds((const unsigned*)((const char*)(gbase) + (voff)[_i]), (G8LAS unsigned*)(lds + (bufoff) + ldsw + _i * 8192), 16, 0, 0); } while (0)
#define G8_STAGE_A(bufoff, gbase, h, vg) do { if (GATHER) G8_STAGE(bufoff, gbase, (vg)[h]); else G8_STAGE(bufoff, (gbase) + (h) * hstepA, voffA); } while (0)
#define G8_LDA(dst, b, h) do { _Pragma("unroll") for (int m = 0; m < 4; ++m) _Pragma("unroll") for (int k = 0; k < 2; ++k) dst[m][k] = *(const G8LAS bf16x8*)(lds + G8_SA(b, h) + aoff + m * 2048 + k * 1024); } while (0)
#define G8_LDB(dst, b, h) do { _Pragma("unroll") for (int n = 0; n < 2; ++n) _Pragma("unroll") for (int k = 0; k < 2; ++k) dst[n][k] = *(const G8LAS bf16x8*)(lds + G8_SB(b, h) + boff + n * 2048 + k * 1024); } while (0)
#define G8_MMA(ai, bj, At, Bt) do { __builtin_amdgcn_s_setprio(1); _Pragma("unroll") for (int m = 0; m < 4; ++m) _Pragma("unroll") for (int n = 0; n < 2; ++n) _Pragma("unroll") for (int k = 0; k < 2; ++k) \
        acc[ai][bj][m][n] = __builtin_amdgcn_mfma_f32_16x16x32_bf16(Bt[n][k], At[m][k], acc[ai][bj][m][n], 0, 0, 0); __builtin_amdgcn_s_setprio(0); } while (0)
#define G8_WAIT_V(n) asm volatile("s_waitcnt vmcnt(" #n ")" ::: "memory")
#define G8_WAIT_L(n) asm volatile("s_waitcnt lgkmcnt(" #n ")" ::: "memory")
#define G8_BAR __builtin_amdgcn_s_barrier()
#define G8_SCHED __builtin_amdgcn_sched_barrier(0)
    G8Unit cur, nxt; int tk[2][2] = {{0, 0}, {0, 0}};
    getf(item, cur, tk); if (GATHER) finf(cur, tk, vA);
    bool has_next = item + stride < item_end;
    if (has_next) { getf(item + stride, nxt, tk); if (GATHER) finf(nxt, tk, vAn); }
    else { nxt = cur; if (GATHER) { vAn[0][0] = vA[0][0]; vAn[0][1] = vA[0][1]; vAn[1][0] = vA[1][0]; vAn[1][1] = vA[1][1]; } }
    G8Acc acc; g8_zero(acc);
    bf16x8 At[4][2], B0[2][2], B1[2][2];
    { const char* cA = cur.a; const char* cB = cur.b;
      G8_STAGE(G8_SB(0, 0), cB, voffB); G8_STAGE_A(G8_SA(0, 0), cA, 0, vA); G8_STAGE(G8_SB(0, 1), cB + hstepB, voffB); G8_STAGE_A(G8_SA(0, 1), cA, 1, vA);
      if (wr == 1) G8_BAR;
      G8_WAIT_V(4); G8_BAR;
      G8_STAGE(G8_SB(1, 0), cB + kstep, voffB); G8_STAGE_A(G8_SA(1, 0), cA + kstep, 0, vA); G8_STAGE(G8_SB(1, 1), cB + hstepB + kstep, voffB);
      G8_WAIT_V(6); G8_BAR; }
#pragma unroll 1
    for (;;) {
        const char* cA = cur.a; const char* cB = cur.b; const char* nA = nxt.a; const char* nB = nxt.b;
#pragma unroll 1
        for (int t = 0; t < nt; t += 2) {
            const bool last = (t == nt - 2);
            const char* a1 = cA + (size_t)(t + 1) * kstep;
            const char* a2 = last ? nA : cA + (size_t)(t + 2) * kstep; const char* b2 = last ? nB : cB + (size_t)(t + 2) * kstep;
            const char* a3 = a2 + kstep; const char* b3 = b2 + kstep;
            unsigned v2[2][2];
#pragma unroll
            for (int h = 0; h < 2; ++h)
#pragma unroll
                for (int i = 0; i < 2; ++i) v2[h][i] = (GATHER && last) ? vAn[h][i] : vA[h][i];
            G8_LDB(B0, 0, 0); G8_SCHED; G8_LDA(At, 0, 0); G8_STAGE_A(G8_SA(1, 1), a1, 1, vA);
            G8_WAIT_L(8); G8_BAR; G8_WAIT_L(0); G8_MMA(0, 0, At, B0); G8_BAR; G8_SCHED;
            G8_LDB(B1, 0, 1); G8_STAGE(G8_SB(0, 0), b2, voffB);
            G8_BAR; G8_WAIT_L(0); G8_MMA(0, 1, At, B1); G8_BAR;
            G8_LDA(At, 0, 1); G8_STAGE_A(G8_SA(0, 0), a2, 0, v2);
            G8_BAR; G8_WAIT_L(0); G8_MMA(1, 0, At, B0); G8_BAR; G8_SCHED;
            G8_STAGE(G8_SB(0, 1), b2 + hstepB, voffB);
            G8_WAIT_V(6); G8_BAR; G8_MMA(1, 1, At, B1); G8_BAR;
            G8_LDB(B0, 1, 0); G8_SCHED; G8_LDA(At, 1, 0); G8_STAGE_A(G8_SA(0, 1), a2, 1, v2);
            G8_WAIT_L(8); G8_BAR; G8_WAIT_L(0); G8_MMA(0, 0, At, B0); G8_BAR; G8_SCHED;
            G8_LDB(B1, 1, 1); G8_STAGE(G8_SB(1, 0), b3, voffB);
            G8_BAR; G8_WAIT_L(0); G8_MMA(0, 1, At, B1); G8_BAR;
            G8_LDA(At, 1, 1); G8_STAGE_A(G8_SA(1, 0), a3, 0, v2);
            G8_BAR; G8_WAIT_L(0); G8_MMA(1, 0, At, B0); G8_BAR; G8_SCHED;
            G8_STAGE(G8_SB(1, 1), b3 + hstepB, voffB);
            G8_WAIT_V(6); G8_BAR; G8_MMA(1, 1, At, B1); G8_BAR;
        }
        const int item2 = item + 2 * stride; const bool has2 = has_next && item2 < item_end;
        G8Unit nn = nxt;
        if (has2) getf(item2, nn, tk);
        epif(acc, cur, wr, wc, fr, fq);
        if (!has_next) break;
        g8_zero(acc);
        cur = nxt;
        if (GATHER) { vA[0][0] = vAn[0][0]; vA[0][1] = vAn[0][1]; vA[1][0] = vAn[1][0]; vA[1][1] = vAn[1][1]; }
        if (has2) { nxt = nn; if (GATHER) finf(nn, tk, vAn); }
        has_next = has2; item += stride;
    }
    G8_WAIT_V(0);
    if (wr == 0) G8_BAR;
    G8_BAR;
#undef G8_SA
#undef G8_SB
#undef G8_STAGE
#undef G8_STAGE_A
#undef G8_LDA
#undef G8_LDB
#undef G8_MMA
#undef G8_WAIT_V
#undef G8_WAIT_L
#undef G8_BAR
#undef G8_SCHED
}
__device__ __forceinline__ unsigned g8_rowoff(int tid, int i, int& R) { int C; g8_stage_rc(tid * 16 + i * 8192, R, C); return (unsigned)C * 2u; }
#define GEMM8_LANE_VARS const int T_ = tidx8(), wid = T_ >> 6, lane = T_ & 63, wr = wid >> 2, wc = wid & 3, fr = lane & 15, fq = lane >> 4; (void)wr; (void)wc; (void)fr; (void)fq; \
    const int br0 = T_ >> 2, bc = ((T_ & 3) ^ ((-(T_ >> 4)) & 3)) * 8;
__device__ __forceinline__ void zero_acc2(f32x4 (&acc)[8][4]) {
#pragma unroll
    for (int m = 0; m < 8; ++m)
#pragma unroll
        for (int n = 0; n < 4; ++n) acc[m][n] = (f32x4){0.f, 0.f, 0.f, 0.f};
}
#define GEMM2_LANE_VARS const int tid = tidx(), wid = tid >> 6, lane = tid & 63, wr = wid >> 1, wc = wid & 1, fr = lane & 15, fq = lane >> 4; (void)wr; (void)wc; (void)fr; (void)fq; \
    const int br0 = tid >> 2, bc = ((tid & 3) ^ ((-(tid >> 4)) & 3)) * 8;
__device__ __forceinline__ int brow(int r) { return (r & ~63) | (((r >> 2) & 3) << 4) | (((r >> 4) & 3) << 2) | (r & 3); }
__device__ __forceinline__ void pack16(const f32x4 (&v)[4], uint4& q0, uint4& q1) {
    q0.x = pack2(v[0][0], v[0][1]); q0.y = pack2(v[0][2], v[0][3]); q0.z = pack2(v[1][0], v[1][1]); q0.w = pack2(v[1][2], v[1][3]);
    q1.x = pack2(v[2][0], v[2][1]); q1.y = pack2(v[2][2], v[2][3]); q1.z = pack2(v[3][0], v[3][1]); q1.w = pack2(v[3][2], v[3][3]); }
__device__ __forceinline__ void zero_acc(f32x4 (&acc)[4][4]) {
#pragma unroll
    for (int m = 0; m < 4; ++m)
#pragma unroll
        for (int n = 0; n < 4; ++n) acc[m][n] = (f32x4){0.f, 0.f, 0.f, 0.f};
}
#define GEMM_LANE_VARS const int tid = tidx(), wid = tid >> 6, lane = tid & 63, wr = wid >> 1, wc = wid & 1, fr = lane & 15, fq = lane >> 4; (void)wr; (void)wc; (void)fr; (void)fq; \
    const int ar0 = tid >> 3, ac = ((tid & 7) ^ (ar0 & 7)) * 8;

constexpr int NM_T = T / 128, NM2 = T / 256, NN8 = WIN_ROWS / 256, N_INPROJ = NM2 * NN8;
__device__ __forceinline__ void stage_inproj(const int wv__, PRef p, int layer, int item, char* lds_all) {
    GEMM8_LANE_VARS
    const int grp = item / (8 * NN8), w = item % (8 * NN8);
    const int gsz = (NM2 - grp * 8) < 8 ? (NM2 - grp * 8) : 8, mt = grp * 8 + (w % gsz), nt = w / gsz;
    const bf16_t* A = p.h + (size_t)(mt * 256) * D; const bf16_t* B = p.w_in_t + ((size_t)layer * WIN_ROWS + nt * 256) * D;
    f32x4 acc[8][4]; zero_acc2(acc);
    { GemmSrc8 s;
#pragma unroll
      for (int i = 0; i < 2; ++i) { s.a[i] = A + (size_t)(br0 + 128 * i) * D + bc; s.b[i] = B + (size_t)brow(br0 + 128 * i) * D + bc; }
      gemm_kloop8(wv__, acc, s, D, lds_all); }
#pragma unroll
    for (int m = 0; m < 8; ++m) {
        const int row = mt * 256 + wr * 128 + m * 16 + fr;
        if (nt < 32) {
            const int gc = nt * 256 + wc * 64 + 16 * fq;
            f32x4 v[4];
#pragma unroll
            for (int n = 0; n < 4; ++n) { v[n] = acc[m][n]; if (gc >= U_GATE) { v[n][0] = sigmoidf_(v[n][0]); v[n][1] = sigmoidf_(v[n][1]); v[n][2] = sigmoidf_(v[n][2]); v[n][3] = sigmoidf_(v[n][3]); } }
            uint4 q0, q1; pack16(v, q0, q1);
            uint4* o = (uint4*)(p.U + (size_t)row * UC + gc); o[0] = q0; o[1] = q1;
        } else if (wc == 0 && fq < 2) {
#pragma unroll
            for (int n = 0; n < 4; ++n) {
                const int cl = 16 * fq + 4 * n; const f32x4 b = *(const f32x4*)(p.dt_bias + layer * 32 + cl); const f32x4 v = acc[m][n];
                f32x4 o; o[0] = softplusf_(v[0] + b[0]); o[1] = softplusf_(v[1] + b[1]); o[2] = softplusf_(v[2] + b[2]); o[3] = softplusf_(v[3] + b[3]);
                *(f32x4*)(p.dt + (size_t)row * 32 + cl) = o;
            }
        }
    }
}
__device__ __forceinline__ void phase_inproj8(const int wv__, PRef p, int layer, int item0, int item_end, int stride, char* lds_all) {
    auto getf = [&](int item, G8Unit& u, int (&tk)[2][2]) {
        (void)tk;
        const int grp = item / (8 * NN8), w = item % (8 * NN8);
        const int gsz = (NM2 - grp * 8) < 8 ? (NM2 - grp * 8) : 8, mt = grp * 8 + (w % gsz), nt = w / gsz;
        u.a = (const char*)(p.h + (size_t)(mt * 256) * D); u.b = (const char*)(p.w_in_t + ((size_t)layer * WIN_ROWS + nt * 256) * D); u.x0 = mt; u.x1 = nt; u.x2 = 0; u.x3 = 0; u.x4 = 0;
    };
    auto finf = [&](const G8Unit&, const int (&)[2][2], unsigned (&)[2][2]) {};
    auto epif = [&](const G8Acc& acc, const G8Unit& u, int wr, int wc, int fr, int fq) {
        const int mt = u.x0, nt = u.x1;
        if (nt < 32) {
            const bool gate = nt * 256 >= U_GATE;
#pragma unroll
            for (int ai = 0; ai < 2; ++ai)
#pragma unroll
                for (int m = 0; m < 4; ++m) {
                    bf16_t* rowp = p.U + (size_t)(mt * 256 + ai * 128 + wr * 64 + m * 16 + fr) * UC + nt * 256 + wc * 32 + 8 * fq;
#pragma unroll
                    for (int bj = 0; bj < 2; ++bj) {
                        f32x4 v0 = acc[ai][bj][m][0], v1 = acc[ai][bj][m][1];
                        if (gate) {
#pragma unroll
                            for (int j = 0; j < 4; ++j) { v0[j] = sigmoidf_(v0[j]); v1[j] = sigmoidf_(v1[j]); } }
                        uint4 q; q.x = pack2(v0[0], v0[1]); q.y = pack2(v0[2], v0[3]); q.z = pack2(v1[0], v1[1]); q.w = pack2(v1[2], v1[3]);
                        *(uint4*)(rowp + bj * 128) = q;
                    }
                }
        } else if (wc == 0) {
            const f32x4 b0 = *(const f32x4*)(p.dt_bias + layer * 32 + 8 * fq), b1 = *(const f32x4*)(p.dt_bias + layer * 32 + 8 * fq + 4);
#pragma unroll
            for (int ai = 0; ai < 2; ++ai)
#pragma unroll
                for (int m = 0; m < 4; ++m) {
                    float* o = p.dt + (size_t)(mt * 256 + ai * 128 + wr * 64 + m * 16 + fr) * 32 + 8 * fq;
                    const f32x4 v0 = acc[ai][0][m][0], v1 = acc[ai][0][m][1];
                    f32x4 o0, o1;
#pragma unroll
                    for (int j = 0; j < 4; ++j) { o0[j] = softplusf_(v0[j] + b0[j]); o1[j] = softplusf_(v1[j] + b1[j]); }
                    *(f32x4*)o = o0; *(f32x4*)(o + 4) = o1;
                }
        }
    };
    gemm_phase8<false, D, D, D>(wv__, lds_all, item0, item_end, stride, (size_t)128 * D * 2, (size_t)128 * D * 2, getf, finf, epif);
}
__device__ __forceinline__ void gemm_tail128(const int wv__, f32x4 (&acc)[4][4], const bf16_t* A, int lda, const bf16_t* B, int ldb, int K, char* lds) {
    const int t2 = tidx(), br0 = t2 >> 2, bc = ((t2 & 3) ^ ((-(t2 >> 4)) & 3)) * 8;
    GemmSrcT<4> s;
#pragma unroll
    for (int i = 0; i < 2; ++i) { s.a[i] = A + (size_t)(br0 + 64 * i) * lda + bc; s.b[i] = B + (size_t)brow(br0 + 64 * i) * ldb + bc; }
    gemm_kloop_t<4>(wv__, acc, s, K, lds);
}
constexpr int N_G1024 = NM_T * 8;
template <int MODE, bool TAIL = false>
__device__ __forceinline__ void stage_gemm_small(const int wv__, PRef p, int layer, int item, char* lds) {
    GEMM_LANE_VARS
    const int mt = item >> 3, nt = item & 7, g = nt >> 1;
    const bf16_t *A, *B; int lda, ldb, K;
    if (MODE == 0) { A = p.Dp + (size_t)(mt * 128) * D + g * 256; lda = D; K = 256; ldb = 256; B = p.pool_w_t + (size_t)(layer * 4 + g) * 65536 + (size_t)((nt & 1) * 128) * 256; }
    else           { A = p.Yb + (size_t)(mt * 128) * 2048 + g * 512; lda = 2048; K = 512; ldb = 512; B = p.cs_t + (size_t)((nt & 1) * 128) * 512; }
    f32x4 acc[4][4]; zero_acc(acc);
    if (TAIL) gemm_tail128(wv__, acc, A, lda, B, ldb, K, lds);
    else { GemmSrc s;
#pragma unroll
      for (int i = 0; i < 4; ++i) { s.a[i] = A + (size_t)(ar0 + 32 * i) * lda + ac; s.b[i] = B + (size_t)brow(ar0 + 32 * i) * ldb + ac; }
      gemm_kloop(wv__, acc, s, K, lds); }
    bf16_t* O = MODE == 0 ? p.ya : p.yb;
#pragma unroll
    for (int m = 0; m < 4; ++m) {
        const int row = mt * 128 + wr * 64 + m * 16 + fr, col = nt * 128 + wc * 64 + 16 * fq;
        f32x4 v[4];
#pragma unroll
        for (int n = 0; n < 4; ++n) { v[n] = acc[m][n]; if (MODE == 0) v[n] *= *(const f32x4*)(p.pool_scale + layer * D + col + 4 * n); }
        uint4 q0, q1; pack16(v, q0, q1);
        uint4* o = (uint4*)(O + (size_t)row * D + col); o[0] = q0; o[1] = q1;
    }
}
template <bool TAIL = false>
__device__ __forceinline__ void stage_merge(const int wv__, PRef p, int layer, int item, char* lds) {
    GEMM_LANE_VARS
    const int mt = item >> 3, nt = item & 7;
    f32x4 macc[4][4]; zero_acc(macc);
#pragma unroll 1
    for (int k = 0; k < 3; ++k) {
        const bf16_t* A = (k == 0 ? p.Dp : (k == 1 ? p.yb : p.yc)) + (size_t)(mt * 128) * D;
        const bf16_t* B = p.w_br_t + ((size_t)(layer * 3 + k) * D + nt * 128) * D;
        f32x4 acc[4][4]; zero_acc(acc);
        if (TAIL) gemm_tail128(wv__, acc, A, D, B, D, D, lds);
        else { GemmSrc s;
#pragma unroll
          for (int i = 0; i < 4; ++i) { s.a[i] = A + (size_t)(ar0 + 32 * i) * D + ac; s.b[i] = B + (size_t)brow(ar0 + 32 * i) * D + ac; }
          gemm_kloop(wv__, acc, s, D, lds); }
#pragma unroll
        for (int m = 0; m < 4; ++m) {
            const int row = mt * 128 + wr * 64 + m * 16 + fr, col = nt * 128 + wc * 64 + 16 * fq;
            float rs = 1.0f;
            if (!NAIVE_SSD && k == 2) { const f32x4* sq = (const f32x4*)(p.ssq + (size_t)row * 16); const f32x4 t = sq[0] + sq[1] + sq[2] + sq[3]; rs = rsqrtf((t[0] + t[1] + t[2] + t[3]) * (1.0f / D) + RMS_EPS); }
            const uint4* gp = (const uint4*)(p.U + (size_t)row * UC + U_GATE + k * D + col);
            const uint4 g0 = gp[0], g1 = gp[1];
            const unsigned gw[8] = {g0.x, g0.y, g0.z, g0.w, g1.x, g1.y, g1.z, g1.w};
#pragma unroll
            for (int n = 0; n < 4; ++n) {
                macc[m][n][0] += lo16(gw[2 * n]) * rs * acc[m][n][0]; macc[m][n][1] += hi16(gw[2 * n]) * rs * acc[m][n][1];
                macc[m][n][2] += lo16(gw[2 * n + 1]) * rs * acc[m][n][2]; macc[m][n][3] += hi16(gw[2 * n + 1]) * rs * acc[m][n][3];
            }
        }
    }
#pragma unroll
    for (int m = 0; m < 4; ++m) {
        const int row = mt * 128 + wr * 64 + m * 16 + fr, col = nt * 128 + wc * 64 + 16 * fq;
        uint4 q0, q1; pack16(macc[m], q0, q1);
        uint4* o = (uint4*)(p.m + (size_t)row * D + col); o[0] = q0; o[1] = q1;
    }
}
template <bool TAIL = false>
__device__ __forceinline__ void stage_outproj(const int wv__, PRef p, int layer, int item, char* lds) {
    GEMM_LANE_VARS
    const int mt = item >> 3, nt = item & 7;
    const bf16_t* A = p.m + (size_t)(mt * 128) * D; const bf16_t* B = p.w_out_t + ((size_t)layer * D + nt * 128) * D;
    f32x4 acc[4][4]; zero_acc(acc);
    if (TAIL) gemm_tail128(wv__, acc, A, D, B, D, D, lds);
    else { GemmSrc s;
#pragma unroll
      for (int i = 0; i < 4; ++i) { s.a[i] = A + (size_t)(ar0 + 32 * i) * D + ac; s.b[i] = B + (size_t)brow(ar0 + 32 * i) * D + ac; }
      gemm_kloop(wv__, acc, s, D, lds); }
#pragma unroll
    for (int m = 0; m < 4; ++m) {
        const int row = mt * 128 + wr * 64 + m * 16 + fr, col = nt * 128 + wc * 64 + 16 * fq; const float* g1 = modp(p, layer, modrow(row), 2) + col;
        bf16_t* r = RESB(p) + (size_t)row * D + col;
        f32x4 gv4[4];
        const uint4 r0 = *(const uint4*)r, r1 = *(const uint4*)(r + 8);
#pragma unroll
        for (int n = 0; n < 4; ++n) gv4[n] = *(const f32x4*)(g1 + 4 * n);
        const unsigned rw[8] = {r0.x, r0.y, r0.z, r0.w, r1.x, r1.y, r1.z, r1.w};
        unsigned ow[8];
#pragma unroll
        for (int n = 0; n < 4; ++n) { const f32x4 a = acc[m][n], g = gv4[n];
            ow[2 * n] = pack2(lo16(rw[2 * n]) + g[0] * a[0], hi16(rw[2 * n]) + g[1] * a[1]); ow[2 * n + 1] = pack2(lo16(rw[2 * n + 1]) + g[2] * a[2], hi16(rw[2 * n + 1]) + g[3] * a[3]); }
        *(uint4*)r = make_uint4(ow[0], ow[1], ow[2], ow[3]); *(uint4*)(r + 8) = make_uint4(ow[4], ow[5], ow[6], ow[7]);
    }
}
constexpr int CNT_STRIDE = 64;
__device__ __forceinline__ int ld_cnt(PRef p, int i) { return __builtin_amdgcn_readfirstlane(__hip_atomic_load(p.cnt + i * CNT_STRIDE, __ATOMIC_RELAXED, __HIP_MEMORY_SCOPE_AGENT)); }
struct MoeTile { int e, mt, nt, cnt, off; };
__device__ __forceinline__ void moe_scan(const int wv__, PRef p, int layer, int& c, int& mtn, int& pm, int& pc) {
    const int lane = tidx() & 63, l31 = lane & 31;
    c = __hip_atomic_load(p.cnt + (layer * NE + l31) * CNT_STRIDE, __ATOMIC_RELAXED, __HIP_MEMORY_SCOPE_AGENT);
    mtn = (c + 255) >> 8; pm = mtn; pc = c;
#pragma unroll
    for (int o = 1; o < 32; o <<= 1) {
        const int src = ((lane - o) & 63) * 4;
        const int um = __builtin_amdgcn_ds_bpermute(src, pm), uc = __builtin_amdgcn_ds_bpermute(src, pc);
        if (l31 >= o) { pm += um; pc += uc; }
    }
}
template <int NT>
__device__ __forceinline__ bool moe_decode(const int wv__, PRef p, int layer, int item, MoeTile& t) {
    const int mg = item / NT; t.nt = item % NT;
    int c, mtn, pm, pc; moe_scan(wv__, p, layer, c, mtn, pm, pc);
    const int e = __popcll(__ballot(pm <= mg) & 0xffffffffull);
    if (e >= NE) return false;
    t.e = e; t.cnt = __builtin_amdgcn_readlane(c, e);
    t.mt = mg - __builtin_amdgcn_readlane(pm - mtn, e); t.off = __builtin_amdgcn_readlane(pc - c, e);
    return true;
}
__device__ __forceinline__ int moe_total_mtiles(const int wv__, PRef p, int layer) { int c, mtn, pm, pc; moe_scan(wv__, p, layer, c, mtn, pm, pc); return __builtin_amdgcn_readlane(pm, 31); }
__device__ __forceinline__ void stage_moe1(const int wv__, PRef p, int layer, int item, char* lds_all) {
    GEMM8_LANE_VARS
    MoeTile t; if (!moe_decode<8>(wv__, p, layer, item, t)) return;
    const int* lst = p.list + (size_t)(layer * NE + t.e) * T;
    const bf16_t* B = p.w1_t + ((size_t)(layer * NE + t.e) * 2048 + t.nt * 256) * D;
    f32x4 acc[8][4]; zero_acc2(acc);
    { GemmSrc8 s;
#pragma unroll
      for (int i = 0; i < 2; ++i) { const int ii = t.mt * 256 + br0 + 128 * i; const int tok = lst[ii < t.cnt ? ii : t.cnt - 1] >> 2;
          s.a[i] = p.h + (size_t)tok * D + bc; s.b[i] = B + (size_t)brow(br0 + 128 * i) * D + bc; }
      gemm_kloop8(wv__, acc, s, D, lds_all); }
    const float* b1 = p.moe_b1 + (size_t)(layer * NE + t.e) * 2048;
#pragma unroll
    for (int m = 0; m < 8; ++m) {
        const int i = t.mt * 256 + wr * 128 + m * 16 + fr;
        if (i < t.cnt) {
            const int gc = t.nt * 128 + wc * 32 + 8 * fq;
            float o[8];
#pragma unroll
            for (int n = 0; n < 2; ++n) {
                const f32x4 bg = *(const f32x4*)(b1 + gc + 4 * n), bl = *(const f32x4*)(b1 + 1024 + gc + 4 * n);
#pragma unroll
                for (int j = 0; j < 4; ++j) {
                    const float g = fminf(acc[m][n][j] + bg[j], 7.0f), l = fminf(fmaxf(acc[m][n + 2][j] + bl[j], -7.0f), 7.0f);
                    o[4 * n + j] = g * sigmoidf_(1.702f * g) * (l + 1.0f);
                }
            }
            uint4 q; q.x = pack2(o[0], o[1]); q.y = pack2(o[2], o[3]); q.z = pack2(o[4], o[5]); q.w = pack2(o[6], o[7]);
            *(uint4*)(p.act + (size_t)(t.off + i) * D + gc) = q;
        }
    }
}
__device__ __forceinline__ void stage_moe2(const int wv__, PRef p, int layer, int item, char* lds_all) {
    GEMM8_LANE_VARS
    MoeTile t; if (!moe_decode<4>(wv__, p, layer, item, t)) return;
    const int* lst = p.list + (size_t)(layer * NE + t.e) * T;
    const bf16_t* B = p.w2_t + ((size_t)(layer * NE + t.e) * D + t.nt * 256) * D;
    f32x4 acc[8][4]; zero_acc2(acc);
    { GemmSrc8 s;
#pragma unroll
      for (int i = 0; i < 2; ++i) { const int ii = t.mt * 256 + br0 + 128 * i;
          s.a[i] = p.act + (size_t)(t.off + (ii < t.cnt ? ii : t.cnt - 1)) * D + bc; s.b[i] = B + (size_t)brow(br0 + 128 * i) * D + bc; }
      gemm_kloop8(wv__, acc, s, D, lds_all); }
    const float* b2 = p.moe_b2 + (size_t)(layer * NE + t.e) * D;
#pragma unroll
    for (int m = 0; m < 8; ++m) {
        const int i = t.mt * 256 + wr * 128 + m * 16 + fr;
        if (i < t.cnt) {
            const int pair = lst[i]; const float w = p.topw[pair]; const int col = t.nt * 256 + wc * 64 + 16 * fq;
            f32x4 v[4];
#pragma unroll
            for (int n = 0; n < 4; ++n) v[n] = (acc[m][n] + *(const f32x4*)(b2 + col + 4 * n)) * w;
            uint4 q0, q1; pack16(v, q0, q1);
            uint4* o = (uint4*)(p.sout + (size_t)pair * D + col); o[0] = q0; o[1] = q1;
        }
    }
}

constexpr int G8_TAB = 131072;
__device__ __forceinline__ void moe_tab_build(const int wv__, PRef p, int layer, char* lds_all) {
    int c, mtn, pm, pc; moe_scan(wv__, p, layer, c, mtn, pm, pc);
    G8LAS int* tab = (G8LAS int*)(lds_all + G8_TAB);
    const int t = tidx8();
    if (t < 32) { tab[t] = pm; tab[32 + t] = c; tab[64 + t] = pc - c; }
    __syncthreads();
}
__device__ __forceinline__ void moe_decode_tab(const int wv__, char* lds_all, int mg, MoeTile& t) {
    const G8LAS int* tab = (const G8LAS int*)(lds_all + G8_TAB);
    const int l31 = tidx8() & 31;
    int e = __popcll(__ballot(tab[l31] <= mg) & 0xffffffffull);
    e = e < NE ? e : NE - 1;
    t.e = e; t.cnt = __builtin_amdgcn_readfirstlane(tab[32 + e]); t.off = __builtin_amdgcn_readfirstlane(tab[64 + e]);
    t.mt = mg - (e > 0 ? __builtin_amdgcn_readfirstlane(tab[e - 1]) : 0);
}
__device__ __forceinline__ void phase_moe1_8(const int wv__, PRef p, int layer, int item0, int item_end, int stride, char* lds_all) {
    moe_tab_build(wv__, p, layer, lds_all);
    const int tid = tidx8();
    int R0, R1; const unsigned cb0 = g8_rowoff(tid, 0, R0), cb1 = g8_rowoff(tid, 1, R1);
    auto getf = [&](int item, G8Unit& u, int (&tk)[2][2]) {
        MoeTile t; t.nt = item & 7; moe_decode_tab(wv__, lds_all, item >> 3, t);
        u.a = (const char*)p.h; u.b = (const char*)(p.w1_t + ((size_t)(layer * NE + t.e) * 2048 + t.nt * 128) * D);
        u.x0 = t.e; u.x1 = t.mt; u.x2 = t.cnt; u.x3 = t.off; u.x4 = t.nt;
        const int* lst = p.list + (size_t)(layer * NE + t.e) * T; const int cm1 = t.cnt - 1;
#pragma unroll
        for (int h = 0; h < 2; ++h) { const int i0 = t.mt * 256 + h * 128 + R0, i1 = t.mt * 256 + h * 128 + R1; tk[h][0] = lst[i0 < cm1 ? i0 : cm1]; tk[h][1] = lst[i1 < cm1 ? i1 : cm1]; }
    };
    auto finf = [&](const G8Unit&, const int (&tk)[2][2], unsigned (&v)[2][2]) {
#pragma unroll
        for (int h = 0; h < 2; ++h) { v[h][0] = (unsigned)(tk[h][0] >> 2) * (unsigned)(D * 2) + cb0; v[h][1] = (unsigned)(tk[h][1] >> 2) * (unsigned)(D * 2) + cb1;
            asm volatile("" : "+v"(v[h][0]), "+v"(v[h][1])); }
    };
    auto epif = [&](const G8Acc& acc, const G8Unit& u, int wr, int wc, int fr, int fq) {
        const int e = u.x0, mt = u.x1, cnt = u.x2, off = u.x3, nt = u.x4;
        const int gc = nt * 128 + wc * 32 + 8 * fq;
        const float* b1 = p.moe_b1 + (size_t)(layer * NE + e) * 2048 + gc;
        f32x4 bg0 = *(const f32x4*)b1, bg1 = *(const f32x4*)(b1 + 4), bl0 = *(const f32x4*)(b1 + 1024), bl1 = *(const f32x4*)(b1 + 1028);
        asm volatile("" : "+v"(bg0), "+v"(bg1), "+v"(bl0), "+v"(bl1));
#pragma unroll
        for (int ai = 0; ai < 2; ++ai)
#pragma unroll
            for (int m = 0; m < 4; ++m) {
                const int i = mt * 256 + ai * 128 + wr * 64 + m * 16 + fr;
                if (i < cnt) {
                    float o[8];
#pragma unroll
                    for (int j = 0; j < 4; ++j) {
                        const float g0 = fminf(acc[ai][0][m][0][j] + bg0[j], 7.0f), l0 = fminf(fmaxf(acc[ai][1][m][0][j] + bl0[j], -7.0f), 7.0f);
                        const float g1 = fminf(acc[ai][0][m][1][j] + bg1[j], 7.0f), l1 = fminf(fmaxf(acc[ai][1][m][1][j] + bl1[j], -7.0f), 7.0f);
                        o[j] = g0 * sigmoidf_(1.702f * g0) * (l0 + 1.0f); o[4 + j] = g1 * sigmoidf_(1.702f * g1) * (l1 + 1.0f);
                    }
                    uint4 q; q.x = pack2(o[0], o[1]); q.y = pack2(o[2], o[3]); q.z = pack2(o[4], o[5]); q.w = pack2(o[6], o[7]);
                    *(uint4*)(p.act + (size_t)(off + i) * D + gc) = q;
                }
            }
    };
    gemm_phase8<true, D, D, D>(wv__, lds_all, item0, item_end, stride, 0, (size_t)1024 * D * 2, getf, finf, epif);
}
__device__ __forceinline__ void phase_moe2_8(const int wv__, PRef p, int layer, int item0, int item_end, int stride, char* lds_all) {
    moe_tab_build(wv__, p, layer, lds_all);
    auto getf = [&](int item, G8Unit& u, int (&tk)[2][2]) {
        (void)tk;
        MoeTile t; t.nt = item & 3; moe_decode_tab(wv__, lds_all, item >> 2, t);
        u.a = (const char*)(p.act + (size_t)(t.off + t.mt * 256) * D); u.b = (const char*)(p.w2_t + ((size_t)(layer * NE + t.e) * D + t.nt * 256) * D);
        u.x0 = t.e; u.x1 = t.mt; u.x2 = t.cnt; u.x3 = t.off; u.x4 = t.nt;
    };
    auto finf = [&](const G8Unit&, const int (&)[2][2], unsigned (&)[2][2]) {};
    auto epif = [&](const G8Acc& acc, const G8Unit& u, int wr, int wc, int fr, int fq) {
        const int e = u.x0, mt = u.x1, cnt = u.x2, nt = u.x4;
        const int* lst = p.list + (size_t)(layer * NE + e) * T;
        const int col = nt * 256 + wc * 32 + 8 * fq;
        const float* b2 = p.moe_b2 + (size_t)(layer * NE + e) * D + col;
        f32x4 bv[2][2];
#pragma unroll
        for (int bj = 0; bj < 2; ++bj) { bv[bj][0] = *(const f32x4*)(b2 + bj * 128); bv[bj][1] = *(const f32x4*)(b2 + bj * 128 + 4); }
        asm volatile("" : "+v"(bv[0][0]), "+v"(bv[0][1]), "+v"(bv[1][0]), "+v"(bv[1][1]));
        int pr[2][4];
#pragma unroll
        for (int ai = 0; ai < 2; ++ai)
#pragma unroll
            for (int m = 0; m < 4; ++m) { const int i = mt * 256 + ai * 128 + wr * 64 + m * 16 + fr; pr[ai][m] = lst[i < cnt ? i : cnt - 1]; }
        asm volatile("" : "+v"(pr[0][0]), "+v"(pr[0][1]), "+v"(pr[0][2]), "+v"(pr[0][3]), "+v"(pr[1][0]), "+v"(pr[1][1]), "+v"(pr[1][2]), "+v"(pr[1][3]));
#pragma unroll
        for (int ai = 0; ai < 2; ++ai)
#pragma unroll
            for (int m = 0; m < 4; ++m) {
                const int i = mt * 256 + ai * 128 + wr * 64 + m * 16 + fr;
                if (i < cnt) {
                    bf16_t* o = p.sout + (size_t)pr[ai][m] * D + col;
#pragma unroll
                    for (int bj = 0; bj < 2; ++bj) {
                        const f32x4 v0 = acc[ai][bj][m][0] + bv[bj][0], v1 = acc[ai][bj][m][1] + bv[bj][1];
                        uint4 q; q.x = pack2(v0[0], v0[1]); q.y = pack2(v0[2], v0[3]); q.z = pack2(v1[0], v1[1]); q.w = pack2(v1[2], v1[3]);
                        *(uint4*)(o + bj * 128) = q;
                    }
                }
            }
    };
    gemm_phase8<false, D, D, D>(wv__, lds_all, item0, item_end, stride, (size_t)128 * D * 2, (size_t)128 * D * 2, getf, finf, epif);
}

constexpr int N_LAT8 = (TL / 256) * 4;
__device__ __forceinline__ void phase_chan8(const int wv__, PRef p, int item0, int item_end, int stride, char* lds_all) {
    auto getf = [&](int item, G8Unit& u, int (&tk)[2][2]) { (void)tk; const int pm = item >> 2, g = item & 3;
        u.a = (const char*)(p.Yb + (size_t)(pm * 256) * 2048 + g * 512); u.b = (const char*)p.cs_t; u.x0 = pm; u.x1 = g; u.x2 = 0; u.x3 = 0; u.x4 = 0; };
    auto finf = [&](const G8Unit&, const int (&)[2][2], unsigned (&)[2][2]) {};
    auto epif = [&](const G8Acc& acc, const G8Unit& u, int wr, int wc, int fr, int fq) {
#pragma unroll
        for (int ai = 0; ai < 2; ++ai)
#pragma unroll
            for (int m = 0; m < 4; ++m) {
                bf16_t* rowp = p.yb + (size_t)(u.x0 * 256 + ai * 128 + wr * 64 + m * 16 + fr) * D + u.x1 * 256 + wc * 32 + 8 * fq;
#pragma unroll
                for (int bj = 0; bj < 2; ++bj) { const f32x4 v0 = acc[ai][bj][m][0], v1 = acc[ai][bj][m][1];
                    uint4 q; q.x = pack2(v0[0], v0[1]); q.y = pack2(v0[2], v0[3]); q.z = pack2(v1[0], v1[1]); q.w = pack2(v1[2], v1[3]);
                    *(uint4*)(rowp + bj * 128) = q; }
            }
    };
    gemm_phase8<false, 512, 2048, 512>(wv__, lds_all, item0, item_end, stride, (size_t)128 * 2048 * 2, (size_t)128 * 512 * 2, getf, finf, epif);
}
__device__ __forceinline__ void phase_outproj8(const int wv__, PRef p, int layer, int item0, int item_end, int stride, char* lds_all) {
    auto getf = [&](int item, G8Unit& u, int (&tk)[2][2]) { (void)tk; const int pm = item >> 2, pn = item & 3;
        u.a = (const char*)(p.m + (size_t)(pm * 256) * D); u.b = (const char*)(p.w_out_t + ((size_t)layer * D + pn * 256) * D); u.x0 = pm; u.x1 = pn; u.x2 = 0; u.x3 = 0; u.x4 = 0; };
    auto finf = [&](const G8Unit&, const int (&)[2][2], unsigned (&)[2][2]) {};
    auto epif = [&](const G8Acc& acc, const G8Unit& u, int wr, int wc, int fr, int fq) {
        const int col = u.x1 * 256 + wc * 32 + 8 * fq;
        const float* g1 = modp(p, layer, modrow(u.x0 * 256), 2) + col;
        f32x4 gv[2][2];
#pragma unroll
        for (int bj = 0; bj < 2; ++bj) { gv[bj][0] = *(const f32x4*)(g1 + bj * 128); gv[bj][1] = *(const f32x4*)(g1 + bj * 128 + 4); }
#pragma unroll
        for (int aim = 0; aim < 4; ++aim) {
            const int ai = aim >> 1, mb = (aim & 1) * 2;
            uint4 rv[4][2];
#pragma unroll
            for (int m = mb; m < mb + 2; ++m) { const bf16_t* r = RESB(p) + (size_t)(u.x0 * 256 + ai * 128 + wr * 64 + m * 16 + fr) * D + col;
#pragma unroll
                for (int bj = 0; bj < 2; ++bj) rv[m][bj] = *(const uint4*)(r + bj * 128); }
#pragma unroll
            for (int m = mb; m < mb + 2; ++m) { bf16_t* r = RESB(p) + (size_t)(u.x0 * 256 + ai * 128 + wr * 64 + m * 16 + fr) * D + col;
#pragma unroll
                for (int bj = 0; bj < 2; ++bj) { const uint4 q = rv[m][bj]; const f32x4 a0 = acc[ai][bj][m][0], a1 = acc[ai][bj][m][1], g0 = gv[bj][0], g1v = gv[bj][1];
                    uint4 o; o.x = pack2(lo16(q.x) + g0[0] * a0[0], hi16(q.x) + g0[1] * a0[1]); o.y = pack2(lo16(q.y) + g0[2] * a0[2], hi16(q.y) + g0[3] * a0[3]);
                    o.z = pack2(lo16(q.z) + g1v[0] * a1[0], hi16(q.z) + g1v[1] * a1[1]); o.w = pack2(lo16(q.w) + g1v[2] * a1[2], hi16(q.w) + g1v[3] * a1[3]);
                    *(uint4*)(r + bj * 128) = o; } }
            asm volatile("" ::: "memory");
        }
    };
    gemm_phase8<false, D, D, D>(wv__, lds_all, item0, item_end, stride, (size_t)128 * D * 2, (size_t)128 * D * 2, getf, finf, epif);
}
__device__ __forceinline__ void phase_merge8(const int wv__, PRef p, int layer, int tile0, int tile_end, int stride, char* lds_all) {
    int ntl = 0; for (int t = tile0; t < tile_end; t += stride) ++ntl;
    constexpr int RS_SLOTS = 16;
    G8LAS float* rst = (G8LAS float*)(lds_all + G8_TAB + 512);
    if (!NAIVE_SSD) {
        const int t = tidx8();
        for (int slot = 0; slot < ntl && slot < RS_SLOTS; ++slot) {
            const int pm = (tile0 + slot * stride) >> 2;
            const f32x4* sq = (const f32x4*)(p.ssq + (size_t)(pm * 256 + (t >> 1)) * 16 + (t & 1) * 8);
            const f32x4 a = sq[0], b = sq[1];
            float s = ((a[0] + a[1]) + (a[2] + a[3])) + ((b[0] + b[1]) + (b[2] + b[3]));
            s += __builtin_bit_cast(float, __builtin_amdgcn_ds_bpermute(((t & 63) ^ 1) * 4, __builtin_bit_cast(int, s)));
            if (!(t & 1)) rst[slot * 256 + (t >> 1)] = __builtin_amdgcn_rsqf(s * (1.0f / D) + RMS_EPS);
        }
        __syncthreads();
    }
    auto getf = [&](int vitem, G8Unit& u, int (&tk)[2][2]) { (void)tk; const int slot = vitem / 3, k = vitem - 3 * slot, tile = tile0 + slot * stride, pm = tile >> 2, pn = tile & 3;
        const bf16_t* A = k == 0 ? p.Dp : (k == 1 ? p.yb : p.yc);
        u.a = (const char*)(A + (size_t)(pm * 256) * D); u.b = (const char*)(p.w_br_t + ((size_t)(layer * 3 + k) * D + pn * 256) * D); u.x0 = pm; u.x1 = pn; u.x2 = k; u.x3 = slot; u.x4 = 0; };
    auto finf = [&](const G8Unit&, const int (&)[2][2], unsigned (&)[2][2]) {};
    auto epif = [&](const G8Acc& acc, const G8Unit& u, int wr, int wc, int fr, int fq) {
        const int k = u.x2, col = u.x1 * 256 + wc * 32 + 8 * fq;
        const bf16_t* prev = k == 2 ? p.act : p.ya; bf16_t* outp = k == 0 ? p.ya : (k == 1 ? p.act : p.m);
        const int row0 = u.x0 * 256 + wr * 64 + fr;
        float rsv[2][4];
#pragma unroll
        for (int ai = 0; ai < 2; ++ai)
#pragma unroll
            for (int m = 0; m < 4; ++m) rsv[ai][m] = 1.0f;
        if (!NAIVE_SSD && k == 2) {
            if (u.x3 < RS_SLOTS) {
#pragma unroll
                for (int ai = 0; ai < 2; ++ai)
#pragma unroll
                    for (int m = 0; m < 4; ++m) rsv[ai][m] = rst[u.x3 * 256 + ai * 128 + wr * 64 + m * 16 + fr];
            } else {
#pragma unroll
                for (int ai = 0; ai < 2; ++ai)
#pragma unroll
                    for (int m = 0; m < 4; ++m) { const f32x4* sq = (const f32x4*)(p.ssq + (size_t)(row0 + ai * 128 + m * 16) * 16); const f32x4 t = sq[0] + sq[1] + sq[2] + sq[3];
                        rsv[ai][m] = __builtin_amdgcn_rsqf((t[0] + t[1] + t[2] + t[3]) * (1.0f / D) + RMS_EPS); }
            }
        }
#pragma unroll
        for (int aim = 0; aim < 4; ++aim) {
            const int ai = aim >> 1, mb = (aim & 1) * 2;
            uint4 gq[4][2], pq[4][2];
#pragma unroll
            for (int m = mb; m < mb + 2; ++m)
#pragma unroll
                for (int bj = 0; bj < 2; ++bj) {
                    const size_t row = (size_t)(row0 + ai * 128 + m * 16);
                    gq[m][bj] = *(const uint4*)(p.U + row * UC + U_GATE + k * D + col + bj * 128);
                    pq[m][bj] = *(const uint4*)(prev + row * D + col + bj * 128);
                }
#pragma unroll
            for (int m = mb; m < mb + 2; ++m)
#pragma unroll
                for (int bj = 0; bj < 2; ++bj) {
                    const size_t row = (size_t)(row0 + ai * 128 + m * 16);
                    const uint4 g = gq[m][bj]; uint4 pv = pq[m][bj]; if (k == 0) pv = make_uint4(0u, 0u, 0u, 0u);
                    const float rs = rsv[ai][m];
                    const f32x4 a0 = acc[ai][bj][m][0], a1 = acc[ai][bj][m][1];
                    float o[8];
                    o[0] = lo16(pv.x) + lo16(g.x) * rs * a0[0]; o[1] = hi16(pv.x) + hi16(g.x) * rs * a0[1]; o[2] = lo16(pv.y) + lo16(g.y) * rs * a0[2]; o[3] = hi16(pv.y) + hi16(g.y) * rs * a0[3];
                    o[4] = lo16(pv.z) + lo16(g.z) * rs * a1[0]; o[5] = hi16(pv.z) + hi16(g.z) * rs * a1[1]; o[6] = lo16(pv.w) + lo16(g.w) * rs * a1[2]; o[7] = hi16(pv.w) + hi16(g.w) * rs * a1[3];
                    uint4 q; q.x = pack2(o[0], o[1]); q.y = pack2(o[2], o[3]); q.z = pack2(o[4], o[5]); q.w = pack2(o[6], o[7]);
                    *(uint4*)(outp + row * D + col + bj * 128) = q;
                }
            asm volatile("" ::: "memory");
        }
    };
    gemm_phase8<false, D, D, D>(wv__, lds_all, 0, 3 * ntl, 1, (size_t)128 * D * 2, (size_t)128 * D * 2, getf, finf, epif);
}

constexpr int N_CONV = T / 32;
__device__ __forceinline__ void stage_conv(const int wv__, PRef p, int layer, int item) {
    const int c0 = tidx() * 8, r0 = item * 32;
    const int seq0 = r0 < TL ? (r0 / SEQ) * SEQ : TL + ((r0 - TL) / CTXL) * CTXL, seq1 = seq0 + (r0 < TL ? SEQ : CTXL);
    float w[5][8], bias[8];
#pragma unroll
    for (int j = 0; j < 5; ++j) { const f32x4 a = *(const f32x4*)(p.conv_w + (size_t)(layer * 5 + j) * 2048 + c0), b = *(const f32x4*)(p.conv_w + (size_t)(layer * 5 + j) * 2048 + c0 + 4);
        w[j][0] = a[0]; w[j][1] = a[1]; w[j][2] = a[2]; w[j][3] = a[3]; w[j][4] = b[0]; w[j][5] = b[1]; w[j][6] = b[2]; w[j][7] = b[3]; }
    { const f32x4 a = *(const f32x4*)(p.conv_b + layer * 2048 + c0), b = *(const f32x4*)(p.conv_b + layer * 2048 + c0 + 4);
      bias[0] = a[0]; bias[1] = a[1]; bias[2] = a[2]; bias[3] = a[3]; bias[4] = b[0]; bias[5] = b[1]; bias[6] = b[2]; bias[7] = b[3]; }
    float win[5][8];
    auto ldraw = [&](int r) { const int rc = r < seq0 ? seq0 : (r >= seq1 ? seq1 - 1 : r); return *(const uint4*)(p.U + (size_t)rc * UC + U_XBC + c0); };
    auto cvt = [&](const uint4 q, int r, float (&o)[8]) { const float k = (r >= seq0 && r < seq1) ? 1.0f : 0.0f;
        o[0] = k * lo16(q.x); o[1] = k * hi16(q.x); o[2] = k * lo16(q.y); o[3] = k * hi16(q.y); o[4] = k * lo16(q.z); o[5] = k * hi16(q.z); o[6] = k * lo16(q.w); o[7] = k * hi16(q.w); };
    { const uint4 q0 = ldraw(r0 - 2), q1 = ldraw(r0 - 1), q2 = ldraw(r0), q3 = ldraw(r0 + 1); cvt(q0, r0 - 2, win[0]); cvt(q1, r0 - 1, win[1]); cvt(q2, r0, win[2]); cvt(q3, r0 + 1, win[3]); }
#pragma unroll 1
    for (int rb = r0; rb < r0 + 32; rb += 16) {
        uint4 qn[16];
#pragma unroll
        for (int i = 0; i < 16; ++i) qn[i] = ldraw(rb + 2 + i);
#pragma unroll
        for (int i8 = 0; i8 < 16; ++i8) {
            const int r = rb + i8;
            cvt(qn[i8], r + 2, win[4]);
            float o[8];
#pragma unroll
            for (int i = 0; i < 8; ++i) { float s = bias[i];
#pragma unroll
                for (int j = 0; j < 5; ++j) s += w[j][i] * win[j][i];
                o[i] = siluf_(s); }
            uint4 q; q.x = pack2(o[0], o[1]); q.y = pack2(o[2], o[3]); q.z = pack2(o[4], o[5]); q.w = pack2(o[6], o[7]);
            *(uint4*)(p.V + (size_t)r * 2048 + c0) = q;
#pragma unroll
            for (int j = 0; j < 4; ++j)
#pragma unroll
                for (int i = 0; i < 8; ++i) win[j][i] = win[j + 1][i];
        }
    }
}

constexpr int N_POOL_LAT = NB * 4 * 4 * 16, N_POOL = N_POOL_LAT + NB * 4 * 64;
__device__ __forceinline__ void pool_acc(const uint2 q, float w, float (&v)[4]) { v[0] += w * lo16(q.x); v[1] += w * hi16(q.x); v[2] += w * lo16(q.y); v[3] += w * hi16(q.y); }
template <int W>
__device__ __forceinline__ void pool_lat(PRef p, int g, int b, int band, int c, int lane, float* ring) {
    constexpr int lo = -(W >> 1), hi = W - (W >> 1) - 1;
    const int r0 = band * 32, cc0 = max(c + lo, 0), cc1 = min(c + hi, 63), ncol = cc1 - cc0 + 1;
    const bf16_t* base = p.U + (size_t)(b * SEQ) * UC + g * 256 + lane * 4;
    auto ldrow = [&](int rr, uint2 (&q)[W]) { const int rc = min(max(rr, 0), 127);
#pragma unroll
        for (int i = 0; i < W; ++i) { const int cc = min(cc0 + i, 63); q[i] = *(const uint2*)(base + (size_t)(rc * 64 + cc) * UC); } };
    auto hsum = [&](int rr, const uint2 (&q)[W], float (&h)[4]) { const bool rv = rr >= 0 && rr <= 127; h[0] = 0.f; h[1] = 0.f; h[2] = 0.f; h[3] = 0.f;
#pragma unroll
        for (int i = 0; i < W; ++i) pool_acc(q[i], (rv && i < ncol) ? 1.0f : 0.f, h); };
    f32x4* rg = (f32x4*)ring + lane;
    float vs[4] = {0.f, 0.f, 0.f, 0.f};
#pragma unroll 2
    for (int j = 0; j < W; ++j) { uint2 q[W]; float h0[4]; ldrow(r0 + lo + j, q); hsum(r0 + lo + j, q, h0);
        rg[j * 64] = (f32x4){h0[0], h0[1], h0[2], h0[3]}; vs[0] += h0[0]; vs[1] += h0[1]; vs[2] += h0[2]; vs[3] += h0[3]; }
    uint2 sq = *(const uint2*)(base + (size_t)(r0 * 64 + c) * UC), qe[W], sq1 = *(const uint2*)(base + (size_t)(min(r0 + 1, 127) * 64 + c) * UC), qe1[W];
    ldrow(r0 + 1 + hi, qe); ldrow(r0 + 2 + hi, qe1);
#pragma unroll 1
    for (int r = r0; r < r0 + 32; ++r) {
        uint2 sqn, qen[W];
        sqn = *(const uint2*)(base + (size_t)(min(r + 2, 127) * 64 + c) * UC);
        ldrow(r + 3 + hi, qen);
        const int rlo = max(r + lo, 0), rhi = min(r + hi, 127);
        const float inv = __builtin_amdgcn_rcpf((float)((rhi - rlo + 1) * ncol));
        uint2 q; q.x = pack2(vs[0] * inv - lo16(sq.x), vs[1] * inv - hi16(sq.x)); q.y = pack2(vs[2] * inv - lo16(sq.y), vs[3] * inv - hi16(sq.y));
        *(uint2*)(p.Dp + (size_t)(b * SEQ + r * 64 + c) * D + g * 256 + lane * 4) = q;
        float hn[4]; hsum(r + 1 + hi, qe, hn);
        const int slot = (r - r0) & (W - 1);
        const f32x4 ho = rg[slot * 64];
        rg[slot * 64] = (f32x4){hn[0], hn[1], hn[2], hn[3]};
        vs[0] += hn[0] - ho[0]; vs[1] += hn[1] - ho[1]; vs[2] += hn[2] - ho[2]; vs[3] += hn[3] - ho[3];
        sq = sq1; sq1 = sqn;
#pragma unroll
        for (int i = 0; i < W; ++i) { qe[i] = qe1[i]; qe1[i] = qen[i]; }
    }
}
__device__ __forceinline__ void stage_pool(const int wv__, PRef p, int item, char* lds) {
    const int tid = tidx(), wave = tid >> 6, lane = tid & 63;
    float* ring = (float*)(lds + wave * 16384);
    if (item < N_POOL_LAT) {
        const int j4 = item & 3, g = j4 == 0 ? 3 : (j4 == 1 ? 0 : (j4 == 2 ? 2 : 1)), it4 = item >> 2, b = (it4 >> 6) & 1, band = (it4 >> 4) & 3, c = (it4 & 15) * 4 + wave;
        if (g == 3) pool_lat<16>(p, g, b, band, c, lane, ring);
        else if (g == 2) pool_lat<8>(p, g, b, band, c, lane, ring);
        else if (g == 1) pool_lat<4>(p, g, b, band, c, lane, ring);
        else pool_lat<2>(p, g, b, band, c, lane, ring);
    } else {
        const int it = item - N_POOL_LAT, g = 3 - (it >> 7), b = (it >> 6) & 1, n = (it & 63) * 4 + wave;
        const int w = 2 << g, lo = -(w >> 1), hi = w - (w >> 1) - 1, t0 = max(n + lo, 0), t1 = min(n + hi, CTXL - 1);
        const bf16_t* base = p.U + (size_t)(TL + b * CTXL) * UC + g * 256 + lane * 4;
        float s[4] = {0.f, 0.f, 0.f, 0.f};
        uint2 q[16];
#pragma unroll
        for (int i = 0; i < 16; ++i) q[i] = *(const uint2*)(base + (size_t)min(t0 + i, CTXL - 1) * UC);
#pragma unroll
        for (int i = 0; i < 16; ++i) pool_acc(q[i], (t0 + i <= t1) ? 1.0f : 0.f, s);
        const float inv = 1.0f / (float)(t1 - t0 + 1);
        const uint2 sq = *(const uint2*)(base + (size_t)n * UC);
        uint2 o; o.x = pack2(s[0] * inv - lo16(sq.x), s[1] * inv - hi16(sq.x)); o.y = pack2(s[2] * inv - lo16(sq.y), s[3] * inv - hi16(sq.y));
        *(uint2*)(p.Dp + (size_t)(TL + b * CTXL + n) * D + g * 256 + lane * 4) = o;
    }
}

constexpr int N_FOUR_LAT = NB * 256 * 16, N_FOUR = N_FOUR_LAT + NB * 8 * 16;
__device__ __forceinline__ void four_table(const int wv__, char* lds) { float* tab = (float*)lds; for (int i = tidx(); i < 8192; i += 256) tab[i] = cosf(6.283185307179586f * (float)i * (1.0f / 8192.0f)); __syncthreads(); }
__device__ __forceinline__ void stage_fourier_naive(const int wv__, PRef p, int item, char* lds) {
    const float* tab = (const float*)lds;
    int b, kt, cch, N, rowbase, mult; float scale;
    if (item < N_FOUR_LAT) { b = item / 4096; const int w = item % 4096; kt = w / 16; cch = w % 16; N = SEQ; rowbase = b * SEQ; mult = 1; scale = 0.011048543456039806f; }
    else { const int it = item - N_FOUR_LAT; b = it / 128; const int w = it % 128; kt = w / 16; cch = w % 16; N = CTXL; rowbase = TL + b * CTXL; mult = 32; scale = 0.0625f; }
    const int kk = tidx() >> 3, oc = tidx() & 7, k = kt * 32 + kk, c0 = cch * 64 + oc * 8;
    const int step = (k * mult) & 8191; int idx = 0;
    float ar[8], ai[8];
#pragma unroll
    for (int i = 0; i < 8; ++i) { ar[i] = 0.f; ai[i] = 0.f; }
    const bf16_t* src = p.U + (size_t)rowbase * UC + U_FOUR + c0;
#pragma unroll 4
    for (int n = 0; n < N; ++n) {
        const uint4 q = *(const uint4*)(src + (size_t)n * UC);
        const float cs = tab[idx], sn = tab[(idx - 2048) & 8191];
        const float xv[8] = {lo16(q.x), hi16(q.x), lo16(q.y), hi16(q.y), lo16(q.z), hi16(q.z), lo16(q.w), hi16(q.w)};
#pragma unroll
        for (int i = 0; i < 8; ++i) { ar[i] += xv[i] * cs; ai[i] -= xv[i] * sn; }
        idx = (idx + step) & 8191;
    }
    const int g = c0 >> 8, cg = c0 & 255;
    bf16_t* o = p.Yb + (size_t)(rowbase + k) * 2048 + g * 512 + cg;
    uint4 r; r.x = pack2(ar[0] * scale, ar[1] * scale); r.y = pack2(ar[2] * scale, ar[3] * scale); r.z = pack2(ar[4] * scale, ar[5] * scale); r.w = pack2(ar[6] * scale, ar[7] * scale);
    *(uint4*)o = r;
    r.x = pack2(ai[0] * scale, ai[1] * scale); r.y = pack2(ai[2] * scale, ai[3] * scale); r.z = pack2(ai[4] * scale, ai[5] * scale); r.w = pack2(ai[6] * scale, ai[7] * scale);
    *(uint4*)(o + 256) = r;
}

typedef unsigned u32x2 __attribute__((ext_vector_type(2)));
union Frag8 { bf16x8 v; u32x2 h[2]; };
template <int OFF>
__device__ __forceinline__ void tr_frag4(bf16x8 (&f)[4], unsigned a0, unsigned a1, unsigned a2, unsigned a3) {
    Frag8 r0, r1, r2, r3;
    asm volatile("ds_read_b64_tr_b16 %0, %8\n\tds_read_b64_tr_b16 %1, %8 offset:%c12\n\t"
                 "ds_read_b64_tr_b16 %2, %9\n\tds_read_b64_tr_b16 %3, %9 offset:%c12\n\t"
                 "ds_read_b64_tr_b16 %4, %10\n\tds_read_b64_tr_b16 %5, %10 offset:%c12\n\t"
                 "ds_read_b64_tr_b16 %6, %11\n\tds_read_b64_tr_b16 %7, %11 offset:%c12\n\t"
                 "s_waitcnt lgkmcnt(0)"
                 : "=&v"(r0.h[0]), "=&v"(r0.h[1]), "=&v"(r1.h[0]), "=&v"(r1.h[1]), "=&v"(r2.h[0]), "=&v"(r2.h[1]), "=&v"(r3.h[0]), "=&v"(r3.h[1])
                 : "v"(a0), "v"(a1), "v"(a2), "v"(a3), "i"(OFF) : "memory");
    f[0] = r0.v; f[1] = r1.v; f[2] = r2.v; f[3] = r3.v;
}
__device__ __forceinline__ unsigned lds_addr(const void* p) { return (unsigned)(size_t)p; }
constexpr int PBA = 544, N_FOURA = NB * 128 * 4;
__device__ __forceinline__ void stage_fourA(const int wv__, PRef p, int item, char* lds) {
    const int tid = tidx(), wid = tid >> 6, lane = tid & 63, fr = lane & 15, fq = lane >> 4;
    const int b = item >> 9, n2 = (item >> 2) & 127, c0 = (item & 3) * 256;
    const bf16_t* tA = p.tabA + ((size_t)n2 * 128 + fr) * 64 + fq * 8;
    bf16x8 tf[2][8];
#pragma unroll
    for (int rt = 0; rt < 8; ++rt) tf[0][rt] = *(const bf16x8*)(tA + rt * 16 * 64);
    __syncthreads();
#pragma unroll
    for (int i = 0; i < 8; ++i) {
        const int id = tid + 256 * i, r = id >> 5, o = id & 31;
        const uint4 q = *(const uint4*)(p.U + (size_t)(b * SEQ + 128 * r + n2) * UC + U_FOUR + c0 + o * 8);
        *(uint4*)(lds + r * PBA + o * 16) = q;
    }
    __syncthreads();
    f32x4 acc[4][8];
#pragma unroll
    for (int a = 0; a < 4; ++a)
#pragma unroll
        for (int r = 0; r < 8; ++r) acc[a][r] = (f32x4){0.f, 0.f, 0.f, 0.f};
    const unsigned base = lds_addr(lds) + (unsigned)((8 * fq + (fr >> 2)) * PBA + (wid * 64 + 4 * (fr & 3)) * 2);
#pragma unroll
    for (int ks = 0; ks < 2; ++ks) {
        bf16x8 xf[4];
        if (ks == 0) {
#pragma unroll
            for (int rt = 0; rt < 8; ++rt) tf[1][rt] = *(const bf16x8*)(tA + rt * 16 * 64 + 32);
        }
        const unsigned a = base + ks * 32 * PBA;
        tr_frag4<4 * PBA>(xf, a, a + 32, a + 64, a + 96);
#pragma unroll
        for (int ct = 0; ct < 4; ++ct)
#pragma unroll
            for (int rt = 0; rt < 8; ++rt) acc[ct][rt] = __builtin_amdgcn_mfma_f32_16x16x32_bf16(xf[ct], tf[ks][rt], acc[ct][rt], 0, 0, 0);
    }
#pragma unroll
    for (int rt = 0; rt < 8; ++rt) {
        const int rA = rt * 16 + fr, k1 = rA >> 1, ri = rA & 1;
        bf16_t* o = p.Ap + ((size_t)(b * 64 + k1) * 256 + n2 * 2 + ri) * D + c0 + wid * 64 + 4 * fq;
#pragma unroll
        for (int ct = 0; ct < 4; ++ct) { uint2 q; q.x = pack2(acc[ct][rt][0], acc[ct][rt][1]); q.y = pack2(acc[ct][rt][2], acc[ct][rt][3]); *(uint2*)(o + ct * 16) = q; }
    }
}
constexpr int PBB = 288, N_FOURB_LAT = NB * 64 * 8, N_FOURB = N_FOURB_LAT + NB * 2 * 8;
__device__ __forceinline__ void stage_fourB(const int wv__, PRef p, int item, char* lds) {
    const int tid = tidx(), wid = tid >> 6, lane = tid & 63, fr = lane & 15, fq = lane >> 4;
    const bf16_t* xsrc; size_t xpitch; const bf16_t* tab; int orow0, orstep, c0;
    if (item < N_FOURB_LAT) { const int b = item >> 9, k1 = (item >> 3) & 63; c0 = (item & 7) * 128;
        xsrc = p.Ap + (size_t)(b * 64 + k1) * 256 * D + c0; xpitch = D; tab = p.tabB; orow0 = b * SEQ + k1; orstep = 64; }
    else { const int it = item - N_FOURB_LAT, b = it >> 4, half = (it >> 3) & 1; c0 = (it & 7) * 128;
        xsrc = p.U + (size_t)(TL + b * CTXL) * UC + U_FOUR + c0; xpitch = UC; tab = p.tabC + half * 65536; orow0 = TL + b * CTXL + half * 128; orstep = 1; }
    f32x4 acc[8][4];
#pragma unroll
    for (int a = 0; a < 8; ++a)
#pragma unroll
        for (int r = 0; r < 4; ++r) acc[a][r] = (f32x4){0.f, 0.f, 0.f, 0.f};
    const unsigned base = lds_addr(lds) + (unsigned)((8 * fq + (fr >> 2)) * PBB + (4 * (fr & 3)) * 2);
    const bf16_t* tB = tab + (size_t)(wid * 64 + fr) * 256 + fq * 8;
#pragma unroll 1
    for (int kh = 0; kh < 2; ++kh) {
        bf16x8 tf0[4];
#pragma unroll
        for (int rt = 0; rt < 4; ++rt) tf0[rt] = *(const bf16x8*)(tB + rt * 16 * 256 + kh * 128);
        __syncthreads();
#pragma unroll
        for (int i = 0; i < 8; ++i) {
            const int id = tid + 256 * i, r = id >> 4, o = id & 15;
            const uint4 q = *(const uint4*)(xsrc + (size_t)(kh * 128 + r) * xpitch + o * 8);
            *(uint4*)(lds + r * PBB + o * 16) = q;
        }
        __syncthreads();
#pragma unroll
        for (int ks = 0; ks < 4; ++ks) {
            bf16x8 xf[8], tf[4];
#pragma unroll
            for (int rt = 0; rt < 4; ++rt) tf[rt] = tf0[rt];
            if (ks < 3) {
#pragma unroll
                for (int rt = 0; rt < 4; ++rt) tf0[rt] = *(const bf16x8*)(tB + rt * 16 * 256 + kh * 128 + (ks + 1) * 32);
            }
            const unsigned a = base + ks * 32 * PBB;
            { bf16x8 t4[4]; tr_frag4<4 * PBB>(t4, a, a + 32, a + 64, a + 96); xf[0] = t4[0]; xf[1] = t4[1]; xf[2] = t4[2]; xf[3] = t4[3]; }
            { bf16x8 t4[4]; tr_frag4<4 * PBB>(t4, a + 128, a + 160, a + 192, a + 224); xf[4] = t4[0]; xf[5] = t4[1]; xf[6] = t4[2]; xf[7] = t4[3]; }
#pragma unroll
            for (int ct = 0; ct < 8; ++ct)
#pragma unroll
                for (int rt = 0; rt < 4; ++rt) acc[ct][rt] = __builtin_amdgcn_mfma_f32_16x16x32_bf16(xf[ct], tf[rt], acc[ct][rt], 0, 0, 0);
        }
    }
    const int g = c0 >> 8, cg = c0 & 255;
#pragma unroll
    for (int rt = 0; rt < 4; ++rt) {
        const int rB = wid * 64 + rt * 16 + fr, kk = rB >> 1, ro = rB & 1;
        bf16_t* o = p.Yb + (size_t)(orow0 + kk * orstep) * 2048 + g * 512 + ro * 256 + cg + 4 * fq;
#pragma unroll
        for (int ct = 0; ct < 8; ++ct) { uint2 q; q.x = pack2(acc[ct][rt][0], acc[ct][rt][1]); q.y = pack2(acc[ct][rt][2], acc[ct][rt][3]); *(uint2*)(o + ct * 16) = q; }
    }
}

constexpr int NCH = T / 128, N_ACSUM = NCH;
__device__ __forceinline__ void stage_acsum(const int wv__, PRef p, int layer, int item, char* lds) {
    const int tid = tidx(), col = tid & 31, seg = tid >> 5, d = col >> 4, h = col & 15;
    float* part = (float*)lds;
    const float A = -__expf(p.a_log[(layer * 2 + d) * NH + h]);
    float v[16];
#pragma unroll
    for (int i = 0; i < 16; ++i) { const int pos = seg * 16 + i, r = item * 128 + (d == 0 ? pos : 127 - pos); v[i] = p.dt[(size_t)r * 32 + col] * A; }
    float s = 0.f;
#pragma unroll
    for (int i = 0; i < 16; ++i) { s += v[i]; v[i] = s; }
    __syncthreads();
    part[seg * 32 + col] = s;
    __syncthreads();
    float base = 0.f;
#pragma unroll
    for (int j = 0; j < 8; ++j) base += (j < seg) ? part[j * 32 + col] : 0.f;
#pragma unroll
    for (int i = 0; i < 16; ++i) { const int pos = seg * 16 + i, r = item * 128 + (d == 0 ? pos : 127 - pos); p.ac[(size_t)r * 32 + col] = base + v[i]; }
}
template <int OFF>
__device__ __forceinline__ void tr_frag4b(bf16x8 (&f)[4], unsigned a, int step) { tr_frag4<OFF>(f, a, a + step, a + 2 * step, a + 3 * step); }
constexpr int PBS = 288, PXS = 160, N_CSTATE = NCH * NH;
__device__ __forceinline__ void stage_cstate(const int wv__, PRef p, int item, char* lds) {
    const int tid = tidx(), wid = tid >> 6, lane = tid & 63, fr = lane & 15, fq = lane >> 4;
    const int cid = item >> 4, hh = item & 15, g = hh >> 2, row0 = cid * 128;
    char* LB = lds; char* LX = lds + 128 * PBS; float* wgt = (float*)(lds + 128 * PBS + 128 * PXS);
    __syncthreads();
    {
        u32x4v tb[8], tx[4];
#pragma unroll
        for (int i = 0; i < 8; ++i) { const int id = tid + 256 * i, r = id >> 4, o = id & 15; tb[i] = *(const u32x4v*)(p.V + (size_t)(row0 + r) * 2048 + 1024 + g * NS + o * 8); }
#pragma unroll
        for (int i = 0; i < 4; ++i) { const int id = tid + 256 * i, r = id >> 3, o = id & 7; tx[i] = *(const u32x4v*)(p.V + (size_t)(row0 + r) * 2048 + hh * HD + o * 8); }
        const int d = tid >> 7, l = tid & 127; const int col = d * 16 + hh;
        const float tot = p.ac[(size_t)(row0 + (d == 0 ? 127 : 0)) * 32 + col], dtl = p.dt[(size_t)(row0 + l) * 32 + col], acl = p.ac[(size_t)(row0 + l) * 32 + col];
        asm volatile("" : "+v"(tb[0]), "+v"(tb[1]), "+v"(tb[2]), "+v"(tb[3]), "+v"(tb[4]), "+v"(tb[5]), "+v"(tb[6]), "+v"(tb[7]), "+v"(tx[0]), "+v"(tx[1]), "+v"(tx[2]), "+v"(tx[3]));
#pragma unroll
        for (int i = 0; i < 8; ++i) { const int id = tid + 256 * i, r = id >> 4, o = id & 15; *(u32x4v*)(LB + r * PBS + o * 16) = tb[i]; }
#pragma unroll
        for (int i = 0; i < 4; ++i) { const int id = tid + 256 * i, r = id >> 3, o = id & 7; *(u32x4v*)(LX + r * PXS + o * 16) = tx[i]; }
        wgt[tid] = dtl * __expf(tot - acl);
    }
    __syncthreads();
    const int d = wid >> 1, nh = wid & 1;
    f32x4 acc[4][4];
#pragma unroll
    for (int a = 0; a < 4; ++a)
#pragma unroll
        for (int b = 0; b < 4; ++b) acc[a][b] = (f32x4){0.f, 0.f, 0.f, 0.f};
    const unsigned rowoff = 8 * fq + (fr >> 2), coloff = 4 * (fr & 3);
    const unsigned baseB = lds_addr(LB) + rowoff * PBS + (nh * 64 + coloff) * 2, baseX = lds_addr(LX) + rowoff * PXS + coloff * 2;
#pragma unroll
    for (int ks = 0; ks < 4; ++ks) {
        bf16x8 bt[4], xr[4], xs[4];
        tr_frag4b<4 * PBS>(bt, baseB + ks * 32 * PBS, 32);
        tr_frag4b<4 * PXS>(xr, baseX + ks * 32 * PXS, 32);
        const f32x4 w0 = *(const f32x4*)(wgt + d * 128 + ks * 32 + 8 * fq), w1 = *(const f32x4*)(wgt + d * 128 + ks * 32 + 8 * fq + 4);
#pragma unroll
        for (int pt = 0; pt < 4; ++pt)
#pragma unroll
            for (int e = 0; e < 8; ++e) xs[pt][e] = (short)f2bf(bf2f((bf16_t)xr[pt][e]) * (e < 4 ? w0[e & 3] : w1[e & 3]));
#pragma unroll
        for (int nt = 0; nt < 4; ++nt)
#pragma unroll
            for (int pt = 0; pt < 4; ++pt) acc[nt][pt] = __builtin_amdgcn_mfma_f32_16x16x32_bf16(bt[nt], xs[pt], acc[nt][pt], 0, 0, 0);
    }
    bf16_t* o = p.Scs + ((size_t)((cid * 2 + d) * 16 + hh) * 64) * NS + nh * 64 + 4 * fq;
#pragma unroll
    for (int pt = 0; pt < 4; ++pt)
#pragma unroll
        for (int nt = 0; nt < 4; ++nt) { uint2 q; q.x = pack2(acc[nt][pt][0], acc[nt][pt][1]); q.y = pack2(acc[nt][pt][2], acc[nt][pt][3]);
            *(uint2*)(o + (size_t)(pt * 16 + fr) * NS + nt * 16) = q; }
}
constexpr int N_SCAN = NB * 2 * NH * HD * 16 / 256;
__device__ __forceinline__ void stage_scan(const int wv__, PRef p, int item) {
    const int idx = item * 256 + tidx(), n8 = idx & 15, pp = (idx >> 4) & 63, hh = (idx >> 10) & 15, d = (idx >> 14) & 1, b = idx >> 15;
    float s[8];
#pragma unroll
    for (int i = 0; i < 8; ++i) s[i] = 0.f;
#pragma unroll 1
    for (int t0 = 0; t0 < 66; t0 += 6) {
        u32x4v c[6]; float dl[6]; size_t o[6];
#pragma unroll
        for (int i = 0; i < 6; ++i) {
            const int t = t0 + i;
            const int cid = t < 2 ? 128 + b * 2 + (d == 0 ? t : 1 - t) : b * 64 + (d == 0 ? t - 2 : 65 - t);
            o[i] = ((size_t)((cid * 2 + d) * 16 + hh) * 64 + pp) * NS + n8 * 8;
            c[i] = *(const u32x4v*)(p.Scs + o[i]);
            dl[i] = p.ac[(size_t)(cid * 128 + (d == 0 ? 127 : 0)) * 32 + d * 16 + hh];
        }
        asm volatile("" : "+v"(c[0]), "+v"(c[1]), "+v"(c[2]), "+v"(c[3]), "+v"(c[4]), "+v"(c[5]), "+v"(dl[0]), "+v"(dl[1]), "+v"(dl[2]), "+v"(dl[3]), "+v"(dl[4]), "+v"(dl[5]));
#pragma unroll
        for (int i = 0; i < 6; ++i) {
            uint4 q; q.x = pack2(s[0], s[1]); q.y = pack2(s[2], s[3]); q.z = pack2(s[4], s[5]); q.w = pack2(s[6], s[7]);
            *(uint4*)(p.Sst + o[i]) = q;
            const float dec = __expf(dl[i]);
            s[0] = s[0] * dec + lo16(c[i].x); s[1] = s[1] * dec + hi16(c[i].x); s[2] = s[2] * dec + lo16(c[i].y); s[3] = s[3] * dec + hi16(c[i].y);
            s[4] = s[4] * dec + lo16(c[i].z); s[5] = s[5] * dec + hi16(c[i].z); s[6] = s[6] * dec + lo16(c[i].w); s[7] = s[7] * dec + hi16(c[i].w);
        }
    }
}
constexpr int N_SSDOUT = 128 * 4 + 4 * 4 * 4;
__device__ __forceinline__ void stage_ssdout(const int wv__, PRef p, int layer, int item, char* lds) {
    const int tid = tidx(), wid = tid >> 6, lane = tid & 63, fr = lane & 15, fq = lane >> 4;
    int cid, g, h0, nh;
    if (item < 512) { cid = item >> 2; g = item & 3; h0 = 0; nh = 4; } else { const int it = item - 512; cid = 128 + (it >> 4); g = (it >> 2) & 3; h0 = it & 3; nh = 1; }
    const int row0 = cid * 128;
    char* LX = lds; float* acd = (float*)(lds + 128 * PXS); float* dtd = acd + 256;
    char* SB = lds + 128 * PXS + 2048;
    const int srow = tid >> 4, sslot = tid & 15, schunk = (sslot ^ (srow & 15)) * 8;
    __syncthreads();
#pragma unroll
    for (int i = 0; i < 8; ++i) __builtin_amdgcn_global_load_lds((const unsigned*)(p.V + (size_t)(row0 + srow + 16 * i) * 2048 + 1024 + g * NS + schunk), (unsigned*)(SB + i * 4096 + tid * 16), 16, 0, 0);
    bf16x8 cf[2][4];
#pragma unroll
    for (int lt = 0; lt < 2; ++lt)
#pragma unroll
        for (int ks = 0; ks < 4; ++ks) cf[lt][ks] = *(const bf16x8*)(p.V + (size_t)(row0 + wid * 32 + lt * 16 + fr) * 2048 + 1536 + g * NS + ks * 32 + fq * 8);
    asm volatile("s_waitcnt vmcnt(0)" ::: "memory");
    __syncthreads();
    f32x4 cbt[8][2];
#pragma unroll
    for (int st = 0; st < 8; ++st) {
        bf16x8 bfA[4];
#pragma unroll
        for (int ks = 0; ks < 4; ++ks) bfA[ks] = *(const bf16x8*)(SB + (st * 16 + fr) * 256 + (((ks * 4 + fq) ^ fr) * 16));
#pragma unroll
        for (int lt = 0; lt < 2; ++lt) { f32x4 a = {0.f, 0.f, 0.f, 0.f};
#pragma unroll
            for (int ks = 0; ks < 4; ++ks) a = __builtin_amdgcn_mfma_f32_16x16x32_bf16(bfA[ks], cf[lt][ks], a, 0, 0, 0);
            cbt[st][lt] = a; }
    }
    const unsigned baseX = lds_addr(LX) + (4 * fq + (fr >> 2)) * PXS + 4 * (fr & 3) * 2;
#pragma unroll 1
    for (int hi = h0; hi < h0 + nh; ++hi) {
        const int hh = g * 4 + hi;
        float ssq[2] = {0.f, 0.f};
        __syncthreads();
        { const int t2 = tidx(), srow2 = t2 >> 4, schunk2 = ((t2 & 15) ^ (srow2 & 15)) * 8;
#pragma unroll
        for (int d = 0; d < 2; ++d) { const bf16_t* S = p.Sst + ((size_t)((cid * 2 + d) * 16 + hh) * 64) * NS;
#pragma unroll
            for (int i = 0; i < 4; ++i) __builtin_amdgcn_global_load_lds((const unsigned*)(S + (size_t)(srow2 + 16 * i) * NS + schunk2), (unsigned*)(SB + d * 16384 + i * 4096 + t2 * 16), 16, 0, 0); } }
        uint2 zq[2][4];
        { u32x4v tx[4];
#pragma unroll
          for (int i = 0; i < 4; ++i) { const int id = tid + 256 * i, r = id >> 3, o = id & 7; tx[i] = *(const u32x4v*)(p.V + (size_t)(row0 + r) * 2048 + hh * HD + o * 8); }
          const int d = tid >> 7, l = tid & 127; const float acl = p.ac[(size_t)(row0 + l) * 32 + d * 16 + hh], dtl = p.dt[(size_t)(row0 + l) * 32 + d * 16 + hh];
#pragma unroll
          for (int lt = 0; lt < 2; ++lt)
#pragma unroll
              for (int pt = 0; pt < 4; ++pt) zq[lt][pt] = *(const uint2*)(p.U + (size_t)(row0 + wid * 32 + lt * 16 + fr) * UC + U_Z + hh * HD + pt * 16 + 4 * fq);
          asm volatile("" : "+v"(tx[0]), "+v"(tx[1]), "+v"(tx[2]), "+v"(tx[3]));
#pragma unroll
          for (int i = 0; i < 4; ++i) { const int id = tid + 256 * i, r = id >> 3, o = id & 7; *(u32x4v*)(LX + r * PXS + o * 16) = tx[i]; }
          acd[tid] = acl; dtd[tid] = dtl; }
        asm volatile("s_waitcnt vmcnt(0)" ::: "memory");
        __syncthreads();
        f32x4 yacc[4][2];
#pragma unroll
        for (int pt = 0; pt < 4; ++pt) { yacc[pt][0] = (f32x4){0.f, 0.f, 0.f, 0.f}; yacc[pt][1] = (f32x4){0.f, 0.f, 0.f, 0.f}; }
#pragma unroll
        for (int d = 0; d < 2; ++d) {
            const float el0 = acd[d * 128 + wid * 32 + fr], el1 = acd[d * 128 + wid * 32 + 16 + fr];
#pragma unroll
            for (int ks = 0; ks < 4; ++ks) {
                if (d == 0 ? ks > wid : ks < wid) continue;
                const int s0 = 32 * ks + 4 * fq;
                const f32x4 as0 = *(const f32x4*)(acd + d * 128 + s0), as1 = *(const f32x4*)(acd + d * 128 + s0 + 16);
                const f32x4 ds0 = *(const f32x4*)(dtd + d * 128 + s0), ds1 = *(const f32x4*)(dtd + d * 128 + s0 + 16);
                bf16x8 gf[2];
#pragma unroll
                for (int lt = 0; lt < 2; ++lt) {
                    const int l = wid * 32 + lt * 16 + fr; const float el = lt ? el1 : el0;
#pragma unroll
                    for (int e = 0; e < 4; ++e) {
                        const int sa = s0 + e, sb = s0 + 16 + e;
                        const bool ma = d == 0 ? (sa <= l) : (sa >= l), mb = d == 0 ? (sb <= l) : (sb >= l);
                        const float va = ma ? cbt[2 * ks][lt][e] * __expf(fminf(el - as0[e], 0.f)) * ds0[e] : 0.f;
                        const float vb = mb ? cbt[2 * ks + 1][lt][e] * __expf(fminf(el - as1[e], 0.f)) * ds1[e] : 0.f;
                        gf[lt][e] = (short)f2bf(va); gf[lt][4 + e] = (short)f2bf(vb);
                    }
                }
                bf16x8 xf[4];
                tr_frag4b<16 * PXS>(xf, baseX + ks * 32 * PXS, 32);
#pragma unroll
                for (int pt = 0; pt < 4; ++pt) { yacc[pt][0] = __builtin_amdgcn_mfma_f32_16x16x32_bf16(xf[pt], gf[0], yacc[pt][0], 0, 0, 0);
                                                 yacc[pt][1] = __builtin_amdgcn_mfma_f32_16x16x32_bf16(xf[pt], gf[1], yacc[pt][1], 0, 0, 0); }
            }
            const float ex0 = __expf(el0), ex1 = __expf(el1);
            const char* S = SB + d * 16384;
#pragma unroll
            for (int pt = 0; pt < 4; ++pt) {
                f32x4 o0 = {0.f, 0.f, 0.f, 0.f}, o1 = {0.f, 0.f, 0.f, 0.f};
#pragma unroll
                for (int ks = 0; ks < 4; ++ks) { const bf16x8 sf = *(const bf16x8*)(S + (pt * 16 + fr) * 256 + (((ks * 4 + fq) ^ fr) * 16));
                    o0 = __builtin_amdgcn_mfma_f32_16x16x32_bf16(sf, cf[0][ks], o0, 0, 0, 0); o1 = __builtin_amdgcn_mfma_f32_16x16x32_bf16(sf, cf[1][ks], o1, 0, 0, 0); }
                yacc[pt][0] += o0 * ex0; yacc[pt][1] += o1 * ex1;
            }
        }
        const float dsk = p.d_skip[layer * NH + hh];
#pragma unroll
        for (int lt = 0; lt < 2; ++lt) {
            const int l = wid * 32 + lt * 16 + fr; const size_t row = (size_t)(row0 + l);
#pragma unroll
            for (int pt = 0; pt < 4; ++pt) {
                const int pc = pt * 16 + 4 * fq;
                const uint2 xq = *(const uint2*)(LX + l * PXS + pc * 2);
                const uint2 zqq = zq[lt][pt];
                const float xv[4] = {lo16(xq.x), hi16(xq.x), lo16(xq.y), hi16(xq.y)}, zv[4] = {lo16(zqq.x), hi16(zqq.x), lo16(zqq.y), hi16(zqq.y)};
                float o[4];
#pragma unroll
                for (int j = 0; j < 4; ++j) { o[j] = (yacc[pt][lt][j] + dsk * xv[j]) * siluf_(zv[j]); ssq[lt] += o[j] * o[j]; }
                uint2 q; q.x = pack2(o[0], o[1]); q.y = pack2(o[2], o[3]);
                *(uint2*)(p.yc + row * D + hh * HD + pc) = q;
            }
        }
#pragma unroll
        for (int lt = 0; lt < 2; ++lt) { float s = ssq[lt]; s += __shfl_xor(s, 16); s += __shfl_xor(s, 32);
            if (fq == 0) p.ssq[(size_t)(row0 + wid * 32 + lt * 16 + fr) * 16 + hh] = s; }
    }
}

constexpr int N_SSD = NB * NH * 16;
__device__ __forceinline__ void stage_ssd_naive(const int wv__, PRef p, int layer, int item) {
    const int wave = tidx() >> 6, lane = tidx() & 63;
    const int b = item / 256, h = (item % 256) / 16, pp = (item % 16) * 4 + wave, g = h >> 2;
    const float dsk = p.d_skip[layer * NH + h];
#pragma unroll 1
    for (int d = 0; d < 2; ++d) {
        const float Ad = -__expf(p.a_log[(layer * 2 + d) * NH + h]);
        float s0 = 0.f, s1 = 0.f;
#pragma unroll 4
        for (int t = 0; t < CTXL + SEQ; ++t) {
            int row;
            if (d == 0) row = t < CTXL ? TL + b * CTXL + t : b * SEQ + (t - CTXL);
            else        row = t < CTXL ? TL + b * CTXL + (CTXL - 1 - t) : b * SEQ + (SEQ - 1 - (t - CTXL));
            const float dtv = p.dt[(size_t)row * 32 + d * 16 + h];
            const bf16_t* vr = p.V + (size_t)row * 2048;
            const float xv = bf2f(vr[h * HD + pp]);
            const unsigned Bq = *(const unsigned*)(vr + 1024 + g * NS + 2 * lane), Cq = *(const unsigned*)(vr + 1536 + g * NS + 2 * lane);
            const float dec = __expf(dtv * Ad), dx = dtv * xv;
            s0 = s0 * dec + dx * lo16(Bq); s1 = s1 * dec + dx * hi16(Bq);
            float y = wave_sum(s0 * lo16(Cq) + s1 * hi16(Cq));
            if (lane == 0) {
                const size_t o = (size_t)row * D + h * HD + pp;
                if (d == 0) p.ybuf[o] = y;
                else { const float tot = p.ybuf[o] + y + dsk * xv; const float z = bf2f(p.U[(size_t)row * UC + U_Z + h * HD + pp]); p.ycraw[o] = tot * siluf_(z); }
            }
        }
    }
}
__device__ __forceinline__ void stage_ycnorm(const int wv__, PRef p, int layer, int item) {
    const int wave = tidx() >> 6, lane = tidx() & 63, row = item * 4 + wave;
    f32x4 v[4]; float ss = 0.f;
#pragma unroll
    for (int j = 0; j < 4; ++j) { v[j] = *(const f32x4*)(p.ycraw + (size_t)row * D + 4 * lane + 256 * j); ss += v[j][0] * v[j][0] + v[j][1] * v[j][1] + v[j][2] * v[j][2] + v[j][3] * v[j][3]; }
    ss = wave_sum(ss); const float rinv = rsqrtf(ss * (1.0f / D) + RMS_EPS);
#pragma unroll
    for (int j = 0; j < 4; ++j) { const int k = 4 * lane + 256 * j; const f32x4 w = *(const f32x4*)(p.ssm_norm_w + layer * D + k); const f32x4 o = v[j] * rinv * w;
        uint2 q; q.x = pack2(o[0], o[1]); q.y = pack2(o[2], o[3]); *(uint2*)(p.yc + (size_t)row * D + k) = q; }
}

constexpr int N_ROUTER = T / 32, HSP = 1028;
__device__ __forceinline__ void stage_router(const int wv__, PRef p, int layer, int rowbase, int nrnd, char* lds) {
    const int tid = tidx(), wave = tid >> 6, lane = tid & 63;
    float* hs = (float*)lds;
    float* part = hs + 16 * HSP;
    int* pe = (int*)(part + 4 * 16 * 32);
    int* hist = pe + 256;
    int* rank = hist + 32;
    const float* nw = p.norm2_w + layer * D;
    __syncthreads();
    if (tid < 32) hist[tid] = 0;
#pragma unroll 1
    for (int rnd = 0; rnd < nrnd; ++rnd) {
        const int rowb = rowbase + rnd * 16;
        {
            const int mrow = modrow(rowb);
            const float* sh = modp(p, layer, mrow, 3); const float* sc = modp(p, layer, mrow, 4);
            f32x4 v[4][4], w4[4], a4[4], b4[4];
#pragma unroll
            for (int t = 0; t < 4; ++t)
#pragma unroll
                for (int j = 0; j < 4; ++j) { const uint2 rq = *(const uint2*)(RESB(p) + (size_t)(rowb + wave * 4 + t) * D + 4 * lane + 256 * j); v[t][j] = (f32x4){lo16(rq.x), hi16(rq.x), lo16(rq.y), hi16(rq.y)}; }
#pragma unroll
            for (int j = 0; j < 4; ++j) { const int k = 4 * lane + 256 * j; w4[j] = *(const f32x4*)(nw + k); a4[j] = *(const f32x4*)(sc + k); b4[j] = *(const f32x4*)(sh + k); }
            asm volatile("" : "+v"(v[0][0]), "+v"(v[0][1]), "+v"(v[0][2]), "+v"(v[0][3]), "+v"(v[1][0]), "+v"(v[1][1]), "+v"(v[1][2]), "+v"(v[1][3]),
                              "+v"(v[2][0]), "+v"(v[2][1]), "+v"(v[2][2]), "+v"(v[2][3]), "+v"(v[3][0]), "+v"(v[3][1]), "+v"(v[3][2]), "+v"(v[3][3]),
                              "+v"(w4[0]), "+v"(w4[1]), "+v"(w4[2]), "+v"(w4[3]), "+v"(a4[0]), "+v"(a4[1]), "+v"(a4[2]), "+v"(a4[3]), "+v"(b4[0]), "+v"(b4[1]), "+v"(b4[2]), "+v"(b4[3]));
#pragma unroll
            for (int t = 0; t < 4; ++t) {
                const int tl = wave * 4 + t, row = rowb + tl;
                float ss = 0.f;
#pragma unroll
                for (int j = 0; j < 4; ++j) ss += v[t][j][0] * v[t][j][0] + v[t][j][1] * v[t][j][1] + v[t][j][2] * v[t][j][2] + v[t][j][3] * v[t][j][3];
                ss = wave_sum(ss); const float rinv = rsqrtf(ss * (1.0f / D) + RMS_EPS);
#pragma unroll
                for (int j = 0; j < 4; ++j) {
                    const int k = 4 * lane + 256 * j;
                    const f32x4 hv = v[t][j] * rinv * w4[j] * (a4[j] + 1.0f) + b4[j];
                    uint2 q; q.x = pack2(hv[0], hv[1]); q.y = pack2(hv[2], hv[3]);
                    *(uint2*)(p.h + (size_t)row * D + k) = q;
                    *(f32x4*)(hs + tl * HSP + k) = hv;
                }
            }
        }
        __syncthreads();
        {
            const int i = lane & 15, kq = lane >> 4;
            const float* rw = p.router_w + (size_t)layer * D * NE + (lane & 15);
            f32x4 a0 = {0.f, 0.f, 0.f, 0.f}, a1 = {0.f, 0.f, 0.f, 0.f};
#pragma unroll 1
            for (int q0 = 0; q0 < 16; q0 += 8) {
                float b0[8][4], b1[8][4];
#pragma unroll
                for (int q = 0; q < 8; ++q)
#pragma unroll
                    for (int j = 0; j < 4; ++j) { const int kb = wave * 256 + (q0 + q) * 16 + kq * 4; b0[q][j] = rw[(size_t)(kb + j) * NE]; b1[q][j] = rw[(size_t)(kb + j) * NE + 16]; }
#pragma unroll
                for (int q = 0; q < 8; ++q) {
                    const int kb = wave * 256 + (q0 + q) * 16 + kq * 4;
                    const f32x4 av = *(const f32x4*)(hs + i * HSP + kb);
#pragma unroll
                    for (int j = 0; j < 4; ++j) {
                        a0 = __builtin_amdgcn_mfma_f32_16x16x4f32(av[j], b0[q][j], a0, 0, 0, 0);
                        a1 = __builtin_amdgcn_mfma_f32_16x16x4f32(av[j], b1[q][j], a1, 0, 0, 0);
                    }
                }
            }
#pragma unroll
            for (int r = 0; r < 4; ++r) { part[(wave * 16 + 4 * kq + r) * 32 + i] = a0[r]; part[(wave * 16 + 4 * kq + r) * 32 + 16 + i] = a1[r]; }
        }
        __syncthreads();
        if (tid < 16) {
            float lg[32];
#pragma unroll
            for (int e = 0; e < 32; ++e) lg[e] = part[(0 * 16 + tid) * 32 + e] + part[(1 * 16 + tid) * 32 + e] + part[(2 * 16 + tid) * 32 + e] + part[(3 * 16 + tid) * 32 + e] + p.router_b[layer * NE + e];
            float tv[4]; int ti[4];
#pragma unroll
            for (int r = 0; r < 4; ++r) {
                float bv = -3.0e38f; int bi = 0;
#pragma unroll
                for (int e = 0; e < 32; ++e) { const bool tk = (r > 0 && ti[0] == e) || (r > 1 && ti[1] == e) || (r > 2 && ti[2] == e); if (!tk && lg[e] > bv) { bv = lg[e]; bi = e; } }
                tv[r] = bv; ti[r] = bi;
            }
            const int row = rowb + tid;
            const float e1 = __expf(tv[1] - tv[0]), e2 = __expf(tv[2] - tv[0]), e3 = __expf(tv[3] - tv[0]); const float inv = 1.0f / (1.0f + e1 + e2 + e3);
            *(f32x4*)(p.topw + (size_t)row * 4) = (f32x4){inv, e1 * inv, e2 * inv, e3 * inv};
#pragma unroll
            for (int r = 0; r < 4; ++r) { p.topi[row * 4 + r] = ti[r]; pe[(rnd * 16 + tid) * 4 + r] = ti[r]; }
        }
        __syncthreads();
    }
    if (tid < 64 * nrnd) rank[tid] = atomicAdd(&hist[pe[tid]], 1);
    __syncthreads();
    if (tid < 32) { const int c = hist[tid]; hist[tid] = c ? atomicAdd(&p.cnt[(layer * NE + tid) * CNT_STRIDE], c) : 0; }
    __syncthreads();
    if (tid < 64 * nrnd) { const int e = pe[tid]; p.list[(size_t)(layer * NE + e) * T + hist[e] + rank[tid]] = (rowbase + (tid >> 2)) * 4 + (tid & 3); }
}

#define XB_TMO      128
#define XB_XCNT(j)  (256  + 64 * (j))
#define XB_XSUB(j)  (1280 + 64 * (j))
#define XB_XGEN(j)  (2304 + 64 * (j))
#define XB_TOP      3328
#define XB_TOPGEN   3392
#define XCD_BAR_WORDS 3456
#define XB_SPIN_CAP (1u << 22)
#define LAS __attribute__((address_space(3)))
__device__ __forceinline__ unsigned xb_ld(unsigned* p)              { return __hip_atomic_load(p, __ATOMIC_RELAXED, __HIP_MEMORY_SCOPE_AGENT); }
__device__ __forceinline__ unsigned xb_add(unsigned* p, unsigned v) { return __hip_atomic_fetch_add(p, v, __ATOMIC_RELAXED, __HIP_MEMORY_SCOPE_AGENT); }
__device__ __forceinline__ unsigned xb_xcc_id() { return (unsigned)__builtin_amdgcn_s_getreg((3 << 11) | 20) & 0xFu; }
#define XB_SPIN(cond, bar) do { unsigned _sp = 0; while (cond) { __builtin_amdgcn_s_sleep(1); \
    if ((++_sp & 255u) == 0u) { if (xb_ld(&(bar)[XB_TMO])) break; if (_sp > XB_SPIN_CAP) { atomicAdd(&(bar)[XB_TMO], 1u); break; } } } } while (0)
struct XcdBarrier { unsigned* bar; unsigned x; volatile LAS unsigned* st; };
__device__ __forceinline__ XcdBarrier xcd_barrier_post(const int wv__, unsigned* bar, volatile LAS unsigned* st) {
    XcdBarrier b; b.bar = bar; b.x = xb_xcc_id(); b.st = st;
    if (tidx8() == 0) st[2] = xb_add(&bar[XB_XCNT(b.x)], 1u);
    return b;
}
__device__ __forceinline__ void xcd_barrier_complete(unsigned* bar, unsigned x, unsigned& nloc, unsigned& nx, unsigned& rank) {
    const unsigned G = gridDim.x * gridDim.y * gridDim.z;
    unsigned sum, cnt, mine, sp = 0u;
    for (;;) {
        sum = 0u; cnt = 0u; mine = 0u;
#pragma unroll
        for (unsigned j = 0; j < 16; ++j) { const unsigned c = xb_ld(&bar[XB_XCNT(j)]); sum += c; cnt += (c > 0u) ? 1u : 0u; }
        mine = xb_ld(&bar[XB_XCNT(x)]);
        rank = 0u;
#pragma unroll
        for (unsigned j = 0; j < 16; ++j) rank += (j < x && xb_ld(&bar[XB_XCNT(j)]) > 0u) ? 1u : 0u;
        if (sum == G) break;
        __builtin_amdgcn_s_sleep(1);
        if ((++sp & 255u) == 0u) { if (xb_ld(&bar[XB_TMO])) break; if (sp > XB_SPIN_CAP) { atomicAdd(&bar[XB_TMO], 1u); break; } }
    }
    nloc = mine > 0u ? mine : 1u; nx = cnt > 0u ? cnt : 1u;
}
__device__ __forceinline__ void xcd_barrier(const int wv__, const XcdBarrier& b) {
    asm volatile("s_waitcnt vmcnt(0)" ::: "memory");
    __syncthreads();
    if (tidx8() == 0) {
        unsigned* bar = b.bar;
        __builtin_amdgcn_s_waitcnt(0);
        unsigned nloc = b.st[0], nx = b.st[1];
        if (nloc == 0u) { unsigned rk = 0u; xcd_barrier_complete(bar, b.x, nloc, nx, rk); b.st[0] = nloc; b.st[1] = nx; b.st[3] = rk; }
        const unsigned old = xb_add(&bar[XB_XSUB(b.x)], 1u);
        const unsigned gen = old / nloc;
        if (old + 1u == (gen + 1u) * nloc) {
            __builtin_amdgcn_fence(__ATOMIC_RELEASE, "agent");
            asm volatile("s_waitcnt vmcnt(0)" ::: "memory");
            const unsigned og = xb_add(&bar[XB_TOP], 1u);
            const unsigned tg = og / nx;
            if (og + 1u == (tg + 1u) * nx) xb_add(&bar[XB_TOPGEN], 1u);
            else XB_SPIN(xb_ld(&bar[XB_TOPGEN]) == tg, bar);
            __builtin_amdgcn_fence(__ATOMIC_ACQUIRE, "agent");
            xb_add(&bar[XB_XGEN(b.x)], 1u);
            asm volatile("s_waitcnt vmcnt(0)" ::: "memory");
        } else {
            XB_SPIN(xb_ld(&bar[XB_XGEN(b.x)]) == gen, bar);
            __builtin_amdgcn_fence(__ATOMIC_ACQUIRE, "agent");
            asm volatile("s_waitcnt vmcnt(0)" ::: "memory");
        }
    }
    __syncthreads();
}

namespace cg = cooperative_groups;
#define PHASE_LOOP(n) for (int item = bid; item < (n); item += G)
#define PHASE_LOOP_REV(n) for (int item = G - 1 - bid; item < (n); item += G)
#define PHASE_LOOP_OFF(n, base, off) for (int item = (base) + (bid >= ((off) % G) ? bid - ((off) % G) : bid + G - ((off) % G)); item < (n); item += G)
#define XSHARE(n, r) ((int)(((long)(n) * (r)) >> xsh))
#define XPHASE_LOOP(n, base) for (int pr_ = XSHARE((n) >> 1, xrank) + xslot, pe_ = XSHARE((n) >> 1, xrank + 1); pr_ < pe_; pr_ += xper) if (const int item = (base) + 2 * pr_ + hf; true)
#define XPHASE8_LOOP(n) for (int item = XSHARE(n, xrank) + xslot, item_end = XSHARE(n, xrank + 1); item < item_end; item += xper)
__global__ void __launch_bounds__(512, 2) hybrid_megakernel(Params p_by_value) {
    CParams* kp = (CParams*)__builtin_amdgcn_kernarg_segment_ptr();
#define p (*launder(kp))
    __shared__ __attribute__((aligned(16))) char lds_all[2 * LDS_BYTES + 16];
#define xb_words (*(uint4*)(lds_all + 2 * LDS_BYTES))
    const int wv__ = __builtin_amdgcn_readfirstlane((int)(threadIdx.x >> 6));
    if (threadIdx.x == 0) xb_words = make_uint4(0u, 0u, 0u, 0u);
    __syncthreads();
    XcdBarrier bar = xcd_barrier_post(wv__, p.bar, (volatile LAS unsigned*)&xb_words);
    const int half = wv__ >> 2;
    const int GB0 = gridDim.x, half0 = half;
    constexpr int PH_PER_LAYER = 11, N_PHASES = 1 + DEPTH * PH_PER_LAYER + 1;
#pragma unroll 1
    for (int ph = 0; ph < N_PHASES; ++ph) {
        const int l = ph == 0 ? 0 : (ph - 1) / PH_PER_LAYER, sub = ph == 0 ? -1 : (ph == N_PHASES - 1 ? 99 : (ph - 1) % PH_PER_LAYER);
        int GB = GB0, bb = (int)blockIdx.x, hf = half0; asm volatile("" : "+s"(GB), "+s"(bb), "+s"(hf));
        const int G = 2 * GB, bid = 2 * bb + hf; char* lds = lds_all + hf * LDS_BYTES;
        const int xsh = GB >= 8 ? 3 : 0, xrank = GB >= 8 ? (bb & 7) : 0, xslot = GB >= 8 ? (bb >> 3) : bb, xper = GB >= 8 ? ((GB - xrank + 7) >> 3) : GB;
        for (int rep = 0; rep < ((sub == REPEAT_SUB) ? 2 : 1); ++rep) {
        if (rep) xcd_barrier(wv__, bar);
        switch (sub) {
        case -1: {
            PHASE_LOOP(N_TABLE) stage_table(wv__, p, item);
            static_assert(((N_FOLD + N_ADA) / 2) * 16 * 2 >= N_CONVERT && (N_FOLD % 2) == 0 && (N_ADA % 2) == 0 && (N_CONVERT % 2) == 0, "prep pairing");
            for (int pi = bb; pi < ((N_FOLD + N_ADA) / 2) * 17; pi += GB) {
                const int q = pi / 17, r = pi % 17;
                if (r == 0) { const int it = 2 * q + hf; if (it < N_FOLD) stage_fold(wv__, p, it, lds); else stage_ada(wv__, p, it - N_FOLD, lds); }
                else { const int cv = 2 * (q * 16 + (r - 1)) + hf; if (cv < N_CONVERT) stage_convert(wv__, p, cv, lds); }
            }
        } break;
        case 0:
            if (l == 0) { PHASE_LOOP(N_ROWNORM) stage_rownorm<0>(wv__, p, l, item); } else { PHASE_LOOP(N_ROWNORM) stage_rownorm<1>(wv__, p, l, item); }
            break;
        case 1: phase_inproj8(wv__, p, l, XSHARE(N_INPROJ, xrank) + xslot, XSHARE(N_INPROJ, xrank + 1), xper, lds_all); break;
        case 2:
            PHASE_LOOP(l == DEPTH - 1 ? N_POOL_LAT : N_POOL) stage_pool(wv__, p, item, lds);
            PHASE_LOOP(N_FOURA) stage_fourA(wv__, p, item, lds);
            PHASE_LOOP(512) stage_conv(wv__, p, l, item);
            PHASE_LOOP_OFF(N_CONV, 512, 192) stage_conv(wv__, p, l, item);
            PHASE_LOOP_REV(N_ACSUM) stage_acsum(wv__, p, l, item, lds);
            break;
        case 3:
            PHASE_LOOP(N_FOURB_LAT) stage_fourB(wv__, p, item, lds);
            if (l != DEPTH - 1) { PHASE_LOOP_OFF(N_FOURB, N_FOURB_LAT, 256) stage_fourB(wv__, p, item, lds); }
            if (l != DEPTH - 1 && G == 512) {
                for (int item = G - 1 - bid; item < 512; item += G) stage_cstate(wv__, p, item, lds);
                if (bid < 256 || bid >= 288) { const int f = bid < 256 ? bid : bid - 32; for (int item = 512 + f; item < N_CSTATE; item += 480) stage_cstate(wv__, p, item, lds); }
            } else { PHASE_LOOP_REV(N_CSTATE) stage_cstate(wv__, p, item, lds); }
            break;
        case 4:
            PHASE_LOOP_REV(N_SCAN) stage_scan(wv__, p, item);
            phase_chan8(wv__, p, XSHARE(N_LAT8, xrank) + xslot, XSHARE(N_LAT8, xrank + 1), xper, lds_all);
            if (l != DEPTH - 1) { XPHASE_LOOP(N_G1024 - (TL / 128) * 8, (TL / 128) * 8) stage_gemm_small<1, true>(wv__, p, l, item, lds); }
            break;
        case 5:
            PHASE_LOOP(512) stage_ssdout(wv__, p, l, item, lds);
            if (l != DEPTH - 1) { for (int item = 512 + bid; item < N_SSDOUT; item += G) stage_ssdout(wv__, p, l, item, lds); }
            break;
        case 6:
            phase_merge8(wv__, p, l, XSHARE(N_LAT8, xrank) + xslot, XSHARE(N_LAT8, xrank + 1), xper, lds_all);
            if (l != DEPTH - 1) { XPHASE_LOOP(N_G1024 - (TL / 128) * 8, (TL / 128) * 8) stage_merge<true>(wv__, p, l, item, lds); }
            break;
        case 7:
            phase_outproj8(wv__, p, l, XSHARE(N_LAT8, xrank) + xslot, XSHARE(N_LAT8, xrank + 1), xper, lds_all);
            if (l != DEPTH - 1) { XPHASE_LOOP(N_G1024 - (TL / 128) * 8, (TL / 128) * 8) stage_outproj<true>(wv__, p, l, item, lds); }
            break;
        case 8:
            PHASE_LOOP(TL / 32) stage_router(wv__, p, l, item * 32, 2, lds);
            if (l != DEPTH - 1) { PHASE_LOOP_OFF((T - TL) / 16, 0, 64) stage_router(wv__, p, l, TL + item * 16, 1, lds); }
            break;
        case 9: { const int n1 = moe_total_mtiles(wv__, p, l) * 8; phase_moe1_8(wv__, p, l, XSHARE(n1, xrank) + xslot, XSHARE(n1, xrank + 1), xper, lds_all); } break;
        case 10: { const int n2 = moe_total_mtiles(wv__, p, l) * 4; phase_moe2_8(wv__, p, l, XSHARE(n2, xrank) + xslot, XSHARE(n2, xrank + 1), xper, lds_all); } break;
        default: PHASE_LOOP(TL / 4) stage_rownorm<2>(wv__, p, DEPTH - 1, item); break;
        }
        }
        if (ph != N_PHASES - 1) xcd_barrier(wv__, bar);
    }
#undef p
}

extern "C" void kernel_launch(void* const* d_in, const int* in_sizes, int n_in, void* d_out, int out_size, void* d_ws, size_t ws_size, hipStream_t stream) {
    Params p; memset(&p, 0, sizeof(p));
    const float** f = (const float**)&p;
    for (int i = 0; i < 26; ++i) f[i] = (const float*)d_in[i];
    p.out = (float*)d_out;
    char* w = (char*)d_ws; size_t off = 0;
    auto take = [&](size_t bytes) { char* r = w + off; off += (bytes + 255) & ~(size_t)255; return r; };
    p.bar = (unsigned*)take(16384); p.cnt = (int*)take((size_t)DEPTH * NE * CNT_STRIDE * 4);
    p.mod = (float*)take((size_t)DEPTH * 3 * 6144 * 4);
    p.res = (float*)take((size_t)T * D * 4);
    p.dt = (float*)take((size_t)T * 32 * 4);
    p.ybuf = (float*)take((size_t)T * D * 4);
    p.ycraw = (float*)take((size_t)T * D * 4);
    p.topw = (float*)take((size_t)T * 4 * 4);
    p.topi = (int*)take((size_t)T * 4 * 4);
    p.list = (int*)take((size_t)DEPTH * NE * T * 4);
    p.h = (bf16_t*)take((size_t)T * D * 2);
    p.w_in_t = (bf16_t*)take((size_t)DEPTH * WIN_ROWS * D * 2);
    p.w_br_t = (bf16_t*)take((size_t)DEPTH * 3 * D * D * 2);
    p.w_out_t = (bf16_t*)take((size_t)DEPTH * D * D * 2);
    p.pool_w_t = (bf16_t*)take((size_t)DEPTH * 4 * 65536 * 2);
    p.w1_t = (bf16_t*)take((size_t)DEPTH * NE * 2048 * D * 2);
    p.w2_t = (bf16_t*)take((size_t)DEPTH * NE * D * D * 2);
    p.cs_t = (bf16_t*)take((size_t)256 * 512 * 2);
    p.tabA = (bf16_t*)take((size_t)128 * 128 * 64 * 2);
    p.tabB = (bf16_t*)take((size_t)256 * 256 * 2);
    p.tabC = (bf16_t*)take((size_t)2 * 256 * 256 * 2);
    p.Ap = (bf16_t*)take((size_t)NB * 64 * 256 * D * 2);
    p.Scs = (bf16_t*)take((size_t)NCH * 2 * NH * HD * NS * 2);
    p.Sst = (bf16_t*)take((size_t)NCH * 2 * NH * HD * NS * 2);
    p.ac = (float*)take((size_t)T * 32 * 4);
    p.ssq = (float*)take((size_t)T * 16 * 4);
    p.U = (bf16_t*)take((size_t)T * UC * 2);
    p.V = (bf16_t*)take((size_t)T * 2048 * 2);
    p.Dp = (bf16_t*)take((size_t)T * D * 2);
    p.ya = (bf16_t*)take((size_t)T * D * 2);
    p.Yb = (bf16_t*)take((size_t)T * 2048 * 2);
    p.yb = (bf16_t*)take((size_t)T * D * 2);
    p.yc = (bf16_t*)take((size_t)T * D * 2);
    p.m = (bf16_t*)take((size_t)T * D * 2);
    p.act = (bf16_t*)take((size_t)(T * 4 + 256) * D * 2);
    p.sout = (bf16_t*)take((size_t)T * 4 * D * 2);
    if (off > ws_size) { fprintf(stderr, "workspace too small: need %zu have %zu\n", off, ws_size); return; }
    static int grid_blocks = 0;
    if (!grid_blocks) {
        int dev = 0, cus = 0, per_cu = 0;
        (void)hipGetDevice(&dev);
        (void)hipDeviceGetAttribute(&cus, hipDeviceAttributeMultiprocessorCount, dev);
        (void)hipOccupancyMaxActiveBlocksPerMultiprocessor(&per_cu, hybrid_megakernel, 512, 0);
        if (per_cu > 1) per_cu = 1;
        if (per_cu < 1) per_cu = 1;
        grid_blocks = cus * per_cu;
    }
    (void)hipMemsetAsync(p.bar, 0, 16384 + (size_t)DEPTH * NE * CNT_STRIDE * 4, stream);
    void* args[] = {&p};
    hipError_t e = hipLaunchCooperativeKernel((void*)hybrid_megakernel, dim3(grid_blocks), dim3(512), args, 0, stream);
    if (e != hipSuccess) fprintf(stderr, "cooperative launch failed: %s (grid %d)\n", hipGetErrorString(e), grid_blocks);
}
```
